# Optimizing an MI355X kernel written in HIP

```python
import jax, jax.numpy as jnp
from jax import lax
import numpy as np

D_MODEL = 1024
BATCH = 16
SEQ = 2048
DEPTH = 1
DEC_BATCH = 8
DEC_SEQ = 16
PAST_LEN = 2048

CHUNK = 64
D_A = 1024
H_A = 4
DH_A = D_A // H_A
D_B = 1024
NB_B = 8
BS_B = D_B // NB_B
CONV_W = 4
LRU_C = 8.0
EPS = 1e-6
SPLITS = [D_A, D_A, D_A, D_A, D_A, H_A, H_A, D_B, D_B]
D_IN = sum(SPLITS)

kernel_name = "hybrid_mlstm_rglru_stream_step"


def _rmsnorm(x, g):
    xf = x.astype(jnp.float32)
    y = xf * lax.rsqrt(jnp.mean(xf * xf, axis=-1, keepdims=True) + EPS)
    return (y * g.astype(jnp.float32)).astype(x.dtype)


def _mlstm_block(state, inp):
    C, n, m = state
    q, k, v, ig, lf = inp
    L = q.shape[2]
    b = jnp.cumsum(lf, axis=-1)
    causal = jnp.tril(jnp.ones((L, L), dtype=bool))
    logw = b[..., :, None] - b[..., None, :] + ig[..., None, :]
    logw = jnp.where(causal, logw, -jnp.inf)
    m_inter = b + m[..., None]
    m_t = jnp.maximum(m_inter, jnp.max(logw, axis=-1))
    w = jnp.exp(logw - m_t[..., None])
    s_inter = jnp.exp(m_inter - m_t)
    wqk = w * jnp.einsum('bhqd,bhsd->bhqs', q, k)
    num = s_inter[..., None] * jnp.einsum('bhvk,bhqk->bhqv', C, q) + jnp.einsum('bhqs,bhsv->bhqv', wqk, v)
    den = s_inter * jnp.einsum('bhk,bhqk->bhq', n, q) + jnp.sum(wqk, axis=-1)
    h = num / jnp.maximum(jnp.abs(den), jnp.exp(-m_t))[..., None]
    m_end = m_t[..., -1]
    decay_prev = jnp.exp(b[..., -1] + m - m_end)
    ws = jnp.exp(b[..., -1:] - b + ig - m_end[..., None])
    C_new = decay_prev[..., None, None] * C + jnp.einsum('bhs,bhsv,bhsk->bhvk', ws, v, k)
    n_new = decay_prev[..., None] * n + jnp.einsum('bhs,bhsk->bhk', ws, k)
    return (C_new, n_new, m_end), h


def _mlstm(q, k, v, ig, lf, state, chunk):
    B, L = q.shape[0], q.shape[1]
    nc = L // chunk

    def to_blocks(t):
        t = t.reshape((B, nc, chunk) + t.shape[2:])
        return jnp.moveaxis(jnp.moveaxis(t, 1, 0), 3, 2)

    xs = (to_blocks(q), to_blocks(k), to_blocks(v), to_blocks(ig), to_blocks(lf))
    state_out, h = lax.scan(_mlstm_block, state, xs)
    h = jnp.transpose(h, (1, 0, 3, 2, 4)).reshape(B, L, H_A, DH_A)
    return h, state_out


def _rglru(xb, conv_buf, h0, conv_w, conv_b, w_ra, b_ra, w_rx, b_rx, lam, start_pos):
    B, L = xb.shape[0], xb.shape[1]
    xpad = jnp.concatenate([conv_buf.astype(xb.dtype), xb], axis=1)
    xc = conv_b + xpad[:, 0:L] * conv_w[0]
    for j in range(1, CONV_W):
        xc = xc + xpad[:, j:j + L] * conv_w[j]
    new_buf = xpad[:, -(CONV_W - 1):]
    xc = xc.astype(jnp.float32)
    blk = xc.reshape(B, L, NB_B, BS_B)
    r = jax.nn.sigmoid(jnp.einsum('blni,nij->blnj', blk, w_ra.astype(jnp.float32)).reshape(B, L, D_B) + b_ra)
    i = jax.nn.sigmoid(jnp.einsum('blni,nij->blnj', blk, w_rx.astype(jnp.float32)).reshape(B, L, D_B) + b_rx)
    log_a = -LRU_C * r * jax.nn.softplus(-lam.astype(jnp.float32))
    a = jnp.exp(log_a)
    mult = jnp.sqrt(-jnp.expm1(2.0 * log_a))
    pos = jnp.arange(L) + start_pos
    mult = jnp.where((pos == 0)[None, :, None], 1.0, mult)
    bt = mult * i * xc
    bt = bt.at[:, 0].add(a[:, 0] * h0.astype(jnp.float32))

    def combine(e1, e2):
        a1, b1 = e1
        a2, b2 = e2
        return a1 * a2, a2 * b1 + b2

    _, h = lax.associative_scan(combine, (a, bt), axis=1)
    return h, h[:, -1], new_buf


def _layer(x, c, st, lw, start_pos, chunk):
    (w_mod, b_mod, g_norm, w_in, b_if, g_head, conv_w, conv_b, w_ra, b_ra, w_rx, b_rx, lam,
     w_gate, b_gate, w_out_a, w_out_b, w_o) = lw
    C0, n0, m0, h0, buf0 = st
    B, L = x.shape[0], x.shape[1]
    mod = c @ w_mod + b_mod
    shift, scale, gate = mod[:, :D_MODEL], mod[:, D_MODEL:2 * D_MODEL], mod[:, 2 * D_MODEL:]
    u = _rmsnorm(x, g_norm) * (1.0 + scale[:, None]) + shift[:, None]
    proj = u @ w_in
    idx = [int(s) for s in np.cumsum(SPLITS)[:-1]]
    q, k, v, o, z_a, ig, fg, xb, z_b = jnp.split(proj, idx, axis=-1)
    f32 = jnp.float32
    qh = q.astype(f32).reshape(B, L, H_A, DH_A)
    kh = k.astype(f32).reshape(B, L, H_A, DH_A) * (DH_A ** -0.5)
    vh = v.astype(f32).reshape(B, L, H_A, DH_A)
    ig = ig.astype(f32) + b_if[:H_A].astype(f32)
    lf = jax.nn.log_sigmoid(fg.astype(f32) + b_if[H_A:].astype(f32))
    h_a, (C1, n1, m1) = _mlstm(qh, kh, vh, ig, lf, (C0.astype(f32), n0.astype(f32), m0.astype(f32)), chunk)
    h_a = h_a * lax.rsqrt(jnp.mean(h_a * h_a, axis=-1, keepdims=True) + EPS)
    h_a = h_a.reshape(B, L, D_A) * g_head.astype(f32)
    y_a = (jax.nn.silu(z_a.astype(f32)) * jax.nn.sigmoid(o.astype(f32)) * h_a).astype(x.dtype)
    h_b, h1, buf1 = _rglru(xb, buf0, h0, conv_w, conv_b, w_ra, b_ra, w_rx, b_rx, lam, start_pos)
    y_b = (jax.nn.silu(z_b.astype(f32)) * h_b).astype(x.dtype)
    g = jax.nn.sigmoid(u @ w_gate + b_gate)
    merged = g[..., :D_MODEL] * (y_a @ w_out_a) + g[..., D_MODEL:] * (y_b @ w_out_b)
    y = x + gate[:, None] * (merged @ w_o)
    return y, (C1, n1, m1, h1.astype(x.dtype), buf1)


def setup_inputs(seed: int = 0) -> dict:
    key = jax.random.key(seed)
    ks = jax.random.split(key, 32)
    nrm = jax.random.normal
    D = D_MODEL
    u_lam = jax.random.uniform(ks[20], (DEPTH, D_B), minval=0.9, maxval=0.999)
    a_base = u_lam ** (1.0 / LRU_C)
    lam = jnp.log(a_base) - jnp.log1p(-a_base)
    b_if = jnp.concatenate([-1.0 + 0.1 * nrm(ks[21], (DEPTH, H_A)),
                            3.0 + 0.5 * nrm(ks[22], (DEPTH, H_A))], axis=-1)
    return {
        "x_prompt": nrm(ks[0], (BATCH, SEQ, D)),
        "x_sample": nrm(ks[1], (DEC_BATCH, DEC_SEQ, D)),
        "c_prompt": nrm(ks[2], (BATCH, D)),
        "c_sample": nrm(ks[3], (DEC_BATCH, D)),
        "state_C": 0.1 * nrm(ks[4], (DEPTH, DEC_BATCH, H_A, DH_A, DH_A)),
        "state_n": 0.1 * nrm(ks[5], (DEPTH, DEC_BATCH, H_A, DH_A)),
        "state_m": nrm(ks[6], (DEPTH, DEC_BATCH, H_A)),
        "state_h": 0.5 * nrm(ks[7], (DEPTH, DEC_BATCH, D_B)),
        "state_conv": nrm(ks[8], (DEPTH, DEC_BATCH, CONV_W - 1, D_B)),
        "w_mod": 0.5 * D ** -0.5 * nrm(ks[9], (DEPTH, D, 3 * D)),
        "b_mod": 0.01 * nrm(ks[10], (DEPTH, 3 * D)),
        "g_norm": 1.0 + 0.01 * nrm(ks[11], (DEPTH, D)),
        "w_in": D ** -0.5 * nrm(ks[12], (DEPTH, D, D_IN)),
        "b_if": b_if,
        "g_head": 1.0 + 0.01 * nrm(ks[13], (DEPTH, D_A)),
        "conv_w": CONV_W ** -0.5 * nrm(ks[14], (DEPTH, CONV_W, D_B)),
        "conv_b": 0.01 * nrm(ks[15], (DEPTH, D_B)),
        "w_ra": BS_B ** -0.5 * nrm(ks[16], (DEPTH, NB_B, BS_B, BS_B)),
        "b_ra": 0.01 * nrm(ks[17], (DEPTH, D_B)),
        "w_rx": BS_B ** -0.5 * nrm(ks[18], (DEPTH, NB_B, BS_B, BS_B)),
        "b_rx": 0.01 * nrm(ks[19], (DEPTH, D_B)),
        "lam": lam,
        "w_gate": D ** -0.5 * nrm(ks[23], (DEPTH, D, 2 * D)),
        "b_gate": 0.01 * nrm(ks[24], (DEPTH, 2 * D)),
        "w_out_a": D_A ** -0.5 * nrm(ks[25], (DEPTH, D_A, D)),
        "w_out_b": D_B ** -0.5 * nrm(ks[26], (DEPTH, D_B, D)),
        "w_o": D ** -0.5 * nrm(ks[27], (DEPTH, D, D)),
        "g_final": 1.0 + 0.01 * nrm(ks[28], (D,)),
    }


def reference(x_prompt, x_sample, c_prompt, c_sample, state_C, state_n, state_m, state_h, state_conv,
              w_mod, b_mod, g_norm, w_in, b_if, g_head, conv_w, conv_b, w_ra, b_ra, w_rx, b_rx, lam,
              w_gate, b_gate, w_out_a, w_out_b, w_o, g_final):
    f32 = jnp.float32
    Bp = x_prompt.shape[0]
    zero_state = (jnp.zeros((Bp, H_A, DH_A, DH_A), f32), jnp.zeros((Bp, H_A, DH_A), f32),
                  jnp.zeros((Bp, H_A), f32), jnp.zeros((Bp, D_B), x_prompt.dtype),
                  jnp.zeros((Bp, CONV_W - 1, D_B), x_prompt.dtype))
    xp, xs = x_prompt, x_sample
    new_p = [[], [], [], [], []]
    new_s = [[], [], [], [], []]
    for l in range(DEPTH):
        lw = (w_mod[l], b_mod[l], g_norm[l], w_in[l], b_if[l], g_head[l], conv_w[l], conv_b[l],
              w_ra[l], b_ra[l], w_rx[l], b_rx[l], lam[l], w_gate[l], b_gate[l],
              w_out_a[l], w_out_b[l], w_o[l])
        xp, sp = _layer(xp, c_prompt, zero_state, lw, 0, CHUNK)
        xs, ss = _layer(xs, c_sample, (state_C[l], state_n[l], state_m[l], state_h[l], state_conv[l]),
                        lw, PAST_LEN, x_sample.shape[1])
        for j in range(5):
            new_p[j].append(sp[j])
            new_s[j].append(ss[j])
    y_prompt = _rmsnorm(xp, g_final)
    y_sample = _rmsnorm(xs, g_final)
    C_p, n_p, m_p, h_p, conv_p = [jnp.stack(t, axis=0) for t in new_p]
    C_s, n_s, m_s, h_s, conv_s = [jnp.stack(t, axis=0) for t in new_s]
    return (y_prompt, y_sample, C_p, n_p, m_p, h_p, conv_p, C_s, n_s, m_s, h_s, conv_s)
```

```cpp
#include <hip/hip_runtime.h>
#include <hip/hip_cooperative_groups.h>
#include <cstdio>
#include <cstdint>
namespace cg = cooperative_groups;

#ifndef GEMM_DRAIN
#define GEMM_DRAIN 0
#endif
#ifndef SYNC_PROBE
#define SYNC_PROBE 0
#endif
#ifndef MK_ONE_LAUNCH
#define MK_ONE_LAUNCH 1
#endif

#define LAS __attribute__((address_space(3)))
typedef unsigned short bf16_t;
typedef short bf16x8 __attribute__((ext_vector_type(8)));
typedef short s16x4 __attribute__((ext_vector_type(4)));
typedef float f32x4 __attribute__((ext_vector_type(4)));
typedef unsigned u32x4 __attribute__((ext_vector_type(4)));
typedef unsigned u32x2 __attribute__((ext_vector_type(2)));

constexpr int DM = 1024, NTP = 32768, NTS = 128, NTT = NTP + NTS, SEQ = 2048, DSEQ = 16;
constexpr int DIN = 7176;
constexpr float EPS = 1e-6f;
constexpr size_t MiB = 1u << 20;
constexpr size_t WS_U = 0 * MiB, WS_V = 64 * MiB, WS_OG = 128 * MiB, WS_XB = 192 * MiB, WS_SZB = 256 * MiB, WS_GA = 320 * MiB, WS_GB = 384 * MiB;
constexpr size_t WS_W1T = 448 * MiB, WS_WAT = 466 * MiB, WS_WBT = 468 * MiB, WS_WOT = 470 * MiB, WS_WRAT = 472 * MiB, WS_WRXT = 472 * MiB + 256 * 1024;
constexpr size_t WS_SMALL = 473 * MiB, SMALL_B = 512 * 1024;
enum { SM_U = 0, SM_Q, SM_K, SM_V, SM_OG, SM_XB, SM_SZB, SM_GA, SM_GB, SM_N };
constexpr size_t WS_IF = 478 * MiB, WS_HSS = 480 * MiB, WS_ROWSS = 483 * MiB, WS_MODP = 486 * MiB, WS_WIF = 488 * MiB, WS_BAR = 489 * MiB, WS_END = 490 * MiB, WS_MODG = 487 * MiB + 256 * 1024;
constexpr size_t O_YP = 0, O_YS = 33554432, O_CP = 33685504, O_NP = 37879808, O_MP = 37896192, O_HP = 37896256, O_CVP = 37912640,
                 O_CS = 37961792, O_NS = 40058944, O_MS = 40067136, O_HS = 40067168, O_CVS = 40075360, O_END = 40099936;
constexpr int LDS_BYTES = 151552, LDS_BARW = 151040, RS_OFF = 131072, PF_OFF = 139264;

struct Params { const float* in[28]; float* out; unsigned char* ws; int ph_lo, ph_hi, probe, pad; };

typedef float f32x2_t __attribute__((ext_vector_type(2)));
typedef __bf16 bf16x2_t __attribute__((ext_vector_type(2)));
__device__ __forceinline__ unsigned pk2(float lo, float hi) { f32x2_t v = {lo, hi}; bf16x2_t b = __builtin_convertvector(v, bf16x2_t); return __builtin_bit_cast(unsigned, b); }
__device__ __forceinline__ unsigned f2bf(float f) { return pk2(f, 0.f) & 0xffffu; }
__device__ __forceinline__ float bf2f(unsigned b) { return __uint_as_float(b << 16); }
__device__ __forceinline__ float bflo(unsigned w) { return __uint_as_float(w << 16); }
__device__ __forceinline__ float bfhi(unsigned w) { return __uint_as_float(w & 0xffff0000u); }
__device__ __forceinline__ float sigm(float x) { return __builtin_amdgcn_rcpf(1.0f + __expf(-x)); }
__device__ __forceinline__ float wave_sum_bperm(float v) {
#pragma unroll
    for (int o = 1; o < 64; o <<= 1) v += __shfl_xor(v, o);
    return v;
}

template <int CTRL, int ROWMASK> __device__ __forceinline__ float dpp_f(float oldv, float src) {
    return __builtin_bit_cast(float, __builtin_amdgcn_update_dpp(__builtin_bit_cast(int, oldv), __builtin_bit_cast(int, src), CTRL, ROWMASK, 0xf, false)); }
__device__ __forceinline__ float row16_sum(float v) {
    v += dpp_f<0xB1, 0xf>(0.f, v); v += dpp_f<0x4E, 0xf>(0.f, v); v += dpp_f<0x124, 0xf>(0.f, v); v += dpp_f<0x128, 0xf>(0.f, v); return v; }
__device__ __forceinline__ float wave_sum(float v) {
    v = row16_sum(v);
    const int iv = __builtin_bit_cast(int, v);
    const float r0 = __builtin_bit_cast(float, __builtin_amdgcn_readlane(iv, 0)), r1 = __builtin_bit_cast(float, __builtin_amdgcn_readlane(iv, 16));
    const float r2 = __builtin_bit_cast(float, __builtin_amdgcn_readlane(iv, 32)), r3 = __builtin_bit_cast(float, __builtin_amdgcn_readlane(iv, 48));
    return (r0 + r1) + (r2 + r3);
}
__device__ __forceinline__ float wave_scan_add(float v) {
    v += dpp_f<0x111, 0xf>(0.f, v); v += dpp_f<0x112, 0xf>(0.f, v); v += dpp_f<0x114, 0xf>(0.f, v); v += dpp_f<0x118, 0xf>(0.f, v);
    v += dpp_f<0x142, 0xa>(0.f, v); v += dpp_f<0x143, 0xc>(0.f, v); return v; }
__device__ __forceinline__ float wave_scan_max(float v) {
    const float ninf = -INFINITY;
    v = fmaxf(v, dpp_f<0x111, 0xf>(ninf, v)); v = fmaxf(v, dpp_f<0x112, 0xf>(ninf, v)); v = fmaxf(v, dpp_f<0x114, 0xf>(ninf, v)); v = fmaxf(v, dpp_f<0x118, 0xf>(ninf, v));
    v = fmaxf(v, dpp_f<0x142, 0xa>(ninf, v)); v = fmaxf(v, dpp_f<0x143, 0xc>(ninf, v)); return v; }
#define LDS_WAIT() asm volatile("s_waitcnt lgkmcnt(0)" ::: "memory")
#define BAR_LDS() do { asm volatile("s_waitcnt lgkmcnt(0)" ::: "memory"); __builtin_amdgcn_s_barrier(); asm volatile("" ::: "memory"); } while (0)

namespace pg8 {
constexpr int BM = 256, BK = 64, HALF = 128, HTB = HALF * BK * 2, STAGE_BYTES = 8 * HTB, NXCD = 8, WGM = 8;
__host__ __device__ __forceinline__ int lds_byte(int r, int c) { const int st = (r >> 4) * 2 + (c >> 5), rr = r & 15, cc = c & 31, ob = rr * 64 + cc * 2; return st * 1024 + (ob ^ (((ob >> 9) & 1) << 5)); }
__host__ __device__ __forceinline__ void stage_rc(int b, int& R, int& C) { const int st = b / 1024, sb = b % 1024, swz = sb ^ (((sb >> 9) & 1) << 5); R = (st >> 1) * 16 + swz / 64; C = (st & 1) * 32 + (swz % 64) / 2; }
__host__ __device__ __forceinline__ int perm32(int rho) { const int n = rho >> 4, i = rho & 15; return 8 * (i >> 2) + 4 * n + (i & 3); }

struct Unit { int pm, pn, sub, slot; };
struct StaticOrder {
    int nM, nN, nwg, G, c;
    __device__ void init(int nM_, int nN_, int G_, int c_) { nM = nM_; nN = nN_; nwg = nM * nN; G = G_; c = c_; }
    __device__ bool tile(int i, Unit& u) const {
        const long L = (long)i * G + c; if (L >= nwg) return false;
        int wgid = (int)L; { const int q = nwg / NXCD, r = nwg % NXCD, xcd = wgid % NXCD, off = wgid / NXCD; wgid = (xcd < r ? xcd * (q + 1) : r * (q + 1) + (xcd - r) * q) + off; }
        const int nig = WGM * nN, gid = wgid / nig, fm = gid * WGM, gsz = (nM - fm) < WGM ? (nM - fm) : WGM;
        u.pm = fm + ((wgid % nig) % gsz); u.pn = (wgid % nig) / gsz; u.sub = 0; u.slot = 0; return true;
    }
    __device__ bool next(int i, Unit& u) const { return tile(i, u); }
};
struct PairOrder : StaticOrder {
    __device__ bool next(int i, Unit& u) const { if (!tile(i >> 1, u)) return false; u.sub = i & 1; u.slot = (i >> 1) & 1; return true; }
};
__device__ __forceinline__ unsigned cvt_pk_bf16(float lo, float hi) { return pk2(lo, hi); }

template <class Epi, class Sched, class Prob>
__device__ __forceinline__ void gemm_phase(LAS unsigned char* lds, const int K, const Sched& S, const Epi& E, const Prob& P) {
    const int tid = threadIdx.x, wid = __builtin_amdgcn_readfirstlane(tid >> 6), lane = tid & 63, wr = wid >> 2, wc = wid & 3, fr = lane & 15, fq = lane >> 4;
    const int nt = K / BK;
    unsigned voffA[2], voffB[2];
#pragma unroll
    for (int i = 0; i < 2; ++i) { int R, C; stage_rc(tid * 16 + i * 8192, R, C); const int Rb = Epi::PERM ? ((R & ~31) + perm32(R & 31)) : R;
        voffA[i] = (unsigned)(R * K + C) * 2u; voffB[i] = (unsigned)(Rb * K + C) * 2u; }
    const size_t kstep = (size_t)(BK * 2);
    const size_t hstep = (size_t)HALF * K * 2;
    const unsigned ldsw = (unsigned)wid * 1024u;
    const int aoff = lds_byte(wr * 64 + fr, fq * 8), boff = lds_byte(wc * 32 + fr, fq * 8);
#define PG8_SA(b, h) (((b) * 2 + (h)) * HTB)
#define PG8_SB(b, h) ((4 + (b) * 2 + (h)) * HTB)
#define PG8_STAGE(bufoff, gbase, voff) do { _Pragma("unroll") for (int _i = 0; _i < 2; ++_i) \
        __builtin_amdgcn_global_load_lds((const unsigned*)((const char*)(gbase) + (voff)[_i]), (LAS unsigned*)(lds + (bufoff) + ldsw + _i * 8192), 16, 0, 0); } while (0)
#define PG8_LDA(dst, b, h) do { _Pragma("unroll") for (int m = 0; m < 4; ++m) _Pragma("unroll") for (int k = 0; k < 2; ++k) dst[m][k] = *(const LAS bf16x8*)(lds + PG8_SA(b, h) + aoff + m * 2048 + k * 1024); } while (0)
#define PG8_LDB(dst, b, h) do { _Pragma("unroll") for (int n = 0; n < 2; ++n) _Pragma("unroll") for (int k = 0; k < 2; ++k) dst[n][k] = *(const LAS bf16x8*)(lds + PG8_SB(b, h) + boff + n * 2048 + k * 1024); } while (0)
#define PG8_MMA(ai, bj, At, Bt) do { __builtin_amdgcn_s_setprio(1); _Pragma("unroll") for (int m = 0; m < 4; ++m) _Pragma("unroll") for (int n = 0; n < 2; ++n) _Pragma("unroll") for (int k = 0; k < 2; ++k) \
        acc[ai][bj][m][n] = __builtin_amdgcn_mfma_f32_16x16x32_bf16(Bt[n][k], At[m][k], acc[ai][bj][m][n], 0, 0, 0); __builtin_amdgcn_s_setprio(0); } while (0)
#define PG8_WAIT_V(n) asm volatile("s_waitcnt vmcnt(" #n ")" ::: "memory")
#define PG8_WAIT_L(n) asm volatile("s_waitcnt lgkmcnt(" #n ")" ::: "memory")
#define PG8_BAR __builtin_amdgcn_s_barrier()
#define PG8_SCHED __builtin_amdgcn_sched_barrier(0)
    Unit cur, nxt; int ui = 0;
    if (!S.next(0, cur)) return;
    f32x4 acc[2][2][4][2];
#pragma unroll
    for (int a = 0; a < 2; ++a)
#pragma unroll
        for (int b = 0; b < 2; ++b)
#pragma unroll
            for (int m = 0; m < 4; ++m)
#pragma unroll
                for (int n = 0; n < 2; ++n) acc[a][b][m][n] = (f32x4){0.f, 0.f, 0.f, 0.f};
    bf16x8 At[4][2], B0[2][2], B1[2][2];
    const char* cA = P.a(cur); const char* cB = P.b(cur);
    PG8_STAGE(PG8_SB(0, 0), cB, voffB); PG8_STAGE(PG8_SA(0, 0), cA, voffA); PG8_STAGE(PG8_SB(0, 1), cB + hstep, voffB); PG8_STAGE(PG8_SA(0, 1), cA + hstep, voffA);
    if (wr == 1) PG8_BAR;
    PG8_WAIT_V(4); PG8_BAR;
    PG8_STAGE(PG8_SB(1, 0), cB + kstep, voffB); PG8_STAGE(PG8_SA(1, 0), cA + kstep, voffA); PG8_STAGE(PG8_SB(1, 1), cB + hstep + kstep, voffB);
    PG8_WAIT_V(6); PG8_BAR;
    for (;;) {
        const bool has_next = S.next(ui + 1, nxt);
        const char* nA = has_next ? P.a(nxt) : cA; const char* nB = has_next ? P.b(nxt) : cB;
        for (int t = 0; t < nt; t += 2) {
            const bool last = (t == nt - 2);
#if GEMM_DRAIN
            PG8_WAIT_V(0);
#endif
            E.mid(acc, cur, t, wr, fr, lds);
            const char* a1 = cA + (size_t)(t + 1) * kstep;
            const char* a2 = last ? nA : cA + (size_t)(t + 2) * kstep; const char* b2 = last ? nB : cB + (size_t)(t + 2) * kstep;
            const char* a3 = a2 + kstep; const char* b3 = b2 + kstep;
            PG8_LDB(B0, 0, 0); PG8_SCHED; PG8_LDA(At, 0, 0); PG8_STAGE(PG8_SA(1, 1), a1 + hstep, voffA);
            PG8_WAIT_L(8); PG8_BAR; PG8_WAIT_L(0); PG8_MMA(0, 0, At, B0); PG8_BAR; PG8_SCHED;
            PG8_LDB(B1, 0, 1); PG8_STAGE(PG8_SB(0, 0), b2, voffB);
            PG8_BAR; PG8_WAIT_L(0); PG8_MMA(0, 1, At, B1); PG8_BAR;
            PG8_LDA(At, 0, 1); PG8_STAGE(PG8_SA(0, 0), a2, voffA);
            PG8_BAR; PG8_WAIT_L(0); PG8_MMA(1, 0, At, B0); PG8_BAR; PG8_SCHED;
            PG8_STAGE(PG8_SB(0, 1), b2 + hstep, voffB);
            PG8_WAIT_V(6); PG8_BAR; PG8_MMA(1, 1, At, B1); PG8_BAR;
            PG8_LDB(B0, 1, 0); PG8_SCHED; PG8_LDA(At, 1, 0); PG8_STAGE(PG8_SA(0, 1), a2 + hstep, voffA);
            PG8_WAIT_L(8); PG8_BAR; PG8_WAIT_L(0); PG8_MMA(0, 0, At, B0); PG8_BAR; PG8_SCHED;
            PG8_LDB(B1, 1, 1); PG8_STAGE(PG8_SB(1, 0), b3, voffB);
            PG8_BAR; PG8_WAIT_L(0); PG8_MMA(0, 1, At, B1); PG8_BAR;
            PG8_LDA(At, 1, 1); PG8_STAGE(PG8_SA(1, 0), a3, voffA);
            PG8_BAR; PG8_WAIT_L(0); PG8_MMA(1, 0, At, B0); PG8_BAR; PG8_SCHED;
            PG8_STAGE(PG8_SB(1, 1), b3 + hstep, voffB);
            PG8_WAIT_V(6); PG8_BAR; PG8_MMA(1, 1, At, B1); PG8_BAR;
        }
        E(acc, cur, wr, wc, fr, fq, lds);
        if (!has_next) break;
        cur = nxt; cA = nA; cB = nB; ++ui;
    }
    PG8_WAIT_V(0);
    if (wr == 0) PG8_BAR;
    PG8_BAR;
#undef PG8_SA
#undef PG8_SB
#undef PG8_STAGE
#undef PG8_LDA
#undef PG8_LDB
#undef PG8_MMA
#undef PG8_WAIT_V
#undef PG8_WAIT_L
#undef PG8_BAR
#undef PG8_SCHED
}
#define ACC_ZERO(acc) do { _Pragma("unroll") for (int a_ = 0; a_ < 2; ++a_) _Pragma("unroll") for (int b_ = 0; b_ < 2; ++b_) _Pragma("unroll") for (int m_ = 0; m_ < 4; ++m_) _Pragma("unroll") for (int n_ = 0; n_ < 2; ++n_) acc[a_][b_][m_][n_] = (f32x4){0.f, 0.f, 0.f, 0.f}; } while (0)
}


#define XB_TMO      128
#define XB_XCNT(j)  (256  + 64 * (j))
#define XB_XSUB(j)  (1280 + 64 * (j))
#define XB_XGEN(j)  (2304 + 64 * (j))
#define XB_TOP      3328
#define XB_TOPGEN   3392
#define XCD_BAR_WORDS 3456
#define XB_SPIN_CAP (1u << 18)

__device__ __forceinline__ unsigned xb_ld(unsigned* p)              { return __hip_atomic_load(p, __ATOMIC_RELAXED, __HIP_MEMORY_SCOPE_AGENT); }
__device__ __forceinline__ unsigned xb_add(unsigned* p, unsigned v) { return __hip_atomic_fetch_add(p, v, __ATOMIC_RELAXED, __HIP_MEMORY_SCOPE_AGENT); }
__device__ __forceinline__ unsigned xb_xcc_id() { return (unsigned)__builtin_amdgcn_s_getreg((3 << 11) | 20) & 0xFu; }
#define XB_SPIN(cond, bar) do { unsigned _sp = 0; while (cond) { __builtin_amdgcn_s_sleep(1); \
    if ((++_sp & 255u) == 0u) { if (xb_ld(&(bar)[XB_TMO])) break; if (_sp > XB_SPIN_CAP) { atomicAdd(&(bar)[XB_TMO], 1u); break; } } } } while (0)

struct XcdBarrier {
    unsigned* bar; unsigned x;
    volatile LAS unsigned* st;
};

__device__ __forceinline__ XcdBarrier xcd_barrier_post(unsigned* bar, volatile LAS unsigned* st) {
    XcdBarrier b; b.bar = bar; b.x = xb_xcc_id(); b.st = st;
    if (threadIdx.x == 0) (void)xb_add(&bar[XB_XCNT(b.x)], 1u);
    return b;
}
__device__ __forceinline__ void xcd_barrier_complete(unsigned* bar, unsigned x, unsigned& nloc, unsigned& nx) {
    const unsigned G = gridDim.x * gridDim.y * gridDim.z;
    unsigned sum, cnt, mine, sp = 0u;
    for (;;) {
        sum = 0u; cnt = 0u; mine = 0u;
#pragma unroll
        for (unsigned j = 0; j < 16; ++j) { const unsigned c = xb_ld(&bar[XB_XCNT(j)]); sum += c; cnt += (c > 0u) ? 1u : 0u; mine = (j == x) ? c : mine; }
        if (sum == G) break;
        __builtin_amdgcn_s_sleep(1);
        if ((++sp & 255u) == 0u) { if (xb_ld(&bar[XB_TMO])) break; if (sp > XB_SPIN_CAP) { atomicAdd(&bar[XB_TMO], 1u); break; } }
    }
    nloc = mine > 0u ? mine : 1u; nx = cnt > 0u ? cnt : 1u;
}

__device__ __forceinline__ void xcd_barrier(const XcdBarrier& b) {
    asm volatile("s_waitcnt vmcnt(0)" ::: "memory");
    __syncthreads();
    if (threadIdx.x == 0) {
        unsigned* bar = b.bar;
        __builtin_amdgcn_s_waitcnt(0);
        unsigned nloc = b.st[0], nx = b.st[1];
        if (nloc == 0u) { xcd_barrier_complete(bar, b.x, nloc, nx); b.st[0] = nloc; b.st[1] = nx; }
        const unsigned old = xb_add(&bar[XB_XSUB(b.x)], 1u);
        const unsigned gen = old / nloc;
        if (old + 1u == (gen + 1u) * nloc) {
            __builtin_amdgcn_fence(__ATOMIC_RELEASE, "agent");
            asm volatile("s_waitcnt vmcnt(0)" ::: "memory");
            const unsigned og = xb_add(&bar[XB_TOP], 1u);
            const unsigned tg = og / nx;
            if (og + 1u == (tg + 1u) * nx) xb_add(&bar[XB_TOPGEN], 1u);
            else XB_SPIN(xb_ld(&bar[XB_TOPGEN]) == tg, bar);
            __builtin_amdgcn_fence(__ATOMIC_ACQUIRE, "agent");
            xb_add(&bar[XB_XGEN(b.x)], 1u);
            asm volatile("s_waitcnt vmcnt(0)" ::: "memory");
        } else {
            XB_SPIN(xb_ld(&bar[XB_XGEN(b.x)]) == gen, bar);
            __builtin_amdgcn_fence(__ATOMIC_ACQUIRE, "agent");
            asm volatile("s_waitcnt vmcnt(0)" ::: "memory");
        }
    }
    __syncthreads();
}


struct TV { bf16_t* big; bf16_t* sm; };
__device__ __forceinline__ bf16_t* tv_tile(const TV& t, int pm) { return pm < 128 ? t.big + (size_t)pm * 256 * DM : t.sm; }
__device__ __forceinline__ bf16_t* tv_row(const TV& t, int row) { return row < NTP ? t.big + (size_t)row * DM : t.sm + (size_t)(row - NTP) * DM; }

struct Epi1 {
    static constexpr bool PERM = true;
    __device__ __forceinline__ void mid(f32x4 (&)[2][2][4][2], const pg8::Unit&, int, int, int, LAS unsigned char*) const {}
    TV Q, K, V, OG, XB, SZB, GA, GB; const float* b_gate;
    __device__ __forceinline__ void operator()(f32x4 (&acc)[2][2][4][2], const pg8::Unit& u, int wr, int wc, int fr, int fq, LAS unsigned char* lds) const {
        const int pn = u.pn; int type, colt; TV tv; const float* bias = nullptr;
        if (pn < 4) { type = 0; tv = Q; colt = pn * 256; }
        else if (pn < 8) { type = 1; tv = K; colt = (pn - 4) * 256; }
        else if (pn < 12) { type = 0; tv = V; colt = (pn - 8) * 256; }
        else if (pn < 20) { type = 2; tv = OG; colt = (pn - 12) * 128; }
        else if (pn < 24) { type = 0; tv = XB; colt = (pn - 20) * 256; }
        else if (pn < 28) { type = 3; tv = SZB; colt = (pn - 24) * 256; }
        else if (pn < 32) { type = 4; tv = GA; colt = (pn - 28) * 256; bias = b_gate + colt; }
        else { type = 4; tv = GB; colt = (pn - 32) * 256; bias = b_gate + 1024 + colt; }
        bf16_t* base = tv_tile(tv, u.pm);
        const int nai = (u.pm < 128) ? 2 : 1;
        const int cl = wc * 32 + 8 * fq;
        if (type == 2) {
#pragma unroll
            for (int ai = 0; ai < 2; ++ai) if (ai < nai)
#pragma unroll
                for (int m = 0; m < 4; ++m) {
                    bf16_t* rowp = base + (size_t)(ai * 128 + wr * 64 + m * 16 + fr) * DM + colt + cl;
                    float v[8];
#pragma unroll
                    for (int n = 0; n < 2; ++n)
#pragma unroll
                        for (int j = 0; j < 4; ++j) { const float o = acc[ai][0][m][n][j], z = acc[ai][1][m][n][j]; v[n * 4 + j] = sigm(o) * z * sigm(z); }
                    u32x4 w; w.x = pg8::cvt_pk_bf16(v[0], v[1]); w.y = pg8::cvt_pk_bf16(v[2], v[3]); w.z = pg8::cvt_pk_bf16(v[4], v[5]); w.w = pg8::cvt_pk_bf16(v[6], v[7]);
                    *(u32x4*)rowp = w;
                }
        } else if (type == 4) {
            f32x4 bv[2][2];
#pragma unroll
            for (int bj = 0; bj < 2; ++bj)
#pragma unroll
                for (int n = 0; n < 2; ++n) bv[bj][n] = *(const f32x4*)(bias + bj * 128 + cl + 4 * n);
#pragma unroll
            for (int ai = 0; ai < 2; ++ai) if (ai < nai)
#pragma unroll
                for (int m = 0; m < 4; ++m) {
                    bf16_t* rowp = base + (size_t)(ai * 128 + wr * 64 + m * 16 + fr) * DM + colt + cl;
#pragma unroll
                    for (int bj = 0; bj < 2; ++bj) {
                        float v[8];
#pragma unroll
                        for (int n = 0; n < 2; ++n)
#pragma unroll
                            for (int j = 0; j < 4; ++j) v[n * 4 + j] = sigm(acc[ai][bj][m][n][j] + bv[bj][n][j]);
                        u32x4 w; w.x = pg8::cvt_pk_bf16(v[0], v[1]); w.y = pg8::cvt_pk_bf16(v[2], v[3]); w.z = pg8::cvt_pk_bf16(v[4], v[5]); w.w = pg8::cvt_pk_bf16(v[6], v[7]);
                        *(u32x4*)(rowp + bj * 128) = w;
                    }
                }
        } else {
            const float sc = (type == 1) ? 0.0625f : 1.0f; const bool silu = (type == 3);
#pragma unroll
            for (int ai = 0; ai < 2; ++ai) if (ai < nai)
#pragma unroll
                for (int m = 0; m < 4; ++m) {
                    bf16_t* rowp = base + (size_t)(ai * 128 + wr * 64 + m * 16 + fr) * DM + colt + cl;
#pragma unroll
                    for (int bj = 0; bj < 2; ++bj) {
                        float v[8];
#pragma unroll
                        for (int n = 0; n < 2; ++n)
#pragma unroll
                            for (int j = 0; j < 4; ++j) { float x = acc[ai][bj][m][n][j] * sc; if (silu) x = x * sigm(x); v[n * 4 + j] = x; }
                        u32x4 w; w.x = pg8::cvt_pk_bf16(v[0], v[1]); w.y = pg8::cvt_pk_bf16(v[2], v[3]); w.z = pg8::cvt_pk_bf16(v[4], v[5]); w.w = pg8::cvt_pk_bf16(v[6], v[7]);
                        *(u32x4*)(rowp + bj * 128) = w;
                    }
                }
        }
        ACC_ZERO(acc);
    }
};
struct Prob1 { TV U; const bf16_t* W;
    __device__ __forceinline__ const char* a(const pg8::Unit& u) const { return (const char*)tv_tile(U, u.pm); }
    __device__ __forceinline__ const char* b(const pg8::Unit& u) const { return (const char*)(W + (size_t)u.pn * 256 * DM); } };

struct Epi2 {
    static constexpr bool PERM = true;
    __device__ __forceinline__ void mid(f32x4 (&acc)[2][2][4][2], const pg8::Unit& u, int t, int wr, int fr, LAS unsigned char* lds) const {
        if (u.sub != 0 || t == 0 || (t & 3) != 0) return;
        const int hd = t >> 2;
        const LAS float* RS = (const LAS float*)(lds + RS_OFF) + u.slot * 1024;
#pragma unroll
        for (int ai = 0; ai < 2; ++ai)
#pragma unroll
            for (int m = 0; m < 4; ++m) { const int rl = ai * 128 + wr * 64 + m * 16 + fr;
                const float ratio = RS[rl * 4 + hd - 1] * __builtin_amdgcn_rcpf(RS[rl * 4 + hd]);
#pragma unroll
                for (int bj = 0; bj < 2; ++bj)
#pragma unroll
                    for (int n = 0; n < 2; ++n) acc[ai][bj][m][n] = acc[ai][bj][m][n] * ratio; }
    }
    TV GA, GB, MG;
    __device__ __forceinline__ void operator()(f32x4 (&acc)[2][2][4][2], const pg8::Unit& u, int wr, int wc, int fr, int fq, LAS unsigned char* lds) const {
        const bf16_t* ga = tv_tile(GA, u.pm); const bf16_t* gb = tv_tile(GB, u.pm); bf16_t* mg = tv_tile(MG, u.pm);
        {
            int t_ = threadIdx.x; asm volatile("" : "+v"(t_));
            const unsigned off0 = (unsigned)(((t_ >> 6) * 32 + (t_ & 63) / 4) << 11) + (unsigned)((t_ & 3) << 7);
            const char* gbt = (const char*)(gb + u.pn * 256); const char* gat = (const char*)(ga + u.pn * 256);
#pragma unroll
            for (int q = 0; q < 2; ++q) { __builtin_amdgcn_global_load_lds((const unsigned*)(gbt + off0 + q * 32768u), (LAS unsigned*)(lds + PF_OFF), 16, 0, 0);
                if (u.sub == 0) __builtin_amdgcn_global_load_lds((const unsigned*)(gat + off0 + q * 32768u), (LAS unsigned*)(lds + PF_OFF), 16, 0, 0); }
        }
        const int nai = (u.pm < 128) ? 2 : 1;
        const int col0 = u.pn * 256 + wc * 32 + 8 * fq;
#pragma unroll
        for (int ai = 0; ai < 2; ++ai) if (ai < nai)
#pragma unroll
            for (int m = 0; m < 4; ++m) {
                const size_t ro = (size_t)(ai * 128 + wr * 64 + m * 16 + fr) * DM + col0;
                const float rs3 = ((const LAS float*)(lds + RS_OFF))[u.slot * 1024 + (ai * 128 + wr * 64 + m * 16 + fr) * 4 + 3];
#pragma unroll
                for (int bj = 0; bj < 2; ++bj) {
                    const u32x4 gbw = *(const u32x4*)(gb + ro + bj * 128);
                    float gbv[8] = {bflo(gbw.x), bfhi(gbw.x), bflo(gbw.y), bfhi(gbw.y), bflo(gbw.z), bfhi(gbw.z), bflo(gbw.w), bfhi(gbw.w)};
                    if (u.sub == 0) {
                        const u32x4 gaw = *(const u32x4*)(ga + ro + bj * 128);
                        float gav[8] = {bflo(gaw.x), bfhi(gaw.x), bflo(gaw.y), bfhi(gaw.y), bflo(gaw.z), bfhi(gaw.z), bflo(gaw.w), bfhi(gaw.w)};
#pragma unroll
                        for (int n = 0; n < 2; ++n)
#pragma unroll
                            for (int j = 0; j < 4; ++j) acc[ai][bj][m][n][j] *= rs3 * gav[n * 4 + j] * __builtin_amdgcn_rcpf(fmaxf(gbv[n * 4 + j], 1e-30f));
                    } else {
                        float v[8];
#pragma unroll
                        for (int n = 0; n < 2; ++n)
#pragma unroll
                            for (int j = 0; j < 4; ++j) v[n * 4 + j] = acc[ai][bj][m][n][j] * fmaxf(gbv[n * 4 + j], 1e-30f);
                        u32x4 w; w.x = pg8::cvt_pk_bf16(v[0], v[1]); w.y = pg8::cvt_pk_bf16(v[2], v[3]); w.z = pg8::cvt_pk_bf16(v[4], v[5]); w.w = pg8::cvt_pk_bf16(v[6], v[7]);
                        *(u32x4*)(mg + ro + bj * 128) = w;
                    }
                }
            }
        if (u.sub == 1) ACC_ZERO(acc);
    }
};
struct Prob2 { TV YA, YB; const bf16_t* WA; const bf16_t* WB;
    __device__ __forceinline__ const char* a(const pg8::Unit& u) const { return (const char*)tv_tile(u.sub ? YB : YA, u.pm); }
    __device__ __forceinline__ const char* b(const pg8::Unit& u) const { return (const char*)((u.sub ? WB : WA) + (size_t)u.pn * 256 * DM); } };

struct Epi3 {
    static constexpr bool PERM = true;
    __device__ __forceinline__ void mid(f32x4 (&)[2][2][4][2], const pg8::Unit&, int, int, int, LAS unsigned char*) const {}
    const float* xp; bf16_t* yb; const float* modg; float* rowss;
    __device__ __forceinline__ void operator()(f32x4 (&acc)[2][2][4][2], const pg8::Unit& u, int wr, int wc, int fr, int fq, LAS unsigned char* lds) const {
        const int col0 = u.pn * 256 + wc * 32 + 8 * fq;
        const float* xb = xp + (size_t)u.pm * 256 * DM;
        int t_ = threadIdx.x; asm volatile("" : "+v"(t_));
        const int rl_ = (t_ >> 8) * 64 + (t_ & 15);
        {
            const char* xt = (const char*)(xb + u.pn * 256);
            const unsigned off0 = (unsigned)(((t_ >> 6) * 32 + (t_ & 63) / 8) << 12) + (unsigned)((t_ & 7) << 7);
#pragma unroll
            for (int q = 0; q < 4; ++q) __builtin_amdgcn_global_load_lds((const unsigned*)(xt + off0 + q * 32768u), (LAS unsigned*)(lds + PF_OFF), 16, 0, 0);
        }
        bf16_t* ob = yb + (size_t)u.pm * 256 * DM;
        const float* gp = modg + (u.pm >> 3) * DM + col0;
#pragma unroll
        for (int ai = 0; ai < 2; ++ai)
#pragma unroll
            for (int m = 0; m < 4; ++m) {
                const int rl = ai * 128 + wr * 64 + m * 16 + fr;
                const size_t ro = (size_t)rl * DM + col0;
                float ss = 0.f;
#pragma unroll
                for (int bj = 0; bj < 2; ++bj) {
                    const f32x4 y0 = *(const f32x4*)(xb + ro + bj * 128) + *(const f32x4*)(gp + bj * 128) * acc[ai][bj][m][0];
                    const f32x4 y1 = *(const f32x4*)(xb + ro + bj * 128 + 4) + *(const f32x4*)(gp + bj * 128 + 4) * acc[ai][bj][m][1];
                    ss += ((y0[0] * y0[0] + y0[1] * y0[1]) + (y0[2] * y0[2] + y0[3] * y0[3])) + ((y1[0] * y1[0] + y1[1] * y1[1]) + (y1[2] * y1[2] + y1[3] * y1[3]));
                    u32x4 w; w.x = pk2(y0[0], y0[1]); w.y = pk2(y0[2], y0[3]); w.z = pk2(y1[0], y1[1]); w.w = pk2(y1[2], y1[3]);
                    *(u32x4*)(ob + ro + bj * 128) = w;
                }
                ss += __shfl_xor(ss, 16); ss += __shfl_xor(ss, 32);
                if (fq == 0) rowss[((size_t)u.pm * 256 + ai * 128 + m * 16 + rl_) * 16 + u.pn * 4 + (t_ >> 6 & 3)] = ss;
            }
        ACC_ZERO(acc);
    }
};
struct Prob3 { TV MG; const bf16_t* WO;
    __device__ __forceinline__ const char* a(const pg8::Unit& u) const { return (const char*)tv_tile(MG, u.pm); }
    __device__ __forceinline__ const char* b(const pg8::Unit& u) const { return (const char*)(WO + (size_t)u.pn * 256 * DM); } };


__device__ __forceinline__ void mini_gemm2(const Params& p, LAS unsigned char* lds) {
    const int lane = threadIdx.x & 63, wave = threadIdx.x >> 6, g = lane >> 4, li = lane & 15, tsel = wave >> 2, ksl = wave & 3;
    unsigned char* ws = p.ws;
    const bf16_t* ya = (const bf16_t*)(ws + WS_SMALL + SM_V * SMALL_B); const bf16_t* yb = (const bf16_t*)(ws + WS_SMALL + SM_SZB * SMALL_B);
    const bf16_t* ga = (const bf16_t*)(ws + WS_SMALL + SM_GA * SMALL_B); const bf16_t* gb = (const bf16_t*)(ws + WS_SMALL + SM_GB * SMALL_B);
    bf16_t* mg = (bf16_t*)(ws + WS_SMALL + SM_U * SMALL_B);
    const bf16_t* wa = (const bf16_t*)(ws + WS_WAT); const bf16_t* wb = (const bf16_t*)(ws + WS_WBT);
    LAS float* red = (LAS float*)lds;
    for (int t0 = blockIdx.x * 2; t0 < 512; t0 += gridDim.x * 2) {
        const int wt = t0 + tsel, r0 = (wt >> 6) * 16, c0 = (wt & 63) * 16;
        const bf16_t* pa = ya + (size_t)(r0 + li) * DM + ksl * 256 + 8 * g; const bf16_t* pb = yb + (size_t)(r0 + li) * DM + ksl * 256 + 8 * g;
        const bf16_t* qa = wa + (size_t)(c0 + li) * DM + ksl * 256 + 8 * g; const bf16_t* qb = wb + (size_t)(c0 + li) * DM + ksl * 256 + 8 * g;
        f32x4 a1 = (f32x4){0.f, 0.f, 0.f, 0.f}, a2 = (f32x4){0.f, 0.f, 0.f, 0.f};
#pragma unroll
        for (int k0 = 0; k0 < 256; k0 += 32) {
            a1 = __builtin_amdgcn_mfma_f32_16x16x32_bf16(*(const bf16x8*)(pa + k0), *(const bf16x8*)(qa + k0), a1, 0, 0, 0);
            a2 = __builtin_amdgcn_mfma_f32_16x16x32_bf16(*(const bf16x8*)(pb + k0), *(const bf16x8*)(qb + k0), a2, 0, 0, 0);
        }
        { const float* hss = (const float*)(ws + WS_HSS);
#pragma unroll
          for (int r = 0; r < 4; ++r) { const f32x4 hs = *(const f32x4*)(hss + (size_t)(NTP + r0 + 4 * g + r) * 16 + ksl * 4);
              a1[r] *= rsqrtf(((hs[0] + hs[1]) + (hs[2] + hs[3])) * (1.0f / 256.0f) + EPS); } }
        *(LAS f32x4*)(red + (wave * 64 + lane) * 8) = a1; *(LAS f32x4*)(red + (wave * 64 + lane) * 8 + 4) = a2;
        __syncthreads();
        if (ksl == 0) {
#pragma unroll
            for (int q = 1; q < 4; ++q) { a1 += *(const LAS f32x4*)(red + ((wave + q) * 64 + lane) * 8); a2 += *(const LAS f32x4*)(red + ((wave + q) * 64 + lane) * 8 + 4); }
#pragma unroll
            for (int r = 0; r < 4; ++r) { const size_t o = (size_t)(r0 + 4 * g + r) * DM + c0 + li;
                mg[o] = (bf16_t)f2bf(bf2f(ga[o]) * a1[r] + bf2f(gb[o]) * a2[r]); }
        }
        __syncthreads();
    }
}
__device__ __forceinline__ void mini_gemm3(const Params& p, LAS unsigned char* lds) {
    const int lane = threadIdx.x & 63, wave = threadIdx.x >> 6, g = lane >> 4, li = lane & 15, tsel = wave >> 2, ksl = wave & 3;
    unsigned char* ws = p.ws;
    const bf16_t* mg = (const bf16_t*)(ws + WS_SMALL + SM_U * SMALL_B); const bf16_t* wo = (const bf16_t*)(ws + WS_WOT);
    const float* modg = (const float*)(ws + WS_MODG);
    LAS float* red = (LAS float*)lds;
    for (int t0 = blockIdx.x * 2; t0 < 512; t0 += gridDim.x * 2) {
        const int wt = t0 + tsel, r0 = (wt >> 6) * 16, c0 = (wt & 63) * 16;
        const bf16_t* pa = mg + (size_t)(r0 + li) * DM + ksl * 256 + 8 * g; const bf16_t* qa = wo + (size_t)(c0 + li) * DM + ksl * 256 + 8 * g;
        f32x4 a1 = (f32x4){0.f, 0.f, 0.f, 0.f};
#pragma unroll
        for (int k0 = 0; k0 < 256; k0 += 32) a1 = __builtin_amdgcn_mfma_f32_16x16x32_bf16(*(const bf16x8*)(pa + k0), *(const bf16x8*)(qa + k0), a1, 0, 0, 0);
        *(LAS f32x4*)(red + (wave * 64 + lane) * 4) = a1;
        __syncthreads();
        if (ksl == 0) {
#pragma unroll
            for (int q = 1; q < 4; ++q) a1 += *(const LAS f32x4*)(red + ((wave + q) * 64 + lane) * 4);
#pragma unroll
            for (int r = 0; r < 4; ++r) { const int row = r0 + 4 * g + r, col = c0 + li;
                p.out[O_YS + (size_t)row * DM + col] = p.in[1][(size_t)row * DM + col] + modg[(16 + (row >> 4)) * DM + col] * a1[r]; }
        }
        __syncthreads();
    }
}

__device__ __forceinline__ void transpose_item(const float* W, int ldw, int col0, int k0, bf16_t* WT, int ldt, int row0, LAS float* scr, int lane, const float* kscale = nullptr) {
#pragma unroll
    for (int i = 0; i < 32; ++i) { const int kk = 2 * i + (lane >> 5); float v = W[(size_t)(k0 + kk) * ldw + col0 + (lane & 31)]; if (kscale) v *= kscale[k0 + kk]; scr[kk * 33 + (lane & 31)] = v; }
    LDS_WAIT(); asm volatile("" ::: "memory");
    const int c = lane & 7;
#pragma unroll
    for (int j = 0; j < 4; ++j) { const int n = (lane >> 3) + 8 * j; const LAS float* s = scr + (8 * c) * 33 + n;
        u32x4 o; o.x = pk2(s[0 * 33], s[1 * 33]); o.y = pk2(s[2 * 33], s[3 * 33]); o.z = pk2(s[4 * 33], s[5 * 33]); o.w = pk2(s[6 * 33], s[7 * 33]);
        *(u32x4*)(WT + (size_t)(row0 + n) * ldt + k0 + 8 * c) = o; }
    LDS_WAIT(); asm volatile("" ::: "memory");
}

__device__ __forceinline__ void phase0(const Params& p, LAS unsigned char* lds) {
    const int tid = threadIdx.x, lane = tid & 63, wave = tid >> 6, G = gridDim.x;
    unsigned char* ws = p.ws;
    for (int it = blockIdx.x; it < 192; it += G) {
        const int cgp = it % 48, ks = it / 48;
        LAS float* cs = (LAS float*)lds;
        LAS float* red = (LAS float*)(lds + 24576);
        for (int i = tid; i < 24 * 256; i += 512) { const int b = i >> 8, k = i & 255; cs[k * 24 + b] = (b < 16) ? p.in[2][b * DM + ks * 256 + k] : p.in[3][(b - 16) * DM + ks * 256 + k]; }
        __syncthreads();
        const int col = tid & 63, kq = tid >> 6;
        float a[24];
#pragma unroll
        for (int b = 0; b < 24; ++b) a[b] = 0.f;
        const float* wm = p.in[9] + (size_t)(ks * 256 + kq * 32) * 3072 + cgp * 64 + col;
        for (int kk = 0; kk < 32; ++kk) { const float w = wm[(size_t)kk * 3072];
#pragma unroll
            for (int b = 0; b < 24; ++b) a[b] += cs[(kq * 32 + kk) * 24 + b] * w; }
#pragma unroll
        for (int b = 0; b < 24; ++b) red[(kq * 24 + b) * 64 + col] = a[b];
        __syncthreads();
        float* modp = (float*)(ws + WS_MODP);
        for (int i = tid; i < 24 * 64; i += 512) { const int b = i >> 6, c = i & 63; float s = 0.f;
#pragma unroll
            for (int q = 0; q < 8; ++q) s += red[(q * 24 + b) * 64 + c];
            modp[((size_t)ks * 24 + b) * 3072 + cgp * 64 + c] = s; }
        __syncthreads();
    }
    { float* wif = (float*)(ws + WS_WIF);
      for (int i = blockIdx.x * 512 + tid; i < 8 * DM; i += G * 512) { const int g = i >> 10, k = i & 1023; wif[i] = p.in[12][(size_t)k * DIN + 5120 + g]; } }
}

__device__ __forceinline__ void weight_items(const Params& p, LAS float* scr, int lane, int wave, int G) {
    unsigned char* ws = p.ws;
    const int gw = blockIdx.x * 8 + wave, NGW = G * 8;
    constexpr int I_W1 = 288 * 16, I_SQ = 32 * 16, I_R = 64, NIT = I_W1 + 3 * I_SQ + 2 * I_R;
    for (int it = gw; it < NIT; it += NGW) {
        int r = it;
        if (r < I_W1) {
            const int rg = r >> 4, kb = r & 15, pn = rg >> 3, c0 = (rg & 7) * 32; const float* W; int ldw, col;
            if (pn < 12) { W = p.in[12]; ldw = DIN; col = rg * 32; }
            else if (pn < 20) { W = p.in[12]; ldw = DIN; const int j = pn - 12; col = (c0 < 128) ? 3072 + 128 * j + c0 : 4096 + 128 * j + (c0 - 128); }
            else if (pn < 24) { W = p.in[12]; ldw = DIN; col = 5128 + (rg * 32 - 5120); }
            else if (pn < 28) { W = p.in[12]; ldw = DIN; col = 6152 + (rg * 32 - 6144); }
            else { W = p.in[22]; ldw = 2048; col = rg * 32 - 7168; }
            transpose_item(W, ldw, col, kb * 64, (bf16_t*)(ws + WS_W1T), DM, rg * 32, scr, lane); continue; }
        r -= I_W1;
        if (r < 3 * I_SQ) { const int w = r / I_SQ, q = r % I_SQ, rg = q >> 4, kb = q & 15;
            transpose_item(p.in[24 + w], DM, rg * 32, kb * 64, (bf16_t*)(ws + (w == 0 ? WS_WAT : (w == 1 ? WS_WBT : WS_WOT))), DM, rg * 32, scr, lane, w == 0 ? p.in[14] : nullptr); continue; }
        r -= 3 * I_SQ;
        { const int w = r / I_R, q = r % I_R, n = q >> 3, rg = (q >> 1) & 3, kb = q & 1;
          transpose_item(p.in[w ? 19 : 17] + (size_t)n * 16384, 128, rg * 32, kb * 64, (bf16_t*)(ws + (w ? WS_WRXT : WS_WRAT)) + (size_t)n * 16384, 128, rg * 32, scr, lane); }
    }
}

__device__ __forceinline__ void phase1(const Params& p, LAS unsigned char* lds) {
    const int tid = threadIdx.x, lane = tid & 63, wave = tid >> 6, G = gridDim.x;
    unsigned char* ws = p.ws;
    LAS float* wif = (LAS float*)lds;
    { const float* src = (const float*)(ws + WS_WIF); for (int i = tid; i < 8 * DM; i += 512) wif[i] = src[i]; }
    __syncthreads();
    const float* modp = (const float*)(ws + WS_MODP); const float* b_mod = p.in[10]; const float* g_norm = p.in[11]; const float* b_if = p.in[13];
    float* IF = (float*)(ws + WS_IF);
    TV U{(bf16_t*)(ws + WS_U), (bf16_t*)(ws + WS_SMALL + SM_U * SMALL_B)};
    { float* modg = (float*)(ws + WS_MODG);
      for (int i = blockIdx.x * 512 + tid; i < 24 * DM; i += G * 512) { const int b = i >> 10, c = i & 1023; float s = b_mod[2048 + c];
#pragma unroll
          for (int ks = 0; ks < 4; ++ks) s += modp[((size_t)ks * 24 + b) * 3072 + 2048 + c];
          modg[i] = s; } }
    const bool h32 = (lane & 32) != 0, h16 = (lane & 16) != 0, h8 = (lane & 8) != 0;
    const int gi = (h32 ? 4 : 0) + (h16 ? 2 : 0) + (h8 ? 1 : 0);
    const float bif = b_if[gi];
    if (wave >= 4) weight_items(p, (LAS float*)(lds + 32768 + wave * 8448), lane, wave, G);
    for (int wi = blockIdx.x * 8 + wave; wi < NTP / 16 + NTS; wi += G * 8) {
        const int row0 = wi < NTP / 16 ? wi * 16 : NTP + (wi - NTP / 16), nrow = wi < NTP / 16 ? 16 : 1;
        const int bidx = row0 < NTP ? (row0 >> 11) : 16 + ((row0 - NTP) >> 4);
        f32x4 sc[4], sh[4];
#pragma unroll
        for (int j = 0; j < 4; ++j) { const int idx = 4 * lane + 256 * j;
            f32x4 s = *(const f32x4*)(b_mod + idx), c = *(const f32x4*)(b_mod + 1024 + idx);
#pragma unroll
            for (int ks = 0; ks < 4; ++ks) { const float* mp = modp + ((size_t)ks * 24 + bidx) * 3072; s += *(const f32x4*)(mp + idx); c += *(const f32x4*)(mp + 1024 + idx); }
            sh[j] = s; sc[j] = *(const f32x4*)(g_norm + idx) * (c + 1.0f); }
        const float* xbase = row0 < NTP ? p.in[0] + (size_t)row0 * DM : p.in[1] + (size_t)(row0 - NTP) * DM;
        f32x4 nv[4];
#pragma unroll
        for (int j = 0; j < 4; ++j) nv[j] = *(const f32x4*)(xbase + 4 * lane + 256 * j);
        for (int r = 0; r < nrow; ++r) {
            const int row = row0 + r;
            f32x4 v[4]; float ss = 0.f;
#pragma unroll
            for (int j = 0; j < 4; ++j) { v[j] = nv[j]; ss += (v[j][0] * v[j][0] + v[j][1] * v[j][1]) + (v[j][2] * v[j][2] + v[j][3] * v[j][3]); }
            if (r + 1 < nrow) {
#pragma unroll
                for (int j = 0; j < 4; ++j) nv[j] = *(const f32x4*)(xbase + (size_t)(r + 1) * DM + 4 * lane + 256 * j); }
            const float rs = rsqrtf(wave_sum(ss) * (1.0f / DM) + EPS);
            bf16_t* ur = tv_row(U, row);
            float d[8];
#pragma unroll
            for (int g = 0; g < 8; ++g) d[g] = 0.f;
#pragma unroll
            for (int j = 0; j < 4; ++j) { v[j] = v[j] * rs * sc[j] + sh[j];
                u32x2 w; w.x = pk2(v[j][0], v[j][1]); w.y = pk2(v[j][2], v[j][3]); *(u32x2*)(ur + 4 * lane + 256 * j) = w;
#pragma unroll
                for (int g = 0; g < 8; ++g) { const f32x4 wv = *(const LAS f32x4*)(wif + g * DM + 4 * lane + 256 * j); d[g] += (v[j][0] * wv[0] + v[j][1] * wv[1]) + (v[j][2] * wv[2] + v[j][3] * wv[3]); } }
            float e[4], f[2], gs;
#pragma unroll
            for (int i = 0; i < 4; ++i) { const float send = h32 ? d[i] : d[i + 4], keep = h32 ? d[i + 4] : d[i]; e[i] = keep + __shfl_xor(send, 32); }
#pragma unroll
            for (int i = 0; i < 2; ++i) { const float send = h16 ? e[i] : e[i + 2], keep = h16 ? e[i + 2] : e[i]; f[i] = keep + __shfl_xor(send, 16); }
            { const float send = h8 ? f[0] : f[1], keep = h8 ? f[1] : f[0]; gs = keep + __shfl_xor(send, 8); }
            gs += __shfl_xor(gs, 4); gs += __shfl_xor(gs, 2); gs += __shfl_xor(gs, 1);
            if ((lane & 7) == 0) { float x = gs + bif;
                if (gi >= 4) x = fminf(x, 0.f) - __logf(1.0f + __expf(-fabsf(x)));
                IF[(size_t)row * 8 + gi] = x; }
        }
    }
    if (wave < 4) weight_items(p, (LAS float*)(lds + 32768 + wave * 8448), lane, wave, G);
}

constexpr int ML_QS = 0, ML_KS = 33792, ML_CB = 67584, ML_VS = 109824, ML_VW = 119040, ML_HS = 128256, ML_F = 137472;
__device__ __forceinline__ void mlstm_item(const Params& p, LAS unsigned char* lds, int b, int h, int vs, bool smp, bool dry) {
    int tid_ = threadIdx.x; asm volatile("" : "+v"(tid_));
    const int tid = tid_, lane = tid & 63, w = __builtin_amdgcn_readfirstlane(tid >> 6), g = lane >> 4, li = lane & 15, q4 = li >> 2, p4 = li & 3;
    unsigned char* ws = p.ws;
    const int L = smp ? DSEQ : 64, nch = smp ? 1 : SEQ / 64;
    const int row0 = smp ? NTP + b * DSEQ : b * SEQ;
    const bf16_t* qb = (smp ? (const bf16_t*)(ws + WS_SMALL + SM_Q * SMALL_B) + (size_t)(b * DSEQ) * DM : (const bf16_t*)(p.out) + (size_t)row0 * DM) + h * 256;
    const bf16_t* kb = (smp ? (const bf16_t*)(ws + WS_SMALL + SM_K * SMALL_B) + (size_t)(b * DSEQ) * DM : (const bf16_t*)((unsigned char*)p.out + 64 * MiB) + (size_t)row0 * DM) + h * 256;
    bf16_t* vb = (smp ? (bf16_t*)(ws + WS_SMALL + SM_V * SMALL_B) + (size_t)(b * DSEQ) * DM : (bf16_t*)(ws + WS_V) + (size_t)row0 * DM) + h * 256 + vs * 64;
    const float* IFb = (const float*)(ws + WS_IF) + (size_t)row0 * 8;
    float* HSSb = (float*)(ws + WS_HSS) + (size_t)row0 * 16 + h * 4 + vs;
    const bf16_t* ogb = (smp ? (const bf16_t*)(ws + WS_SMALL + SM_OG * SMALL_B) + (size_t)(b * DSEQ) * DM : (const bf16_t*)(ws + WS_OG) + (size_t)row0 * DM) + h * 256 + vs * 64;
    LAS float* F = (LAS float*)(lds + ML_F);
    LAS float *IG = F, *LF = F + 64, *HSQ = F + 128;
    LAS float *GGw = F + 264 + 320 * w, *MMw = GGw + 64, *SIw = GGw + 128, *EMw = GGw + 192, *WSw = GGw + 256;
    const int bh = b * 4 + h;
    const int vt = w & 3, ktb = (w >> 2) * 8, i0 = 2 * (w & 3);
    f32x4 cst[8], nst[2];
    float m_state;
    if (smp) {
        const float* C0 = p.in[4] + (size_t)bh * 65536 + (size_t)(vs * 64 + vt * 16 + li) * 256;
#pragma unroll
        for (int i = 0; i < 8; ++i) cst[i] = *(const f32x4*)(C0 + (ktb + i) * 16 + 4 * g);
#pragma unroll
        for (int q = 0; q < 2; ++q) nst[q] = (li == 0) ? *(const f32x4*)(p.in[5] + bh * 256 + (ktb + i0 + q) * 16 + 4 * g) : (f32x4){0.f, 0.f, 0.f, 0.f};
        m_state = p.in[6][bh];
    } else {
#pragma unroll
        for (int i = 0; i < 8; ++i) cst[i] = (f32x4){0.f, 0.f, 0.f, 0.f};
        nst[0] = (f32x4){0.f, 0.f, 0.f, 0.f}; nst[1] = nst[0];
        m_state = 0.f;
    }
#pragma unroll
    for (int i = 0; i < 8; ++i) { u32x2 wv; wv.x = pk2(cst[i][0], cst[i][1]); wv.y = pk2(cst[i][2], cst[i][3]);
        *(LAS u32x2*)(lds + ML_CB + (vt * 16 + li) * 528 + ((ktb + i) * 16 + 4 * g) * 2) = wv; }
    if (li == 0) {
#pragma unroll
        for (int q = 0; q < 2; ++q) { u32x2 wv; wv.x = pk2(nst[q][0], nst[q][1]); wv.y = pk2(nst[q][2], nst[q][3]);
            *(LAS u32x2*)(lds + ML_CB + 64 * 528 + ((ktb + i0 + q) * 16 + 4 * g) * 2) = wv; } }
    u32x4 rq[4], rk[4], rv; float rig = 0.f, rlf = 0.f;
    const u32x4 z4 = (u32x4){0u, 0u, 0u, 0u};
#define ML_PREFETCH(c) do { const int t0_ = (c) * 64; \
        _Pragma("unroll") for (int i_ = 0; i_ < 4; ++i_) { const int id_ = tid + 512 * i_, r_ = id_ >> 5, ch_ = id_ & 31; \
            if (!smp || r_ < L) { rq[i_] = *(const u32x4*)(qb + (size_t)(t0_ + r_) * DM + ch_ * 8); rk[i_] = *(const u32x4*)(kb + (size_t)(t0_ + r_) * DM + ch_ * 8); } else { rq[i_] = z4; rk[i_] = z4; } } \
        { const int r_ = tid >> 3, ch_ = tid & 7; rv = (!smp || r_ < L) ? *(const u32x4*)(vb + (size_t)(t0_ + r_) * DM + ch_ * 8) : z4; } \
        if (tid < 64) { if (!smp || tid < L) { rig = IFb[(size_t)(t0_ + tid) * 8 + h]; rlf = IFb[(size_t)(t0_ + tid) * 8 + 4 + h]; } else { rig = -INFINITY; rlf = 0.f; } } } while (0)
    ML_PREFETCH(0);
    bf16x8 ones; { const short o1 = (short)0x3F80;
#pragma unroll
        for (int j = 0; j < 8; ++j) ones[j] = o1; }
    const int tt = w >> 1, hb = (w & 1) * 2;
    for (int c = 0; c < nch; ++c) {
        const int t0 = c * 64;
#pragma unroll
        for (int i = 0; i < 4; ++i) { const int id = tid + 512 * i, r = id >> 5, ch = id & 31;
            *(LAS u32x4*)(lds + ML_QS + r * 528 + ch * 16) = rq[i]; *(LAS u32x4*)(lds + ML_KS + r * 528 + ch * 16) = rk[i]; }
        const u32x4 vcur = rv;
        { const int r = tid >> 3, ch = tid & 7; *(LAS u32x4*)(lds + ML_VS + r * 144 + ch * 16) = vcur; }
        if (tid < 64) { IG[tid] = rig; LF[tid] = rlf; }
        BAR_LDS();
        if (c + 1 < nch) ML_PREFETCH(c + 1);
        float decay, m_next;
        {
            const float bc = wave_scan_add(LF[lane]);
            const float gs = IG[lane] - bc;
            const float cm = wave_scan_max(gs);
            const float Mt = fmaxf(m_state, cm);
            const float ML_ = __builtin_bit_cast(float, __builtin_amdgcn_readlane(__builtin_bit_cast(int, Mt), 63));
            const float bL = __builtin_bit_cast(float, __builtin_amdgcn_readlane(__builtin_bit_cast(int, bc), 63));
            GGw[lane] = gs; MMw[lane] = Mt; SIw[lane] = __expf(m_state - Mt); EMw[lane] = __expf(-(bc + Mt)); WSw[lane] = __expf(gs - ML_);
            decay = __expf(m_state - ML_); m_next = bL + ML_;
        }
        { const int r = tid >> 3, ch = tid & 7; const float wsr = WSw[r];
          u32x4 o; o.x = pk2(bflo(vcur.x) * wsr, bfhi(vcur.x) * wsr); o.y = pk2(bflo(vcur.y) * wsr, bfhi(vcur.y) * wsr); o.z = pk2(bflo(vcur.z) * wsr, bfhi(vcur.z) * wsr); o.w = pk2(bflo(vcur.w) * wsr, bfhi(vcur.w) * wsr);
          *(LAS u32x4*)(lds + ML_VW + r * 144 + ch * 16) = o; }
        {
            bf16x8 qf[8];
#pragma unroll
            for (int kk = 0; kk < 8; ++kk) qf[kk] = *(const LAS bf16x8*)(lds + ML_QS + (tt * 16 + li) * 528 + (kk * 32 + g * 8) * 2);
            const float mt = MMw[tt * 16 + li];
            const int tq = tt * 16 + li;
            bf16x8 ap[2];
#pragma unroll
            for (int ks = 0; ks < 2; ++ks) {
                float pv[8];
#pragma unroll
                for (int hh = 0; hh < 2; ++hh) { const int st = 2 * ks + hh;
                    if (st <= tt) { f32x4 sa = (f32x4){0.f, 0.f, 0.f, 0.f};
#pragma unroll
                        for (int kk = 0; kk < 8; ++kk) { const bf16x8 kf = *(const LAS bf16x8*)(lds + ML_KS + (st * 16 + li) * 528 + (kk * 32 + g * 8) * 2); sa = __builtin_amdgcn_mfma_f32_16x16x32_bf16(kf, qf[kk], sa, 0, 0, 0); }
                        const f32x4 gv = *(const LAS f32x4*)(GGw + st * 16 + 4 * g);
#pragma unroll
                        for (int r = 0; r < 4; ++r) { const int sidx = st * 16 + 4 * g + r; pv[hh * 4 + r] = (sidx <= tq) ? sa[r] * __expf(gv[r] - mt) : 0.f; }
                    } else {
#pragma unroll
                        for (int r = 0; r < 4; ++r) pv[hh * 4 + r] = 0.f; } }
                union { u32x4 u; bf16x8 v; } cvt; cvt.u.x = pk2(pv[0], pv[1]); cvt.u.y = pk2(pv[2], pv[3]); cvt.u.z = pk2(pv[4], pv[5]); cvt.u.w = pk2(pv[6], pv[7]);
                ap[ks] = cvt.v;
            }
            f32x4 na[2], nq = (f32x4){0.f, 0.f, 0.f, 0.f}, ra = (f32x4){0.f, 0.f, 0.f, 0.f};
            na[0] = (f32x4){0.f, 0.f, 0.f, 0.f}; na[1] = na[0];
#pragma unroll
            for (int kk = 0; kk < 8; ++kk) {
                const bf16x8 c0 = *(const LAS bf16x8*)(lds + ML_CB + ((hb + 0) * 16 + li) * 528 + (kk * 32 + g * 8) * 2);
                const bf16x8 c1 = *(const LAS bf16x8*)(lds + ML_CB + ((hb + 1) * 16 + li) * 528 + (kk * 32 + g * 8) * 2);
                const bf16x8 cn = *(const LAS bf16x8*)(lds + ML_CB + 64 * 528 + (kk * 32 + g * 8) * 2);
                na[0] = __builtin_amdgcn_mfma_f32_16x16x32_bf16(qf[kk], c0, na[0], 0, 0, 0);
                na[1] = __builtin_amdgcn_mfma_f32_16x16x32_bf16(qf[kk], c1, na[1], 0, 0, 0);
                nq = __builtin_amdgcn_mfma_f32_16x16x32_bf16(qf[kk], cn, nq, 0, 0, 0);
            }
            const f32x4 si = *(const LAS f32x4*)(SIw + tt * 16 + 4 * g), em = *(const LAS f32x4*)(EMw + tt * 16 + 4 * g);
            na[0] = na[0] * si; na[1] = na[1] * si;
#pragma unroll
            for (int ks = 0; ks < 2; ++ks) if (2 * ks <= tt) {
                ra = __builtin_amdgcn_mfma_f32_16x16x32_bf16(ap[ks], ones, ra, 0, 0, 0);
#pragma unroll
                for (int j = 0; j < 2; ++j) {
                    const s16x4 v0 = __builtin_amdgcn_ds_read_tr16_b64_v4i16((LAS s16x4*)(lds + ML_VS + (ks * 32 + g * 4 + q4) * 144 + ((hb + j) * 16 + 4 * p4) * 2));
                    const s16x4 v1 = __builtin_amdgcn_ds_read_tr16_b64_v4i16((LAS s16x4*)(lds + ML_VS + (ks * 32 + 16 + g * 4 + q4) * 144 + ((hb + j) * 16 + 4 * p4) * 2));
                    bf16x8 bv; bv[0] = v0[0]; bv[1] = v0[1]; bv[2] = v0[2]; bv[3] = v0[3]; bv[4] = v1[0]; bv[5] = v1[1]; bv[6] = v1[2]; bv[7] = v1[3];
                    na[j] = __builtin_amdgcn_mfma_f32_16x16x32_bf16(ap[ks], bv, na[j], 0, 0, 0);
                }
            }
#pragma unroll
            for (int r = 0; r < 4; ++r) { const int t = tt * 16 + 4 * g + r;
                const float den = si[r] * nq[r] + ra[r]; const float inv = __builtin_amdgcn_rcpf(fmaxf(fabsf(den), em[r]));
                const float h0 = na[0][r] * inv, h1 = na[1][r] * inv;
                *(LAS bf16_t*)(lds + ML_HS + t * 144 + ((hb + 0) * 16 + li) * 2) = (bf16_t)f2bf(h0);
                *(LAS bf16_t*)(lds + ML_HS + t * 144 + ((hb + 1) * 16 + li) * 2) = (bf16_t)f2bf(h1);
                float sq = h0 * h0 + h1 * h1;
                sq = row16_sum(sq);
                HSQ[t * 2 + (w & 1)] = sq; }
        }
        BAR_LDS();
        u32x4 ogv = (u32x4){0u, 0u, 0u, 0u};
        { const int r = tid >> 3, ch = tid & 7; if (!smp || r < L) ogv = *(const u32x4*)(ogb + (size_t)(t0 + r) * DM + ch * 8); }
        if (tid < L && !dry) HSSb[(size_t)(t0 + tid) * 16] = HSQ[tid * 2] + HSQ[tid * 2 + 1];
        {
            bf16x8 bvw[2], bws[2];
#pragma unroll
            for (int ks = 0; ks < 2; ++ks) {
                const s16x4 v0 = __builtin_amdgcn_ds_read_tr16_b64_v4i16((LAS s16x4*)(lds + ML_VW + (ks * 32 + g * 8 + 0 + q4) * 144 + (vt * 16 + 4 * p4) * 2));
                const s16x4 v1 = __builtin_amdgcn_ds_read_tr16_b64_v4i16((LAS s16x4*)(lds + ML_VW + (ks * 32 + g * 8 + 4 + q4) * 144 + (vt * 16 + 4 * p4) * 2));
                bvw[ks][0] = v0[0]; bvw[ks][1] = v0[1]; bvw[ks][2] = v0[2]; bvw[ks][3] = v0[3]; bvw[ks][4] = v1[0]; bvw[ks][5] = v1[1]; bvw[ks][6] = v1[2]; bvw[ks][7] = v1[3];
                const f32x4 w0 = *(const LAS f32x4*)(WSw + ks * 32 + g * 8), w1 = *(const LAS f32x4*)(WSw + ks * 32 + g * 8 + 4);
                union { u32x4 u; bf16x8 v; } cvt; cvt.u.x = pk2(w0[0], w0[1]); cvt.u.y = pk2(w0[2], w0[3]); cvt.u.z = pk2(w1[0], w1[1]); cvt.u.w = pk2(w1[2], w1[3]);
                if (li != 0) cvt.u = (u32x4){0u, 0u, 0u, 0u};
                bws[ks] = cvt.v; }
            nst[0] = nst[0] * decay; nst[1] = nst[1] * decay;
#pragma unroll
            for (int i = 0; i < 8; ++i) { const int kt = ktb + i; cst[i] = cst[i] * decay;
                const bool mine = ((i >> 1) == (w & 3));
#pragma unroll
                for (int ks = 0; ks < 2; ++ks) {
                    const s16x4 k0 = __builtin_amdgcn_ds_read_tr16_b64_v4i16((LAS s16x4*)(lds + ML_KS + (ks * 32 + g * 8 + 0 + q4) * 528 + (kt * 16 + 4 * p4) * 2));
                    const s16x4 k1 = __builtin_amdgcn_ds_read_tr16_b64_v4i16((LAS s16x4*)(lds + ML_KS + (ks * 32 + g * 8 + 4 + q4) * 528 + (kt * 16 + 4 * p4) * 2));
                    bf16x8 ak; ak[0] = k0[0]; ak[1] = k0[1]; ak[2] = k0[2]; ak[3] = k0[3]; ak[4] = k1[0]; ak[5] = k1[1]; ak[6] = k1[2]; ak[7] = k1[3];
                    cst[i] = __builtin_amdgcn_mfma_f32_16x16x32_bf16(ak, bvw[ks], cst[i], 0, 0, 0);
                    if (mine) nst[i & 1] = __builtin_amdgcn_mfma_f32_16x16x32_bf16(ak, bws[ks], nst[i & 1], 0, 0, 0); }
                u32x2 wv; wv.x = pk2(cst[i][0], cst[i][1]); wv.y = pk2(cst[i][2], cst[i][3]);
                *(LAS u32x2*)(lds + ML_CB + (vt * 16 + li) * 528 + (kt * 16 + 4 * g) * 2) = wv; }
            if (li == 0) {
#pragma unroll
                for (int q = 0; q < 2; ++q) { u32x2 wv; wv.x = pk2(nst[q][0], nst[q][1]); wv.y = pk2(nst[q][2], nst[q][3]);
                    *(LAS u32x2*)(lds + ML_CB + 64 * 528 + ((ktb + i0 + q) * 16 + 4 * g) * 2) = wv; } }
        }
        { const int r = tid >> 3, ch = tid & 7; if ((!smp || r < L) && !dry) { const u32x4 hv = *(const LAS u32x4*)(lds + ML_HS + r * 144 + ch * 16); u32x4 o;
            o.x = pk2(bflo(hv.x) * bflo(ogv.x), bfhi(hv.x) * bfhi(ogv.x)); o.y = pk2(bflo(hv.y) * bflo(ogv.y), bfhi(hv.y) * bfhi(ogv.y));
            o.z = pk2(bflo(hv.z) * bflo(ogv.z), bfhi(hv.z) * bfhi(ogv.z)); o.w = pk2(bflo(hv.w) * bflo(ogv.w), bfhi(hv.w) * bfhi(ogv.w));
            *(u32x4*)(vb + (size_t)(t0 + r) * DM + ch * 8) = o; } }
        BAR_LDS();
        m_state = m_next;
    }
    if (!dry) {
        float* Co = p.out + (smp ? O_CS : O_CP) + (size_t)bh * 65536 + (size_t)(vs * 64 + vt * 16 + li) * 256;
#pragma unroll
        for (int i = 0; i < 8; ++i) *(f32x4*)(Co + (ktb + i) * 16 + 4 * g) = cst[i];
        if (vs == 0) {
            if (li == 0) {
#pragma unroll
                for (int q = 0; q < 2; ++q) *(f32x4*)(p.out + (smp ? O_NS : O_NP) + bh * 256 + (ktb + i0 + q) * 16 + 4 * g) = nst[q]; }
            if (tid == 0) p.out[(smp ? O_MS : O_MP) + bh] = m_state; }
    }
    __syncthreads();
#undef ML_PREFETCH
}

constexpr int RG_XR = 0, RG_XC = 18432, RG_W = 36864, RG_EX = 71680, RG_HC = 72704, RG_ZS = 73216;
__device__ __forceinline__ void rglru_item(const Params& p, LAS unsigned char* lds, int b, int n, int hf, bool smp, bool dry) {
    int tid_ = threadIdx.x; asm volatile("" : "+v"(tid_));
    const int tid = tid_, lane = tid & 63, w = __builtin_amdgcn_readfirstlane(tid >> 6), g = lane >> 4, li = lane & 15;
    unsigned char* ws = p.ws;
    const int L = smp ? DSEQ : SEQ, ntile = smp ? 1 : SEQ / 64;
    const int row0 = smp ? NTP + b * DSEQ : b * SEQ;
    const bf16_t* xbp = (smp ? (const bf16_t*)(ws + WS_SMALL + SM_XB * SMALL_B) + (size_t)(b * DSEQ) * DM : (const bf16_t*)(ws + WS_XB) + (size_t)row0 * DM) + n * 128;
    bf16_t* zbp = (smp ? (bf16_t*)(ws + WS_SMALL + SM_SZB * SMALL_B) + (size_t)(b * DSEQ) * DM : (bf16_t*)(ws + WS_SZB) + (size_t)row0 * DM) + n * 128 + hf * 64;
    const float* cvs = p.in[8] + (size_t)b * 3 * DM + n * 128;
    LAS float* EX = (LAS float*)(lds + RG_EX); LAS float* HC = (LAS float*)(lds + RG_HC);
    for (int id = tid; id < 2 * 64 * 16; id += 512) { const int gt = id >> 10, j = (id >> 4) & 63, ch = id & 15;
        *(LAS u32x4*)(lds + RG_W + (gt * 64 + j) * 272 + ch * 16) = *(const u32x4*)((const bf16_t*)(ws + (gt ? WS_WRXT : WS_WRAT)) + (size_t)n * 16384 + (size_t)(hf * 64 + j) * 128 + ch * 8); }
    const int jt = w & 3, th = w >> 2, jc = jt * 16 + li, chn = n * 128 + hf * 64 + jc;
    const float bra = p.in[18][chn], brx = p.in[20][chn];
    float spl; { const float lm = p.in[21][chn]; spl = fmaxf(-lm, 0.f) + log1pf(__expf(-fabsf(lm))); }
    float gw_[4]; const float gb_ = p.in[16][chn];
#pragma unroll
    for (int j = 0; j < 4; ++j) gw_[j] = p.in[15][j * DM + chn];
    const int c2 = tid & 63, tq = tid >> 6;
    float cw[4][2], cb[2];
#pragma unroll
    for (int j = 0; j < 4; ++j) { cw[j][0] = p.in[15][j * DM + n * 128 + 2 * c2]; cw[j][1] = p.in[15][j * DM + n * 128 + 2 * c2 + 1]; }
    cb[0] = p.in[16][n * 128 + 2 * c2]; cb[1] = p.in[16][n * 128 + 2 * c2 + 1];
    if (tid < 64) { HC[tid] = smp ? p.in[7][b * DM + n * 128 + hf * 64 + tid] : 0.f; }
    u32x4 rx[3], rzv;
    const u32x4 z4 = (u32x4){0u, 0u, 0u, 0u};
#define RG_PREFETCH(tl) do { const int t0_ = (tl) * 64; \
        _Pragma("unroll") for (int i_ = 0; i_ < 3; ++i_) { const int id_ = tid + 512 * i_, r_ = id_ >> 4, ch_ = id_ & 15, tok_ = t0_ - 3 + r_; rx[i_] = z4; \
            if (id_ < 67 * 16) { if (tok_ >= 0 && (!smp || tok_ < L)) rx[i_] = *(const u32x4*)(xbp + (size_t)tok_ * DM + ch_ * 8); \
                else if (tok_ < 0 && smp) { const float* s_ = cvs + (size_t)(tok_ + 3) * DM + ch_ * 8; const f32x4 a_ = *(const f32x4*)s_, b_ = *(const f32x4*)(s_ + 4); \
                    rx[i_].x = pk2(a_[0], a_[1]); rx[i_].y = pk2(a_[2], a_[3]); rx[i_].z = pk2(b_[0], b_[1]); rx[i_].w = pk2(b_[2], b_[3]); } } } \
        { const int r_ = tid >> 3, ch_ = tid & 7; rzv = (!smp || t0_ + r_ < L) ? *(const u32x4*)(zbp + (size_t)(t0_ + r_) * DM + ch_ * 8) : z4; } } while (0)
    RG_PREFETCH(0);
    for (int tl = 0; tl < ntile; ++tl) {
        const int t0 = tl * 64;
#pragma unroll
        for (int i = 0; i < 3; ++i) { const int id = tid + 512 * i, r = id >> 4, ch = id & 15; if (id < 67 * 16) *(LAS u32x4*)(lds + RG_XR + r * 272 + ch * 16) = rx[i]; }
        { const int r = tid >> 3, ch = tid & 7; *(LAS u32x4*)(lds + RG_ZS + (tl & 1) * 9216 + r * 144 + ch * 16) = rzv; }
        BAR_LDS();
        if (tl > 0 && !dry) { const int r = tid >> 3, ch = tid & 7;
            *(u32x4*)(zbp + (size_t)(t0 - 64 + r) * DM + ch * 8) = *(const LAS u32x4*)(lds + RG_ZS + ((tl - 1) & 1) * 9216 + r * 144 + ch * 16); }
        if (tl == ntile - 1 && tid < 192 && !dry) {
            const int j = tid >> 6, c = tid & 63, rr = (L - t0) + j;
            p.out[(smp ? O_CVS : O_CVP) + ((size_t)b * 3 + j) * DM + n * 128 + hf * 64 + c] = bf2f(*(const LAS bf16_t*)(lds + RG_XR + rr * 272 + (hf * 64 + c) * 2));
        }
        if (tl + 1 < ntile) RG_PREFETCH(tl + 1);
        { float x0[3], x1[3];
#pragma unroll
          for (int j = 0; j < 3; ++j) { const unsigned wv = *(const LAS unsigned*)(lds + RG_XR + (tq * 8 + j) * 272 + c2 * 4); x0[j] = bflo(wv); x1[j] = bfhi(wv); }
#pragma unroll
          for (int i = 0; i < 8; ++i) { const int t = tq * 8 + i; const unsigned wv = *(const LAS unsigned*)(lds + RG_XR + (t + 3) * 272 + c2 * 4); const float n0 = bflo(wv), n1 = bfhi(wv);
              const float y0 = cb[0] + cw[0][0] * x0[0] + cw[1][0] * x0[1] + cw[2][0] * x0[2] + cw[3][0] * n0;
              const float y1 = cb[1] + cw[0][1] * x1[0] + cw[1][1] * x1[1] + cw[2][1] * x1[2] + cw[3][1] * n1;
              x0[0] = x0[1]; x0[1] = x0[2]; x0[2] = n0; x1[0] = x1[1]; x1[1] = x1[2]; x1[2] = n1;
              *(LAS unsigned*)(lds + RG_XC + t * 272 + c2 * 4) = pk2(y0, y1); } }
        BAR_LDS();
        float av[2][4], bv[2][4], TA[2], TB[2], EA[2], EB[2];
        {
            bf16x8 wr_[4], wi_[4];
#pragma unroll
            for (int kk = 0; kk < 4; ++kk) { wr_[kk] = *(const LAS bf16x8*)(lds + RG_W + jc * 272 + (kk * 32 + g * 8) * 2); wi_[kk] = *(const LAS bf16x8*)(lds + RG_W + (64 + jc) * 272 + (kk * 32 + g * 8) * 2); }
#pragma unroll
            for (int q = 0; q < 2; ++q) { const int tt = 2 * th + q;
                f32x4 ar = (f32x4){0.f, 0.f, 0.f, 0.f}, ai = (f32x4){0.f, 0.f, 0.f, 0.f};
#pragma unroll
                for (int kk = 0; kk < 4; ++kk) { const bf16x8 ax = *(const LAS bf16x8*)(lds + RG_XC + (tt * 16 + li) * 272 + (kk * 32 + g * 8) * 2);
                    ar = __builtin_amdgcn_mfma_f32_16x16x32_bf16(ax, wr_[kk], ar, 0, 0, 0); ai = __builtin_amdgcn_mfma_f32_16x16x32_bf16(ax, wi_[kk], ai, 0, 0, 0); }
                float xw[7];
#pragma unroll
                for (int k = 0; k < 7; ++k) xw[k] = bf2f(*(const LAS bf16_t*)(lds + RG_XR + (tt * 16 + 4 * g + k) * 272 + (hf * 64 + jc) * 2));
                float A4 = 1.f, B4 = 0.f;
#pragma unroll
                for (int r = 0; r < 4; ++r) { const int t = tt * 16 + 4 * g + r;
                    const float xc = gb_ + gw_[0] * xw[r] + gw_[1] * xw[r + 1] + gw_[2] * xw[r + 2] + gw_[3] * xw[r + 3];
                    const float rg = sigm(ar[r] + bra), ig = sigm(ai[r] + brx);
                    const float la = -8.0f * rg * spl; const float a = __expf(la);
                    const float x2 = 2.0f * la;
                    const float pm = x2 * (1.0f + x2 * (0.5f + x2 * (0.16666667f + x2 * (0.041666668f + x2 * (0.0083333338f + x2 * (0.0013888889f + x2 * 0.0001984127f))))));
                    const float om = (x2 > -0.5f) ? -pm : 1.0f - __expf(x2);
                    float mult = __builtin_amdgcn_sqrtf(om); if (!smp && (t0 + t) == 0) mult = 1.0f;
                    const float bt = mult * ig * xc;
                    av[q][r] = a; bv[q][r] = bt; B4 = a * B4 + bt; A4 *= a; }
                { const float pA = __shfl_up(A4, 16), pB = __shfl_up(B4, 16); if (g >= 1) { B4 = A4 * pB + B4; A4 = A4 * pA; } }
                { const float pA = __shfl_up(A4, 32), pB = __shfl_up(B4, 32); if (g >= 2) { B4 = A4 * pB + B4; A4 = A4 * pA; } }
                { const float pA = __shfl_up(A4, 16), pB = __shfl_up(B4, 16); EA[q] = (g >= 1) ? pA : 1.f; EB[q] = (g >= 1) ? pB : 0.f; }
                TA[q] = __shfl(A4, 48 + li); TB[q] = __shfl(B4, 48 + li);
            }
            { EX[(th * 64 + jc) * 2] = TA[0] * TA[1]; EX[(th * 64 + jc) * 2 + 1] = TA[1] * TB[0] + TB[1]; }
        }
        BAR_LDS();
        {
            float hin = HC[(tl & 1) * 64 + jc];
            if (th == 1) hin = EX[jc * 2] * hin + EX[jc * 2 + 1];
            if (th == 1) HC[((tl + 1) & 1) * 64 + jc] = (TA[0] * TA[1]) * hin + (TA[1] * TB[0] + TB[1]);
#pragma unroll
            for (int q = 0; q < 2; ++q) { const int tt = 2 * th + q;
                float hcur = EA[q] * hin + EB[q];
#pragma unroll
                for (int r = 0; r < 4; ++r) { const int tok = t0 + tt * 16 + 4 * g + r;
                    hcur = av[q][r] * hcur + bv[q][r];
                    { LAS bf16_t* zp = (LAS bf16_t*)(lds + RG_ZS + (tl & 1) * 9216 + (tt * 16 + 4 * g + r) * 144 + jc * 2); *zp = (bf16_t)f2bf(bf2f(*zp) * hcur); }
                    if ((!smp || tok < L) && !dry && tok == L - 1) p.out[(smp ? O_HS : O_HP) + (size_t)b * DM + chn] = hcur; }
                hin = TA[q] * hin + TB[q];
            }
        }
    }
    BAR_LDS();
    if (!dry) { const int r = tid >> 3, ch = tid & 7, tlast = (ntile - 1) * 64;
        if (tlast + r < L) *(u32x4*)(zbp + (size_t)(tlast + r) * DM + ch * 8) = *(const LAS u32x4*)(lds + RG_ZS + ((ntile - 1) & 1) * 9216 + r * 144 + ch * 16); }
    __syncthreads();
#undef RG_PREFETCH
}

__device__ __forceinline__ void phase3(const Params& p, LAS unsigned char* lds) {
    const int G = gridDim.x;
    for (int it = blockIdx.x; it < 256; it += G) { const int bh = (it & 7) * 8 + (it >> 5), vs = (it >> 3) & 3; mlstm_item(p, lds, bh >> 2, bh & 3, vs, false, false); }
    for (int it = blockIdx.x; it < 256; it += G) { const int q = (it & 7) * 16 + (it >> 4), hf = (it >> 3) & 1; rglru_item(p, lds, q >> 3, q & 7, hf, false, false); }
    for (int it = blockIdx.x; it < 128; it += G) mlstm_item(p, lds, it >> 4, (it >> 2) & 3, it & 3, true, false);
    for (int it = blockIdx.x; it < 256; it += G) if (it >= 128) { const int q = it - 128; rglru_item(p, lds, q >> 4, (q >> 1) & 7, q & 1, true, false); }
}

__device__ __forceinline__ void phase4(const Params& p) {
    unsigned char* ws = p.ws;
    TV YA{(bf16_t*)(ws + WS_V), (bf16_t*)(ws + WS_SMALL + SM_V * SMALL_B)}, OG{(bf16_t*)(ws + WS_OG), (bf16_t*)(ws + WS_SMALL + SM_OG * SMALL_B)};
    const float* HSS = (const float*)(ws + WS_HSS); const float* gh = p.in[14];
    for (int id = blockIdx.x * 512 + threadIdx.x; id < NTT * 128; id += gridDim.x * 512) {
        const int row = id >> 7, ch = id & 127, hd = ch >> 5;
        const f32x4 hs = *(const f32x4*)(HSS + (size_t)row * 16 + hd * 4);
        const float rs = rsqrtf(((hs[0] + hs[1]) + (hs[2] + hs[3])) * (1.0f / 256.0f) + EPS);
        bf16_t* yp = tv_row(YA, row) + ch * 8; const bf16_t* op = tv_row(OG, row) + ch * 8;
        const u32x4 hv = *(const u32x4*)yp, ov = *(const u32x4*)op; const f32x4 g0 = *(const f32x4*)(gh + ch * 8), g1 = *(const f32x4*)(gh + ch * 8 + 4);
        u32x4 o;
        o.x = pk2(bflo(hv.x) * bflo(ov.x) * rs * g0[0], bfhi(hv.x) * bfhi(ov.x) * rs * g0[1]);
        o.y = pk2(bflo(hv.y) * bflo(ov.y) * rs * g0[2], bfhi(hv.y) * bfhi(ov.y) * rs * g0[3]);
        o.z = pk2(bflo(hv.z) * bflo(ov.z) * rs * g1[0], bfhi(hv.z) * bfhi(ov.z) * rs * g1[1]);
        o.w = pk2(bflo(hv.w) * bflo(ov.w) * rs * g1[2], bfhi(hv.w) * bfhi(ov.w) * rs * g1[3]);
        *(u32x4*)yp = o;
    }
}

__device__ __forceinline__ void phase7(const Params& p) {
    const int lane = threadIdx.x & 63, wave = threadIdx.x >> 6;
    const float* rowss = (const float*)(p.ws + WS_ROWSS); const float* gf = p.in[27];
    f32x4 gv[4];
#pragma unroll
    for (int j = 0; j < 4; ++j) gv[j] = *(const f32x4*)(gf + 4 * lane + 256 * j);
    const bf16_t* ybf = (const bf16_t*)(p.ws + WS_V);
    const int gw = blockIdx.x * 8 + wave, NGW = gridDim.x * 8;
    for (int r0 = gw; r0 < NTP; r0 += 4 * NGW) {
        u32x2 w[4][4]; float part[4];
#pragma unroll
        for (int q = 0; q < 4; ++q) { const int row = r0 + q * NGW; const bool ok = row < NTP; const int rr = ok ? row : r0;
#pragma unroll
            for (int j = 0; j < 4; ++j) w[q][j] = *(const u32x2*)(ybf + (size_t)rr * DM + 4 * lane + 256 * j);
            part[q] = lane < 16 ? rowss[(size_t)rr * 16 + lane] : 0.f; }
#pragma unroll
        for (int q = 0; q < 4; ++q) { const int row = r0 + q * NGW; if (row < NTP) {
            const float rs = rsqrtf(wave_sum(part[q]) * (1.0f / DM) + EPS);
            float* yr = p.out + O_YP + (size_t)row * DM;
#pragma unroll
            for (int j = 0; j < 4; ++j) { const f32x4 v = (f32x4){bflo(w[q][j].x), bfhi(w[q][j].x), bflo(w[q][j].y), bfhi(w[q][j].y)}; *(f32x4*)(yr + 4 * lane + 256 * j) = v * rs * gv[j]; } } }
    }
    for (int row = gw; row < NTS; row += NGW) {
        float* yr = p.out + O_YS + (size_t)row * DM;
        f32x4 v[4]; float part = 0.f;
#pragma unroll
        for (int j = 0; j < 4; ++j) { v[j] = *(const f32x4*)(yr + 4 * lane + 256 * j); part += (v[j][0] * v[j][0] + v[j][1] * v[j][1]) + (v[j][2] * v[j][2] + v[j][3] * v[j][3]); }
        const float rs = rsqrtf(wave_sum(part) * (1.0f / DM) + EPS);
#pragma unroll
        for (int j = 0; j < 4; ++j) *(f32x4*)(yr + 4 * lane + 256 * j) = v[j] * rs * gv[j];
    }
}

__global__ void __launch_bounds__(512) fwd_kernel(Params p) {
    extern __shared__ __attribute__((aligned(16))) unsigned char lds_raw[];
    LAS unsigned char* lds = (LAS unsigned char*)lds_raw;
    unsigned char* ws = p.ws;
    const int lo = p.ph_lo, hi = p.ph_hi;
#ifndef REP2
#define REP2 1
#define REP56 1
#define REP01 1
#ifndef PROBE_MODE
#define PROBE_MODE 0
#endif
#endif
#ifndef PH_MASK
#define PH_MASK 255
#endif
#define IN(k) (((PH_MASK >> (k)) & 1) && lo <= (k) && (k) < hi)
    { volatile LAS unsigned* stw = (volatile LAS unsigned*)(lds + LDS_BARW); if (threadIdx.x < 2) stw[threadIdx.x] = 0u; }
    __syncthreads();
    XcdBarrier xbar = xcd_barrier_post((unsigned*)(ws + WS_BAR), (volatile LAS unsigned*)(lds + LDS_BARW));
#define SEAM(k) do { if (IN(k) && IN((k) + 1)) { xcd_barrier(xbar); } } while (0)
    if (p.ph_hi > 1000) cg::this_grid().sync();
    auto small = [&](int i) { return (bf16_t*)(ws + WS_SMALL + (size_t)i * SMALL_B); };
    TV tU{(bf16_t*)(ws + WS_U), small(SM_U)}, tQ{(bf16_t*)p.out, small(SM_Q)}, tK{(bf16_t*)((unsigned char*)p.out + 64 * MiB), small(SM_K)},
       tV{(bf16_t*)(ws + WS_V), small(SM_V)}, tOG{(bf16_t*)(ws + WS_OG), small(SM_OG)}, tXB{(bf16_t*)(ws + WS_XB), small(SM_XB)},
       tSZB{(bf16_t*)(ws + WS_SZB), small(SM_SZB)}, tGA{(bf16_t*)(ws + WS_GA), small(SM_GA)}, tGB{(bf16_t*)(ws + WS_GB), small(SM_GB)};
    if (IN(0)) { phase0(p, lds); } SEAM(0);
    if (IN(1)) { phase1(p, lds); } SEAM(1);
#if REP01 > 1
    phase0(p, lds); cg::this_grid().sync(); phase1(p, lds); cg::this_grid().sync();
#endif
    if (IN(2)) {
        pg8::StaticOrder S; S.init(129, 36, gridDim.x, blockIdx.x);
        Epi1 E{tQ, tK, tV, tOG, tXB, tSZB, tGA, tGB, p.in[23]};
        Prob1 P{tU, (const bf16_t*)(ws + WS_W1T)};
        pg8::gemm_phase(lds, DM, S, E, P);
    } SEAM(2);
    if (IN(3)) { phase3(p, lds); } SEAM(3);
    if (IN(5)) {
        {
            pg8::PairOrder S0; S0.init(128, 4, gridDim.x, blockIdx.x);
            const int ord = threadIdx.x >> 8, rl = threadIdx.x & 255; pg8::Unit u0;
            if (S0.next(2 * ord, u0)) { const float* hss = (const float*)(ws + WS_HSS) + (size_t)(u0.pm * 256 + rl) * 16; f32x4 o;
#pragma unroll
                for (int hd = 0; hd < 4; ++hd) { const f32x4 hs = *(const f32x4*)(hss + hd * 4); o[hd] = rsqrtf(((hs[0] + hs[1]) + (hs[2] + hs[3])) * (1.0f / 256.0f) + EPS); }
                *(LAS f32x4*)(lds + RS_OFF + (ord * 256 + rl) * 16) = o; }
            __syncthreads();
        }
        pg8::PairOrder S; S.init(128, 4, gridDim.x, blockIdx.x);
        Epi2 E{tGA, tGB, tU};
        Prob2 P{tV, tSZB, (const bf16_t*)(ws + WS_WAT), (const bf16_t*)(ws + WS_WBT)};
        pg8::gemm_phase(lds, DM, S, E, P);
        mini_gemm2(p, lds);
#if REP56 > 1
        cg::this_grid().sync();
        pg8::gemm_phase(lds, DM, S, E, P);
#endif
    } SEAM(5);
    if (IN(6)) {
        pg8::StaticOrder S; S.init(128, 4, gridDim.x, blockIdx.x);
        Epi3 E{p.in[0], (bf16_t*)(ws + WS_V), (const float*)(ws + WS_MODG), (float*)(ws + WS_ROWSS)};
        Prob3 P{tU, (const bf16_t*)(ws + WS_WOT)};
        pg8::gemm_phase(lds, DM, S, E, P);
        mini_gemm3(p, lds);
#if REP56 > 1
        cg::this_grid().sync();
        pg8::gemm_phase(lds, DM, S, E, P);
#endif
    } SEAM(6);
    if (IN(7)) { phase7(p); }
#if SYNC_PROBE
    for (int i_ = 0; i_ < 8; ++i_) cg::this_grid().sync();
#endif
#undef IN
#undef SEAM
}

extern "C" void kernel_launch(void* const* d_in, const int* in_sizes, int n_in, void* d_out, int out_size, void* d_ws, size_t ws_size, hipStream_t stream) {
    static int grid = 0;
    if (grid == 0) {
        if (n_in != 28 || out_size != (int)O_END || ws_size < WS_END) { fprintf(stderr, "kernel_launch: unexpected shapes (n_in %d out %d ws %zu)\n", n_in, out_size, ws_size); grid = -1; return; }
        int dev = 0, cus = 0, per_cu = 0;
        hipGetDevice(&dev); hipDeviceGetAttribute(&cus, hipDeviceAttributeMultiprocessorCount, dev);
        hipFuncSetAttribute((const void*)fwd_kernel, hipFuncAttributeMaxDynamicSharedMemorySize, LDS_BYTES);
        hipOccupancyMaxActiveBlocksPerMultiprocessor(&per_cu, (const void*)fwd_kernel, 512, LDS_BYTES);
        if (per_cu < 1) { fprintf(stderr, "kernel_launch: occupancy query says %d blocks per CU\n", per_cu); grid = -1; return; }
        grid = cus;
        (void)hipGetLastError();
    }
    if (grid < 0) return;
    Params p{};
    for (int i = 0; i < 28; ++i) p.in[i] = (const float*)d_in[i];
    p.out = (float*)d_out; p.ws = (unsigned char*)d_ws; p.probe = PROBE_MODE;
#if MK_ONE_LAUNCH
    if (hipMemsetAsync((char*)d_ws + WS_BAR, 0, 16384, stream) != hipSuccess) { fprintf(stderr, "kernel_launch: memset of the barrier words failed\n"); return; }
    p.ph_lo = 0; p.ph_hi = 8;
    void* args[] = {&p};
    hipError_t e = hipLaunchCooperativeKernel((const void*)fwd_kernel, dim3(grid), dim3(512), args, LDS_BYTES, stream);
    if (e != hipSuccess) fprintf(stderr, "cooperative launch failed: %s (grid %d)\n", hipGetErrorString(e), grid);
#else
    for (int k = 0; k < 8; ++k) { p.ph_lo = k; p.ph_hi = k + 1; hipLaunchKernelGGL(fwd_kernel, dim3(grid), dim3(512), LDS_BYTES, stream, p); }
#endif
}
```

```cpp
#include <hip/hip_runtime.h>
#include <hip/hip_cooperative_groups.h>
#include <cstdio>
#include <cstdint>
namespace cg = cooperative_groups;

#ifndef GEMM_DRAIN
#define GEMM_DRAIN 0
#endif
#ifndef SYNC_PROBE
#define SYNC_PROBE 0
#endif
#ifndef MK_ONE_LAUNCH
#define MK_ONE_LAUNCH 1
#endif

#define LAS __attribute__((address_space(3)))
typedef unsigned short bf16_t;
typedef short bf16x8 __attribute__((ext_vector_type(8)));
typedef short s16x4 __attribute__((ext_vector_type(4)));
typedef float f32x4 __attribute__((ext_vector_type(4)));
typedef unsigned u32x4 __attribute__((ext_vector_type(4)));
typedef unsigned u32x2 __attribute__((ext_vector_type(2)));

constexpr int DM = 1024, NTP = 32768, NTS = 128, NTT = NTP + NTS, SEQ = 2048, DSEQ = 16;
constexpr int DIN = 7176;
constexpr float EPS = 1e-6f;
constexpr size_t MiB = 1u << 20;
constexpr size_t WS_U = 0 * MiB, WS_V = 64 * MiB, WS_OG = 128 * MiB, WS_XB = 192 * MiB, WS_SZB = 256 * MiB, WS_GA = 320 * MiB, WS_GB = 384 * MiB;
constexpr size_t WS_W1T = 448 * MiB, WS_WAT = 466 * MiB, WS_WBT = 468 * MiB, WS_WOT = 470 * MiB, WS_WRAT = 472 * MiB, WS_WRXT = 472 * MiB + 256 * 1024;
constexpr size_t WS_SMALL = 473 * MiB, SMALL_B = 512 * 1024;
enum { SM_U = 0, SM_Q, SM_K, SM_V, SM_OG, SM_XB, SM_SZB, SM_GA, SM_GB, SM_N };
constexpr size_t WS_IF = 478 * MiB, WS_HSS = 480 * MiB, WS_ROWSS = 483 * MiB, WS_MODP = 486 * MiB, WS_WIF = 488 * MiB, WS_BAR = 489 * MiB, WS_END = 490 * MiB, WS_MODG = 487 * MiB + 256 * 1024;
constexpr size_t O_YP = 0, O_YS = 33554432, O_CP = 33685504, O_NP = 37879808, O_MP = 37896192, O_HP = 37896256, O_CVP = 37912640,
                 O_CS = 37961792, O_NS = 40058944, O_MS = 40067136, O_HS = 40067168, O_CVS = 40075360, O_END = 40099936;
constexpr int LDS_BYTES = 151552, LDS_BARW = 151040, RS_OFF = 131072, PF_OFF = 139264;

struct Params { const float* in[28]; float* out; unsigned char* ws; int ph_lo, ph_hi, probe, pad; };

typedef float f32x2_t __attribute__((ext_vector_type(2)));
typedef __bf16 bf16x2_t __attribute__((ext_vector_type(2)));
__device__ __forceinline__ unsigned pk2(float lo, float hi) { f32x2_t v = {lo, hi}; bf16x2_t b = __builtin_convertvector(v, bf16x2_t); return __builtin_bit_cast(unsigned, b); }
__device__ __forceinline__ unsigned f2bf(float f) { return pk2(f, 0.f) & 0xffffu; }
__device__ __forceinline__ float bf2f(unsigned b) { return __uint_as_float(b << 16); }
__device__ __forceinline__ float bflo(unsigned w) { return __uint_as_float(w << 16); }
__device__ __forceinline__ float bfhi(unsigned w) { return __uint_as_float(w & 0xffff0000u); }
__device__ __forceinline__ float sigm(float x) { return __builtin_amdgcn_rcpf(1.0f + __expf(-x)); }
__device__ __forceinline__ float wave_sum_bperm(float v) {
#pragma unroll
    for (int o = 1; o < 64; o <<= 1) v += __shfl_xor(v, o);
    return v;
}

template <int CTRL, int ROWMASK> __device__ __forceinline__ float dpp_f(float oldv, float src) {
    return __builtin_bit_cast(float, __builtin_amdgcn_update_dpp(__builtin_bit_cast(int, oldv), __builtin_bit_cast(int, src), CTRL, ROWMASK, 0xf, false)); }
__device__ __forceinline__ float row16_sum(float v) {
    v += dpp_f<0xB1, 0xf>(0.f, v); v += dpp_f<0x4E, 0xf>(0.f, v); v += dpp_f<0x124, 0xf>(0.f, v); v += dpp_f<0x128, 0xf>(0.f, v); return v; }
__device__ __forceinline__ float wave_sum(float v) {
    v = row16_sum(v);
    const int iv = __builtin_bit_cast(int, v);
    const float r0 = __builtin_bit_cast(float, __builtin_amdgcn_readlane(iv, 0)), r1 = __builtin_bit_cast(float, __builtin_amdgcn_readlane(iv, 16));
    const float r2 = __builtin_bit_cast(float, __builtin_amdgcn_readlane(iv, 32)), r3 = __builtin_bit_cast(float, __builtin_amdgcn_readlane(iv, 48));
    return (r0 + r1) + (r2 + r3);
}
__device__ __forceinline__ float wave_scan_add(float v) {
    v += dpp_f<0x111, 0xf>(0.f, v); v += dpp_f<0x112, 0xf>(0.f, v); v += dpp_f<0x114, 0xf>(0.f, v); v += dpp_f<0x118, 0xf>(0.f, v);
    v += dpp_f<0x142, 0xa>(0.f, v); v += dpp_f<0x143, 0xc>(0.f, v); return v; }
__device__ __forceinline__ float wave_scan_max(float v) {
    const float ninf = -INFINITY;
    v = fmaxf(v, dpp_f<0x111, 0xf>(ninf, v)); v = fmaxf(v, dpp_f<0x112, 0xf>(ninf, v)); v = fmaxf(v, dpp_f<0x114, 0xf>(ninf, v)); v = fmaxf(v, dpp_f<0x118, 0xf>(ninf, v));
    v = fmaxf(v, dpp_f<0x142, 0xa>(ninf, v)); v = fmaxf(v, dpp_f<0x143, 0xc>(ninf, v)); return v; }
#define LDS_WAIT() asm volatile("s_waitcnt lgkmcnt(0)" ::: "memory")
#define BAR_LDS() do { asm volatile("s_waitcnt lgkmcnt(0)" ::: "memory"); __builtin_amdgcn_s_barrier(); asm volatile("" ::: "memory"); } while (0)

namespace pg8 {
constexpr int BM = 256, BK = 64, HALF = 128, HTB = HALF * BK * 2, STAGE_BYTES = 8 * HTB, NXCD = 8, WGM = 8;
__host__ __device__ __forceinline__ int lds_byte(int r, int c) { const int st = (r >> 4) * 2 + (c >> 5), rr = r & 15, cc = c & 31, ob = rr * 64 + cc * 2; return st * 1024 + (ob ^ (((ob >> 9) & 1) << 5)); }
__host__ __device__ __forceinline__ void stage_rc(int b, int& R, int& C) { const int st = b / 1024, sb = b % 1024, swz = sb ^ (((sb >> 9) & 1) << 5); R = (st >> 1) * 16 + swz / 64; C = (st & 1) * 32 + (swz % 64) / 2; }
__host__ __device__ __forceinline__ int perm32(int rho) { const int n = rho >> 4, i = rho & 15; return 8 * (i >> 2) + 4 * n + (i & 3); }

struct Unit { int pm, pn, sub, slot; };
struct StaticOrder {
    int nM, nN, nwg, G, c;
    __device__ void init(int nM_, int nN_, int G_, int c_) { nM = nM_; nN = nN_; nwg = nM * nN; G = G_; c = c_; }
    __device__ bool tile(int i, Unit& u) const {
        const long L = (long)i * G + c; if (L >= nwg) return false;
        int wgid = (int)L; { const int q = nwg / NXCD, r = nwg % NXCD, xcd = wgid % NXCD, off = wgid / NXCD; wgid = (xcd < r ? xcd * (q + 1) : r * (q + 1) + (xcd - r) * q) + off; }
        const int nig = WGM * nN, gid = wgid / nig, fm = gid * WGM, gsz = (nM - fm) < WGM ? (nM - fm) : WGM;
        u.pm = fm + ((wgid % nig) % gsz); u.pn = (wgid % nig) / gsz; u.sub = 0; u.slot = 0; return true;
    }
    __device__ bool next(int i, Unit& u) const { return tile(i, u); }
};
struct PairOrder : StaticOrder {
    __device__ bool next(int i, Unit& u) const { if (!tile(i >> 1, u)) return false; u.sub = i & 1; u.slot = (i >> 1) & 1; return true; }
};
__device__ __forceinline__ unsigned cvt_pk_bf16(float lo, float hi) { return pk2(lo, hi); }

template <class Epi, class Sched, class Prob>
__device__ __forceinline__ void gemm_phase(LAS unsigned char* lds, const int K, const Sched& S, const Epi& E, const Prob& P) {
    const int tid = threadIdx.x, wid = __builtin_amdgcn_readfirstlane(tid >> 6), lane = tid & 63, wr = wid >> 2, wc = wid & 3, fr = lane & 15, fq = lane >> 4;
    const int nt = K / BK;
    unsigned voffA[2], voffB[2];
#pragma unroll
    for (int i = 0; i < 2; ++i) { int R, C; stage_rc(tid * 16 + i * 8192, R, C); const int Rb = Epi::PERM ? ((R & ~31) + perm32(R & 31)) : R;
        voffA[i] = (unsigned)(R * K + C) * 2u; voffB[i] = (unsigned)(Rb * K + C) * 2u; }
    const size_t kstep = (size_t)(BK * 2);
    const size_t hstep = (size_t)HALF * K * 2;
    const unsigned ldsw = (unsigned)wid * 1024u;
    const int aoff = lds_byte(wr * 64 + fr, fq * 8), boff = lds_byte(wc * 32 + fr, fq * 8);
#define PG8_SA(b, h) (((b) * 2 + (h)) * HTB)
#define PG8_SB(b, h) ((4 + (b) * 2 + (h)) * HTB)
#define PG8_STAGE(bufoff, gbase, voff) do { _Pragma("unroll") for (int _i = 0; _i < 2; ++_i) \
        __builtin_amdgcn_global_load_lds((const unsigned*)((const char*)(gbase) + (voff)[_i]), (LAS unsigned*)(lds + (bufoff) + ldsw + _i * 8192), 16, 0, 0); } while (0)
#define PG8_LDA(dst, b, h) do { _Pragma("unroll") for (int m = 0; m < 4; ++m) _Pragma("unroll") for (int k = 0; k < 2; ++k) dst[m][k] = *(const LAS bf16x8*)(lds + PG8_SA(b, h) + aoff + m * 2048 + k * 1024); } while (0)
#define PG8_LDB(dst, b, h) do { _Pragma("unroll") for (int n = 0; n < 2; ++n) _Pragma("unroll") for (int k = 0; k < 2; ++k) dst[n][k] = *(const LAS bf16x8*)(lds + PG8_SB(b, h) + boff + n * 2048 + k * 1024); } while (0)
#define PG8_MMA(ai, bj, At, Bt) do { __builtin_amdgcn_s_setprio(1); _Pragma("unroll") for (int m = 0; m < 4; ++m) _Pragma("unroll") for (int n = 0; n < 2; ++n) _Pragma("unroll") for (int k = 0; k < 2; ++k) \
        acc[ai][bj][m][n] = __builtin_amdgcn_mfma_f32_16x16x32_bf16(Bt[n][k], At[m][k], acc[ai][bj][m][n], 0, 0, 0); __builtin_amdgcn_s_setprio(0); } while (0)
#define PG8_WAIT_V(n) asm volatile("s_waitcnt vmcnt(" #n ")" ::: "memory")
#define PG8_WAIT_L(n) asm volatile("s_waitcnt lgkmcnt(" #n ")" ::: "memory")
#define PG8_BAR __builtin_amdgcn_s_barrier()
#define PG8_SCHED __builtin_amdgcn_sched_barrier(0)
    Unit cur, nxt; int ui = 0;
    if (!S.next(0, cur)) return;
    f32x4 acc[2][2][4][2];
#pragma unroll
    for (int a = 0; a < 2; ++a)
#pragma unroll
        for (int b = 0; b < 2; ++b)
#pragma unroll
            for (int m = 0; m < 4; ++m)
#pragma unroll
                for (int n = 0; n < 2; ++n) acc[a][b][m][n] = (f32x4){0.f, 0.f, 0.f, 0.f};
    bf16x8 At[4][2], B0[2][2], B1[2][2];
    const char* cA = P.a(cur); const char* cB = P.b(cur);
    PG8_STAGE(PG8_SB(0, 0), cB, voffB); PG8_STAGE(PG8_SA(0, 0), cA, voffA); PG8_STAGE(PG8_SB(0, 1), cB + hstep, voffB); PG8_STAGE(PG8_SA(0, 1), cA + hstep, voffA);
    if (wr == 1) PG8_BAR;
    PG8_WAIT_V(4); PG8_BAR;
    PG8_STAGE(PG8_SB(1, 0), cB + kstep, voffB); PG8_STAGE(PG8_SA(1, 0), cA + kstep, voffA); PG8_STAGE(PG8_SB(1, 1), cB + hstep + kstep, voffB);
    PG8_WAIT_V(6); PG8_BAR;
    for (;;) {
        const bool has_next = S.next(ui + 1, nxt);
        const char* nA = has_next ? P.a(nxt) : cA; const char* nB = has_next ? P.b(nxt) : cB;
        for (int t = 0; t < nt; t += 2) {
            const bool last = (t == nt - 2);
#if GEMM_DRAIN
            PG8_WAIT_V(0);
#endif
            E.mid(acc, cur, t, wr, fr, lds);
            const char* a1 = cA + (size_t)(t + 1) * kstep;
            const char* a2 = last ? nA : cA + (size_t)(t + 2) * kstep; const char* b2 = last ? nB : cB + (size_t)(t + 2) * kstep;
            const char* a3 = a2 + kstep; const char* b3 = b2 + kstep;
            PG8_LDB(B0, 0, 0); PG8_SCHED; PG8_LDA(At, 0, 0); PG8_STAGE(PG8_SA(1, 1), a1 + hstep, voffA);
            PG8_WAIT_L(8); PG8_BAR; PG8_WAIT_L(0); PG8_MMA(0, 0, At, B0); PG8_BAR; PG8_SCHED;
            PG8_LDB(B1, 0, 1); PG8_STAGE(PG8_SB(0, 0), b2, voffB);
            PG8_BAR; PG8_WAIT_L(0); PG8_MMA(0, 1, At, B1); PG8_BAR;
            PG8_LDA(At, 0, 1); PG8_STAGE(PG8_SA(0, 0), a2, voffA);
            PG8_BAR; PG8_WAIT_L(0); PG8_MMA(1, 0, At, B0); PG8_BAR; PG8_SCHED;
            PG8_STAGE(PG8_SB(0, 1), b2 + hstep, voffB);
            PG8_WAIT_V(6); PG8_BAR; PG8_MMA(1, 1, At, B1); PG8_BAR;
            PG8_LDB(B0, 1, 0); PG8_SCHED; PG8_LDA(At, 1, 0); PG8_STAGE(PG8_SA(0, 1), a2 + hstep, voffA);
            PG8_WAIT_L(8); PG8_BAR; PG8_WAIT_L(0); PG8_MMA(0, 0, At, B0); PG8_BAR; PG8_SCHED;
            PG8_LDB(B1, 1, 1); PG8_STAGE(PG8_SB(1, 0), b3, voffB);
            PG8_BAR; PG8_WAIT_L(0); PG8_MMA(0, 1, At, B1); PG8_BAR;
            PG8_LDA(At, 1, 1); PG8_STAGE(PG8_SA(1, 0), a3, voffA);
            PG8_BAR; PG8_WAIT_L(0); PG8_MMA(1, 0, At, B0); PG8_BAR; PG8_SCHED;
            PG8_STAGE(PG8_SB(1, 1), b3 + hstep, voffB);
            PG8_WAIT_V(6); PG8_BAR; PG8_MMA(1, 1, At, B1); PG8_BAR;
        }
        E(acc, cur, wr, wc, fr, fq, lds);
        if (!has_next) break;
        cur = nxt; cA = nA; cB = nB; ++ui;
    }
    PG8_WAIT_V(0);
    if (wr == 0) PG8_BAR;
    PG8_BAR;
#undef PG8_SA
#undef PG8_SB
#undef PG8_STAGE
#undef PG8_LDA
#undef PG8_LDB
#undef PG8_MMA
#undef PG8_WAIT_V
#undef PG8_WAIT_L
#undef PG8_BAR
#undef PG8_SCHED
}
#define ACC_ZERO(acc) do { _Pragma("unroll") for (int a_ = 0; a_ < 2; ++a_) _Pragma("unroll") for (int b_ = 0; b_ < 2; ++b_) _Pragma("unroll") for (int m_ = 0; m_ < 4; ++m_) _Pragma("unroll") for (int n_ = 0; n_ < 2; ++n_) acc[a_][b_][m_][n_] = (f32x4){0.f, 0.f, 0.f, 0.f}; } while (0)
}


#define XB_TMO      128
#define XB_XCNT(j)  (256  + 64 * (j))
#define XB_XSUB(j)  (1280 + 64 * (j))
#define XB_XGEN(j)  (2304 + 64 * (j))
#define XB_TOP      3328
#define XB_TOPGEN   3392
#define XCD_BAR_WORDS 3456
#define XB_SPIN_CAP (1u << 18)

__device__ __forceinline__ unsigned xb_ld(unsigned* p)              { return __hip_atomic_load(p, __ATOMIC_RELAXED, __HIP_MEMORY_SCOPE_AGENT); }
__device__ __forceinline__ unsigned xb_add(unsigned* p, unsigned v) { return __hip_atomic_fetch_add(p, v, __ATOMIC_RELAXED, __HIP_MEMORY_SCOPE_AGENT); }
__device__ __forceinline__ unsigned xb_xcc_id() { return (unsigned)__builtin_amdgcn_s_getreg((3 << 11) | 20) & 0xFu; }
#define XB_SPIN(cond, bar) do { unsigned _sp = 0; while (cond) { __builtin_amdgcn_s_sleep(1); \
    if ((++_sp & 255u) == 0u) { if (xb_ld(&(bar)[XB_TMO])) break; if (_sp > XB_SPIN_CAP) { atomicAdd(&(bar)[XB_TMO], 1u); break; } } } } while (0)

struct XcdBarrier {
    unsigned* bar; unsigned x;
    volatile LAS unsigned* st;
};

__device__ __forceinline__ XcdBarrier xcd_barrier_post(unsigned* bar, volatile LAS unsigned* st) {
    XcdBarrier b; b.bar = bar; b.x = xb_xcc_id(); b.st = st;
    if (threadIdx.x == 0) (void)xb_add(&bar[XB_XCNT(b.x)], 1u);
    return b;
}
__device__ __forceinline__ void xcd_barrier_complete(unsigned* bar, unsigned x, unsigned& nloc, unsigned& nx) {
    const unsigned G = gridDim.x * gridDim.y * gridDim.z;
    unsigned sum, cnt, mine, sp = 0u;
    for (;;) {
        sum = 0u; cnt = 0u; mine = 0u;
#pragma unroll
        for (unsigned j = 0; j < 16; ++j) { const unsigned c = xb_ld(&bar[XB_XCNT(j)]); sum += c; cnt += (c > 0u) ? 1u : 0u; mine = (j == x) ? c : mine; }
        if (sum == G) break;
        __builtin_amdgcn_s_sleep(1);
        if ((++sp & 255u) == 0u) { if (xb_ld(&bar[XB_TMO])) break; if (sp > XB_SPIN_CAP) { atomicAdd(&bar[XB_TMO], 1u); break; } }
    }
    nloc = mine > 0u ? mine : 1u; nx = cnt > 0u ? cnt : 1u;
}

__device__ __forceinline__ void xcd_barrier(const XcdBarrier& b) {
    asm volatile("s_waitcnt vmcnt(0)" ::: "memory");
    __syncthreads();
    if (threadIdx.x == 0) {
        unsigned* bar = b.bar;
        __builtin_amdgcn_s_waitcnt(0);
        unsigned nloc = b.st[0], nx = b.st[1];
        if (nloc == 0u) { xcd_barrier_complete(bar, b.x, nloc, nx); b.st[0] = nloc; b.st[1] = nx; }
        const unsigned old = xb_add(&bar[XB_XSUB(b.x)], 1u);
        const unsigned gen = old / nloc;
        if (old + 1u == (gen + 1u) * nloc) {
            __builtin_amdgcn_fence(__ATOMIC_RELEASE, "agent");
            asm volatile("s_waitcnt vmcnt(0)" ::: "memory");
            const unsigned og = xb_add(&bar[XB_TOP], 1u);
            const unsigned tg = og / nx;
            if (og + 1u == (tg + 1u) * nx) xb_add(&bar[XB_TOPGEN], 1u);
            else XB_SPIN(xb_ld(&bar[XB_TOPGEN]) == tg, bar);
            __builtin_amdgcn_fence(__ATOMIC_ACQUIRE, "agent");
            xb_add(&bar[XB_XGEN(b.x)], 1u);
            asm volatile("s_waitcnt vmcnt(0)" ::: "memory");
        } else {
            XB_SPIN(xb_ld(&bar[XB_XGEN(b.x)]) == gen, bar);
            __builtin_amdgcn_fence(__ATOMIC_ACQUIRE, "agent");
            asm volatile("s_waitcnt vmcnt(0)" ::: "memory");
        }
    }
    __syncthreads();
}


struct TV { bf16_t* big; bf16_t* sm; };
__device__ __forceinline__ bf16_t* tv_tile(const TV& t, int pm) { return pm < 128 ? t.big + (size_t)pm * 256 * DM : t.sm; }
__device__ __forceinline__ bf16_t* tv_row(const TV& t, int row) { return row < NTP ? t.big + (size_t)row * DM : t.sm + (size_t)(row - NTP) * DM; }

struct Epi1 {
    static constexpr bool PERM = true;
    __device__ __forceinline__ void mid(f32x4 (&)[2][2][4][2], const pg8::Unit&, int, int, int, LAS unsigned char*) const {}
    TV Q, K, V, OG, XB, SZB, GA, GB; const float* b_gate;
    __device__ __forceinline__ void operator()(f32x4 (&acc)[2][2][4][2], const pg8::Unit& u, int wr, int wc, int fr, int fq, LAS unsigned char* lds) const {
        const int pn = u.pn; int type, colt; TV tv; const float* bias = nullptr;
        if (pn < 4) { type = 0; tv = Q; colt = pn * 256; }
        else if (pn < 8) { type = 1; tv = K; colt = (pn - 4) * 256; }
        else if (pn < 12) { type = 0; tv = V; colt = (pn - 8) * 256; }
        else if (pn < 20) { type = 2; tv = OG; colt = (pn - 12) * 128; }
        else if (pn < 24) { type = 0; tv = XB; colt = (pn - 20) * 256; }
        else if (pn < 28) { type = 3; tv = SZB; colt = (pn - 24) * 256; }
        else { type = 4; tv = GA; colt = (pn - 28) * 128; bias = b_gate + colt; }
        bf16_t* base = tv_tile(tv, u.pm);
        const int nai = (u.pm < 128) ? 2 : 1;
        const int cl = wc * 32 + 8 * fq;
        if (type == 2) {
#pragma unroll
            for (int ai = 0; ai < 2; ++ai) if (ai < nai)
#pragma unroll
                for (int m = 0; m < 4; ++m) {
                    bf16_t* rowp = base + (size_t)(ai * 128 + wr * 64 + m * 16 + fr) * DM + colt + cl;
                    float v[8];
#pragma unroll
                    for (int n = 0; n < 2; ++n)
#pragma unroll
                        for (int j = 0; j < 4; ++j) { const float o = acc[ai][0][m][n][j], z = acc[ai][1][m][n][j]; v[n * 4 + j] = sigm(o) * z * sigm(z); }
                    u32x4 w; w.x = pg8::cvt_pk_bf16(v[0], v[1]); w.y = pg8::cvt_pk_bf16(v[2], v[3]); w.z = pg8::cvt_pk_bf16(v[4], v[5]); w.w = pg8::cvt_pk_bf16(v[6], v[7]);
                    *(u32x4*)rowp = w;
                }
        } else if (type == 4) {
            f32x4 bv[2][2];
#pragma unroll
            for (int bj = 0; bj < 2; ++bj)
#pragma unroll
                for (int n = 0; n < 2; ++n) bv[bj][n] = *(const f32x4*)(bias + bj * 1024 + cl + 4 * n);
            bf16_t* baseb = tv_tile(GB, u.pm);
#pragma unroll
            for (int ai = 0; ai < 2; ++ai) if (ai < nai)
#pragma unroll
                for (int m = 0; m < 4; ++m) {
                    const size_t ro = (size_t)(ai * 128 + wr * 64 + m * 16 + fr) * DM + colt + cl;
                    float vr[8], vg[8];
#pragma unroll
                    for (int n = 0; n < 2; ++n)
#pragma unroll
                        for (int j = 0; j < 4; ++j) { const float ea = __expf(-(acc[ai][0][m][n][j] + bv[0][n][j])), eb = __expf(-fmaxf(acc[ai][1][m][n][j] + bv[1][n][j], -30.f));
                            vg[n * 4 + j] = __builtin_amdgcn_rcpf(1.0f + eb); vr[n * 4 + j] = (1.0f + eb) * __builtin_amdgcn_rcpf(1.0f + ea); }
                    u32x4 w; w.x = pg8::cvt_pk_bf16(vr[0], vr[1]); w.y = pg8::cvt_pk_bf16(vr[2], vr[3]); w.z = pg8::cvt_pk_bf16(vr[4], vr[5]); w.w = pg8::cvt_pk_bf16(vr[6], vr[7]);
                    *(u32x4*)(base + ro) = w;
                    w.x = pg8::cvt_pk_bf16(vg[0], vg[1]); w.y = pg8::cvt_pk_bf16(vg[2], vg[3]); w.z = pg8::cvt_pk_bf16(vg[4], vg[5]); w.w = pg8::cvt_pk_bf16(vg[6], vg[7]);
                    *(u32x4*)(baseb + ro) = w;
                }
        } else {
            const float sc = (type == 1) ? 0.0625f : 1.0f; const bool silu = (type == 3);
#pragma unroll
            for (int ai = 0; ai < 2; ++ai) if (ai < nai)
#pragma unroll
                for (int m = 0; m < 4; ++m) {
                    bf16_t* rowp = base + (size_t)(ai * 128 + wr * 64 + m * 16 + fr) * DM + colt + cl;
#pragma unroll
                    for (int bj = 0; bj < 2; ++bj) {
                        float v[8];
#pragma unroll
                        for (int n = 0; n < 2; ++n)
#pragma unroll
                            for (int j = 0; j < 4; ++j) { float x = acc[ai][bj][m][n][j] * sc; if (silu) x = x * sigm(x); v[n * 4 + j] = x; }
                        u32x4 w; w.x = pg8::cvt_pk_bf16(v[0], v[1]); w.y = pg8::cvt_pk_bf16(v[2], v[3]); w.z = pg8::cvt_pk_bf16(v[4], v[5]); w.w = pg8::cvt_pk_bf16(v[6], v[7]);
                        *(u32x4*)(rowp + bj * 128) = w;
                    }
                }
        }
        ACC_ZERO(acc);
    }
};
struct Prob1 { TV U; const bf16_t* W;
    __device__ __forceinline__ const char* a(const pg8::Unit& u) const { return (const char*)tv_tile(U, u.pm); }
    __device__ __forceinline__ const char* b(const pg8::Unit& u) const { return (const char*)(W + (size_t)u.pn * 256 * DM); } };

struct Epi2 {
    static constexpr bool PERM = true;
    __device__ __forceinline__ void mid(f32x4 (&acc)[2][2][4][2], const pg8::Unit& u, int t, int wr, int fr, LAS unsigned char* lds) const {
        if (u.sub != 0 || t == 0 || (t & 3) != 0) return;
        const int hd = t >> 2;
        const LAS float* RS = (const LAS float*)(lds + RS_OFF) + u.slot * 1024;
#pragma unroll
        for (int ai = 0; ai < 2; ++ai)
#pragma unroll
            for (int m = 0; m < 4; ++m) { const int rl = ai * 128 + wr * 64 + m * 16 + fr;
                const float ratio = RS[rl * 4 + hd - 1] * __builtin_amdgcn_rcpf(RS[rl * 4 + hd]);
#pragma unroll
                for (int bj = 0; bj < 2; ++bj)
#pragma unroll
                    for (int n = 0; n < 2; ++n) acc[ai][bj][m][n] = acc[ai][bj][m][n] * ratio; }
    }
    TV GA, GB, MG;
    __device__ __forceinline__ void operator()(f32x4 (&acc)[2][2][4][2], const pg8::Unit& u, int wr, int wc, int fr, int fq, LAS unsigned char* lds) const {
        const bf16_t* ga = tv_tile(GA, u.pm); const bf16_t* gb = tv_tile(GB, u.pm); bf16_t* mg = tv_tile(MG, u.pm);
        {
            int t_ = threadIdx.x; asm volatile("" : "+v"(t_));
            const unsigned off0 = (unsigned)(((t_ >> 6) * 32 + (t_ & 63) / 4) << 11) + (unsigned)((t_ & 3) << 7);
            const char* gbt = (const char*)(gb + u.pn * 256); const char* gat = (const char*)(ga + u.pn * 256);
#pragma unroll
            for (int q = 0; q < 2; ++q) __builtin_amdgcn_global_load_lds((const unsigned*)((u.sub == 0 ? gat : gbt) + off0 + q * 32768u), (LAS unsigned*)(lds + PF_OFF), 16, 0, 0);
        }
        const int nai = (u.pm < 128) ? 2 : 1;
        const int col0 = u.pn * 256 + wc * 32 + 8 * fq;
#pragma unroll
        for (int ai = 0; ai < 2; ++ai) if (ai < nai)
#pragma unroll
            for (int m = 0; m < 4; ++m) {
                const size_t ro = (size_t)(ai * 128 + wr * 64 + m * 16 + fr) * DM + col0;
                const float rs3 = ((const LAS float*)(lds + RS_OFF))[u.slot * 1024 + (ai * 128 + wr * 64 + m * 16 + fr) * 4 + 3];
#pragma unroll
                for (int bj = 0; bj < 2; ++bj) {
                    const u32x4 gbw = *(const u32x4*)((u.sub == 0 ? ga : gb) + ro + bj * 128);
                    float gbv[8] = {bflo(gbw.x), bfhi(gbw.x), bflo(gbw.y), bfhi(gbw.y), bflo(gbw.z), bfhi(gbw.z), bflo(gbw.w), bfhi(gbw.w)};
                    if (u.sub == 0) {
#pragma unroll
                        for (int n = 0; n < 2; ++n)
#pragma unroll
                            for (int j = 0; j < 4; ++j) acc[ai][bj][m][n][j] *= rs3 * gbv[n * 4 + j];
                    } else {
                        float v[8];
#pragma unroll
                        for (int n = 0; n < 2; ++n)
#pragma unroll
                            for (int j = 0; j < 4; ++j) v[n * 4 + j] = acc[ai][bj][m][n][j] * gbv[n * 4 + j];
                        u32x4 w; w.x = pg8::cvt_pk_bf16(v[0], v[1]); w.y = pg8::cvt_pk_bf16(v[2], v[3]); w.z = pg8::cvt_pk_bf16(v[4], v[5]); w.w = pg8::cvt_pk_bf16(v[6], v[7]);
                        *(u32x4*)(mg + ro + bj * 128) = w;
                    }
                }
            }
        if (u.sub == 1) ACC_ZERO(acc);
    }
};
struct Prob2 { TV YA, YB; const bf16_t* WA; const bf16_t* WB;
    __device__ __forceinline__ const char* a(const pg8::Unit& u) const { return (const char*)tv_tile(u.sub ? YB : YA, u.pm); }
    __device__ __forceinline__ const char* b(const pg8::Unit& u) const { return (const char*)((u.sub ? WB : WA) + (size_t)u.pn * 256 * DM); } };

struct Epi3 {
    static constexpr bool PERM = true;
    __device__ __forceinline__ void mid(f32x4 (&)[2][2][4][2], const pg8::Unit&, int, int, int, LAS unsigned char*) const {}
    const float* xp; bf16_t* yb; const float* modg; float* rowss;
    __device__ __forceinline__ void operator()(f32x4 (&acc)[2][2][4][2], const pg8::Unit& u, int wr, int wc, int fr, int fq, LAS unsigned char* lds) const {
        const int col0 = u.pn * 256 + wc * 32 + 8 * fq;
        const float* xb = xp + (size_t)u.pm * 256 * DM;
        int t_ = threadIdx.x; asm volatile("" : "+v"(t_));
        const int rl_ = (t_ >> 8) * 64 + (t_ & 15);
        {
            const char* xt = (const char*)(xb + u.pn * 256);
            const unsigned off0 = (unsigned)(((t_ >> 6) * 32 + (t_ & 63) / 8) << 12) + (unsigned)((t_ & 7) << 7);
#pragma unroll
            for (int q = 0; q < 4; ++q) __builtin_amdgcn_global_load_lds((const unsigned*)(xt + off0 + q * 32768u), (LAS unsigned*)(lds + PF_OFF), 16, 0, 0);
        }
        bf16_t* ob = yb + (size_t)u.pm * 256 * DM;
        const float* gp = modg + (u.pm >> 3) * DM + col0;
#pragma unroll
        for (int ai = 0; ai < 2; ++ai)
#pragma unroll
            for (int m = 0; m < 4; ++m) {
                const int rl = ai * 128 + wr * 64 + m * 16 + fr;
                const size_t ro = (size_t)rl * DM + col0;
                float ss = 0.f;
#pragma unroll
                for (int bj = 0; bj < 2; ++bj) {
                    const f32x4 y0 = *(const f32x4*)(xb + ro + bj * 128) + *(const f32x4*)(gp + bj * 128) * acc[ai][bj][m][0];
                    const f32x4 y1 = *(const f32x4*)(xb + ro + bj * 128 + 4) + *(const f32x4*)(gp + bj * 128 + 4) * acc[ai][bj][m][1];
                    ss += ((y0[0] * y0[0] + y0[1] * y0[1]) + (y0[2] * y0[2] + y0[3] * y0[3])) + ((y1[0] * y1[0] + y1[1] * y1[1]) + (y1[2] * y1[2] + y1[3] * y1[3]));
                    u32x4 w; w.x = pk2(y0[0], y0[1]); w.y = pk2(y0[2], y0[3]); w.z = pk2(y1[0], y1[1]); w.w = pk2(y1[2], y1[3]);
                    *(u32x4*)(ob + ro + bj * 128) = w;
                }
                ss += __shfl_xor(ss, 16); ss += __shfl_xor(ss, 32);
                if (fq == 0) rowss[((size_t)u.pm * 256 + ai * 128 + m * 16 + rl_) * 16 + u.pn * 4 + (t_ >> 6 & 3)] = ss;
            }
        ACC_ZERO(acc);
    }
};
struct Prob3 { TV MG; const bf16_t* WO;
    __device__ __forceinline__ const char* a(const pg8::Unit& u) const { return (const char*)tv_tile(MG, u.pm); }
    __device__ __forceinline__ const char* b(const pg8::Unit& u) const { return (const char*)(WO + (size_t)u.pn * 256 * DM); } };


__device__ __forceinline__ void mini_gemm2(const Params& p, LAS unsigned char* lds) {
    const int lane = threadIdx.x & 63, wave = threadIdx.x >> 6, g = lane >> 4, li = lane & 15, tsel = wave >> 2, ksl = wave & 3;
    unsigned char* ws = p.ws;
    const bf16_t* ya = (const bf16_t*)(ws + WS_SMALL + SM_V * SMALL_B); const bf16_t* yb = (const bf16_t*)(ws + WS_SMALL + SM_SZB * SMALL_B);
    const bf16_t* ga = (const bf16_t*)(ws + WS_SMALL + SM_GA * SMALL_B); const bf16_t* gb = (const bf16_t*)(ws + WS_SMALL + SM_GB * SMALL_B);
    bf16_t* mg = (bf16_t*)(ws + WS_SMALL + SM_U * SMALL_B);
    const bf16_t* wa = (const bf16_t*)(ws + WS_WAT); const bf16_t* wb = (const bf16_t*)(ws + WS_WBT);
    LAS float* red = (LAS float*)lds;
    for (int t0 = blockIdx.x * 2; t0 < 512; t0 += gridDim.x * 2) {
        const int wt = t0 + tsel, r0 = (wt >> 6) * 16, c0 = (wt & 63) * 16;
        const bf16_t* pa = ya + (size_t)(r0 + li) * DM + ksl * 256 + 8 * g; const bf16_t* pb = yb + (size_t)(r0 + li) * DM + ksl * 256 + 8 * g;
        const bf16_t* qa = wa + (size_t)(c0 + li) * DM + ksl * 256 + 8 * g; const bf16_t* qb = wb + (size_t)(c0 + li) * DM + ksl * 256 + 8 * g;
        f32x4 a1 = (f32x4){0.f, 0.f, 0.f, 0.f}, a2 = (f32x4){0.f, 0.f, 0.f, 0.f};
#pragma unroll
        for (int k0 = 0; k0 < 256; k0 += 32) {
            a1 = __builtin_amdgcn_mfma_f32_16x16x32_bf16(*(const bf16x8*)(pa + k0), *(const bf16x8*)(qa + k0), a1, 0, 0, 0);
            a2 = __builtin_amdgcn_mfma_f32_16x16x32_bf16(*(const bf16x8*)(pb + k0), *(const bf16x8*)(qb + k0), a2, 0, 0, 0);
        }
        { const float* hss = (const float*)(ws + WS_HSS);
#pragma unroll
          for (int r = 0; r < 4; ++r) { const f32x4 hs = *(const f32x4*)(hss + (size_t)(NTP + r0 + 4 * g + r) * 16 + ksl * 4);
              a1[r] *= rsqrtf(((hs[0] + hs[1]) + (hs[2] + hs[3])) * (1.0f / 256.0f) + EPS); } }
        *(LAS f32x4*)(red + (wave * 64 + lane) * 8) = a1; *(LAS f32x4*)(red + (wave * 64 + lane) * 8 + 4) = a2;
        __syncthreads();
        if (ksl == 0) {
#pragma unroll
            for (int q = 1; q < 4; ++q) { a1 += *(const LAS f32x4*)(red + ((wave + q) * 64 + lane) * 8); a2 += *(const LAS f32x4*)(red + ((wave + q) * 64 + lane) * 8 + 4); }
#pragma unroll
            for (int r = 0; r < 4; ++r) { const size_t o = (size_t)(r0 + 4 * g + r) * DM + c0 + li;
                mg[o] = (bf16_t)f2bf(bf2f(gb[o]) * (bf2f(ga[o]) * a1[r] + a2[r])); }
        }
        __syncthreads();
    }
}
__device__ __forceinline__ void mini_gemm3(const Params& p, LAS unsigned char* lds) {
    const int lane = threadIdx.x & 63, wave = threadIdx.x >> 6, g = lane >> 4, li = lane & 15, tsel = wave >> 2, ksl = wave & 3;
    unsigned char* ws = p.ws;
    const bf16_t* mg = (const bf16_t*)(ws + WS_SMALL + SM_U * SMALL_B); const bf16_t* wo = (const bf16_t*)(ws + WS_WOT);
    const float* modg = (const float*)(ws + WS_MODG);
    LAS float* red = (LAS float*)lds;
    for (int t0 = blockIdx.x * 2; t0 < 512; t0 += gridDim.x * 2) {
        const int wt = t0 + tsel, r0 = (wt >> 6) * 16, c0 = (wt & 63) * 16;
        const bf16_t* pa = mg + (size_t)(r0 + li) * DM + ksl * 256 + 8 * g; const bf16_t* qa = wo + (size_t)(c0 + li) * DM + ksl * 256 + 8 * g;
        f32x4 a1 = (f32x4){0.f, 0.f, 0.f, 0.f};
#pragma unroll
        for (int k0 = 0; k0 < 256; k0 += 32) a1 = __builtin_amdgcn_mfma_f32_16x16x32_bf16(*(const bf16x8*)(pa + k0), *(const bf16x8*)(qa + k0), a1, 0, 0, 0);
        *(LAS f32x4*)(red + (wave * 64 + lane) * 4) = a1;
        __syncthreads();
        if (ksl == 0) {
#pragma unroll
            for (int q = 1; q < 4; ++q) a1 += *(const LAS f32x4*)(red + ((wave + q) * 64 + lane) * 4);
#pragma unroll
            for (int r = 0; r < 4; ++r) { const int row = r0 + 4 * g + r, col = c0 + li;
                p.out[O_YS + (size_t)row * DM + col] = p.in[1][(size_t)row * DM + col] + modg[(16 + (row >> 4)) * DM + col] * a1[r]; }
        }
        __syncthreads();
    }
}

__device__ __forceinline__ void transpose_item(const float* W, int ldw, int col0, int k0, bf16_t* WT, int ldt, int row0, LAS float* scr, int lane, const float* kscale = nullptr) {
#pragma unroll
    for (int i = 0; i < 32; ++i) { const int kk = 2 * i + (lane >> 5); float v = W[(size_t)(k0 + kk) * ldw + col0 + (lane & 31)]; if (kscale) v *= kscale[k0 + kk]; scr[kk * 33 + (lane & 31)] = v; }
    LDS_WAIT(); asm volatile("" ::: "memory");
    const int c = lane & 7;
#pragma unroll
    for (int j = 0; j < 4; ++j) { const int n = (lane >> 3) + 8 * j; const LAS float* s = scr + (8 * c) * 33 + n;
        u32x4 o; o.x = pk2(s[0 * 33], s[1 * 33]); o.y = pk2(s[2 * 33], s[3 * 33]); o.z = pk2(s[4 * 33], s[5 * 33]); o.w = pk2(s[6 * 33], s[7 * 33]);
        *(u32x4*)(WT + (size_t)(row0 + n) * ldt + k0 + 8 * c) = o; }
    LDS_WAIT(); asm volatile("" ::: "memory");
}

__device__ __forceinline__ void phase0(const Params& p, LAS unsigned char* lds) {
    const int tid = threadIdx.x, lane = tid & 63, wave = tid >> 6, G = gridDim.x;
    unsigned char* ws = p.ws;
    for (int it = blockIdx.x; it < 192; it += G) {
        const int cgp = it % 48, ks = it / 48;
        LAS float* cs = (LAS float*)lds;
        LAS float* red = (LAS float*)(lds + 24576);
        for (int i = tid; i < 24 * 256; i += 512) { const int b = i >> 8, k = i & 255; cs[k * 24 + b] = (b < 16) ? p.in[2][b * DM + ks * 256 + k] : p.in[3][(b - 16) * DM + ks * 256 + k]; }
        __syncthreads();
        const int col = tid & 63, kq = tid >> 6;
        float a[24];
#pragma unroll
        for (int b = 0; b < 24; ++b) a[b] = 0.f;
        const float* wm = p.in[9] + (size_t)(ks * 256 + kq * 32) * 3072 + cgp * 64 + col;
        for (int kk = 0; kk < 32; ++kk) { const float w = wm[(size_t)kk * 3072];
#pragma unroll
            for (int b = 0; b < 24; ++b) a[b] += cs[(kq * 32 + kk) * 24 + b] * w; }
#pragma unroll
        for (int b = 0; b < 24; ++b) red[(kq * 24 + b) * 64 + col] = a[b];
        __syncthreads();
        float* modp = (float*)(ws + WS_MODP);
        for (int i = tid; i < 24 * 64; i += 512) { const int b = i >> 6, c = i & 63; float s = 0.f;
#pragma unroll
            for (int q = 0; q < 8; ++q) s += red[(q * 24 + b) * 64 + c];
            modp[((size_t)ks * 24 + b) * 3072 + cgp * 64 + c] = s; }
        __syncthreads();
    }
    { float* wif = (float*)(ws + WS_WIF);
      for (int i = blockIdx.x * 512 + tid; i < 8 * DM; i += G * 512) { const int g = i >> 10, k = i & 1023; wif[i] = p.in[12][(size_t)k * DIN + 5120 + g]; } }
    LAS float* scr = (LAS float*)(lds + wave * 16384);
    const int gw = blockIdx.x * 8 + wave, NGW = G * 8;
    constexpr int I_W1 = 288 * 16, I_SQ = 32 * 16, I_R = 64, NIT = I_W1 + 3 * I_SQ + 2 * I_R;
    for (int it = gw; it < NIT; it += NGW) {
        int r = it;
        if (r < I_W1) {
            const int rg = r >> 4, kb = r & 15, pn = rg >> 3, c0 = (rg & 7) * 32; const float* W; int ldw, col;
            if (pn < 12) { W = p.in[12]; ldw = DIN; col = rg * 32; }
            else if (pn < 20) { W = p.in[12]; ldw = DIN; const int j = pn - 12; col = (c0 < 128) ? 3072 + 128 * j + c0 : 4096 + 128 * j + (c0 - 128); }
            else if (pn < 24) { W = p.in[12]; ldw = DIN; col = 5128 + (rg * 32 - 5120); }
            else if (pn < 28) { W = p.in[12]; ldw = DIN; col = 6152 + (rg * 32 - 6144); }
            else { W = p.in[22]; ldw = 2048; const int j = pn - 28; col = (c0 < 128) ? 128 * j + c0 : 1024 + 128 * j + (c0 - 128); }
            transpose_item(W, ldw, col, kb * 64, (bf16_t*)(ws + WS_W1T), DM, rg * 32, scr, lane); continue; }
        r -= I_W1;
        if (r < 3 * I_SQ) { const int w = r / I_SQ, q = r % I_SQ, rg = q >> 4, kb = q & 15;
            transpose_item(p.in[24 + w], DM, rg * 32, kb * 64, (bf16_t*)(ws + (w == 0 ? WS_WAT : (w == 1 ? WS_WBT : WS_WOT))), DM, rg * 32, scr, lane, w == 0 ? p.in[14] : nullptr); continue; }
        r -= 3 * I_SQ;
        { const int w = r / I_R, q = r % I_R, n = q >> 3, rg = (q >> 1) & 3, kb = q & 1;
          transpose_item(p.in[w ? 19 : 17] + (size_t)n * 16384, 128, rg * 32, kb * 64, (bf16_t*)(ws + (w ? WS_WRXT : WS_WRAT)) + (size_t)n * 16384, 128, rg * 32, scr, lane); }
    }
}

__device__ __forceinline__ void phase1(const Params& p, LAS unsigned char* lds) {
    const int tid = threadIdx.x, lane = tid & 63, wave = tid >> 6, G = gridDim.x;
    unsigned char* ws = p.ws;
    LAS float* wif = (LAS float*)lds;
    { const float* src = (const float*)(ws + WS_WIF); for (int i = tid; i < 8 * DM; i += 512) wif[i] = src[i]; }
    __syncthreads();
    const float* modp = (const float*)(ws + WS_MODP); const float* b_mod = p.in[10]; const float* g_norm = p.in[11]; const float* b_if = p.in[13];
    float* IF = (float*)(ws + WS_IF);
    TV U{(bf16_t*)(ws + WS_U), (bf16_t*)(ws + WS_SMALL + SM_U * SMALL_B)};
    { float* modg = (float*)(ws + WS_MODG);
      for (int i = blockIdx.x * 512 + tid; i < 24 * DM; i += G * 512) { const int b = i >> 10, c = i & 1023; float s = b_mod[2048 + c];
#pragma unroll
          for (int ks = 0; ks < 4; ++ks) s += modp[((size_t)ks * 24 + b) * 3072 + 2048 + c];
          modg[i] = s; } }
    const bool h32 = (lane & 32) != 0, h16 = (lane & 16) != 0, h8 = (lane & 8) != 0;
    const int gi = (h32 ? 4 : 0) + (h16 ? 2 : 0) + (h8 ? 1 : 0);
    const float bif = b_if[gi];
    for (int wi = blockIdx.x * 8 + wave; wi < NTP / 16 + NTS; wi += G * 8) {
        const int row0 = wi < NTP / 16 ? wi * 16 : NTP + (wi - NTP / 16), nrow = wi < NTP / 16 ? 16 : 1;
        const int bidx = row0 < NTP ? (row0 >> 11) : 16 + ((row0 - NTP) >> 4);
        f32x4 sc[4], sh[4];
#pragma unroll
        for (int j = 0; j < 4; ++j) { const int idx = 4 * lane + 256 * j;
            f32x4 s = *(const f32x4*)(b_mod + idx), c = *(const f32x4*)(b_mod + 1024 + idx);
#pragma unroll
            for (int ks = 0; ks < 4; ++ks) { const float* mp = modp + ((size_t)ks * 24 + bidx) * 3072; s += *(const f32x4*)(mp + idx); c += *(const f32x4*)(mp + 1024 + idx); }
            sh[j] = s; sc[j] = *(const f32x4*)(g_norm + idx) * (c + 1.0f); }
        const float* xbase = row0 < NTP ? p.in[0] + (size_t)row0 * DM : p.in[1] + (size_t)(row0 - NTP) * DM;
        f32x4 nv[4];
#pragma unroll
        for (int j = 0; j < 4; ++j) nv[j] = *(const f32x4*)(xbase + 4 * lane + 256 * j);
        for (int r = 0; r < nrow; ++r) {
            const int row = row0 + r;
            f32x4 v[4]; float ss = 0.f;
#pragma unroll
            for (int j = 0; j < 4; ++j) { v[j] = nv[j]; ss += (v[j][0] * v[j][0] + v[j][1] * v[j][1]) + (v[j][2] * v[j][2] + v[j][3] * v[j][3]); }
            if (r + 1 < nrow) {
#pragma unroll
                for (int j = 0; j < 4; ++j) nv[j] = *(const f32x4*)(xbase + (size_t)(r + 1) * DM + 4 * lane + 256 * j); }
            const float rs = rsqrtf(wave_sum(ss) * (1.0f / DM) + EPS);
            bf16_t* ur = tv_row(U, row);
            float d[8];
#pragma unroll
            for (int g = 0; g < 8; ++g) d[g] = 0.f;
#pragma unroll
            for (int j = 0; j < 4; ++j) { v[j] = v[j] * rs * sc[j] + sh[j];
                u32x2 w; w.x = pk2(v[j][0], v[j][1]); w.y = pk2(v[j][2], v[j][3]); *(u32x2*)(ur + 4 * lane + 256 * j) = w;
#pragma unroll
                for (int g = 0; g < 8; ++g) { const f32x4 wv = *(const LAS f32x4*)(wif + g * DM + 4 * lane + 256 * j); d[g] += (v[j][0] * wv[0] + v[j][1] * wv[1]) + (v[j][2] * wv[2] + v[j][3] * wv[3]); } }
            float e[4], f[2], gs;
#pragma unroll
            for (int i = 0; i < 4; ++i) { const float send = h32 ? d[i] : d[i + 4], keep = h32 ? d[i + 4] : d[i]; e[i] = keep + __shfl_xor(send, 32); }
#pragma unroll
            for (int i = 0; i < 2; ++i) { const float send = h16 ? e[i] : e[i + 2], keep = h16 ? e[i + 2] : e[i]; f[i] = keep + __shfl_xor(send, 16); }
            { const float send = h8 ? f[0] : f[1], keep = h8 ? f[1] : f[0]; gs = keep + __shfl_xor(send, 8); }
            gs += __shfl_xor(gs, 4); gs += __shfl_xor(gs, 2); gs += __shfl_xor(gs, 1);
            if ((lane & 7) == 0) { float x = gs + bif;
                if (gi >= 4) x = fminf(x, 0.f) - __logf(1.0f + __expf(-fabsf(x)));
                IF[(size_t)row * 8 + gi] = x; }
        }
    }
}

constexpr int ML_QS = 0, ML_KS = 33792, ML_CB = 67584, ML_VS = 109824, ML_VW = 119040, ML_HS = 128256, ML_F = 137472;
__device__ __forceinline__ void mlstm_item(const Params& p, LAS unsigned char* lds, int b, int h, int vs, bool smp, bool dry) {
    int tid_ = threadIdx.x; asm volatile("" : "+v"(tid_));
    const int tid = tid_, lane = tid & 63, w = __builtin_amdgcn_readfirstlane(tid >> 6), g = lane >> 4, li = lane & 15, q4 = li >> 2, p4 = li & 3;
    unsigned char* ws = p.ws;
    const int L = smp ? DSEQ : 64, nch = smp ? 1 : SEQ / 64;
    const int row0 = smp ? NTP + b * DSEQ : b * SEQ;
    const bf16_t* qb = (smp ? (const bf16_t*)(ws + WS_SMALL + SM_Q * SMALL_B) + (size_t)(b * DSEQ) * DM : (const bf16_t*)(p.out) + (size_t)row0 * DM) + h * 256;
    const bf16_t* kb = (smp ? (const bf16_t*)(ws + WS_SMALL + SM_K * SMALL_B) + (size_t)(b * DSEQ) * DM : (const bf16_t*)((unsigned char*)p.out + 64 * MiB) + (size_t)row0 * DM) + h * 256;
    bf16_t* vb = (smp ? (bf16_t*)(ws + WS_SMALL + SM_V * SMALL_B) + (size_t)(b * DSEQ) * DM : (bf16_t*)(ws + WS_V) + (size_t)row0 * DM) + h * 256 + vs * 64;
    const float* IFb = (const float*)(ws + WS_IF) + (size_t)row0 * 8;
    float* HSSb = (float*)(ws + WS_HSS) + (size_t)row0 * 16 + h * 4 + vs;
    const bf16_t* ogb = (smp ? (const bf16_t*)(ws + WS_SMALL + SM_OG * SMALL_B) + (size_t)(b * DSEQ) * DM : (const bf16_t*)(ws + WS_OG) + (size_t)row0 * DM) + h * 256 + vs * 64;
    LAS float* F = (LAS float*)(lds + ML_F);
    LAS float *IG = F, *LF = F + 64, *HSQ = F + 128;
    LAS float *GGw = F + 264 + 320 * w, *MMw = GGw + 64, *SIw = GGw + 128, *EMw = GGw + 192, *WSw = GGw + 256;
    const int bh = b * 4 + h;
    const int vt = w & 3, ktb = (w >> 2) * 8, i0 = 2 * (w & 3);
    f32x4 cst[8], nst[2];
    float m_state;
    if (smp) {
        const float* C0 = p.in[4] + (size_t)bh * 65536 + (size_t)(vs * 64 + vt * 16 + li) * 256;
#pragma unroll
        for (int i = 0; i < 8; ++i) cst[i] = *(const f32x4*)(C0 + (ktb + i) * 16 + 4 * g);
#pragma unroll
        for (int q = 0; q < 2; ++q) nst[q] = (li == 0) ? *(const f32x4*)(p.in[5] + bh * 256 + (ktb + i0 + q) * 16 + 4 * g) : (f32x4){0.f, 0.f, 0.f, 0.f};
        m_state = p.in[6][bh];
    } else {
#pragma unroll
        for (int i = 0; i < 8; ++i) cst[i] = (f32x4){0.f, 0.f, 0.f, 0.f};
        nst[0] = (f32x4){0.f, 0.f, 0.f, 0.f}; nst[1] = nst[0];
        m_state = 0.f;
    }
#pragma unroll
    for (int i = 0; i < 8; ++i) { u32x2 wv; wv.x = pk2(cst[i][0], cst[i][1]); wv.y = pk2(cst[i][2], cst[i][3]);
        *(LAS u32x2*)(lds + ML_CB + (vt * 16 + li) * 528 + ((ktb + i) * 16 + 4 * g) * 2) = wv; }
    if (li == 0) {
#pragma unroll
        for (int q = 0; q < 2; ++q) { u32x2 wv; wv.x = pk2(nst[q][0], nst[q][1]); wv.y = pk2(nst[q][2], nst[q][3]);
            *(LAS u32x2*)(lds + ML_CB + 64 * 528 + ((ktb + i0 + q) * 16 + 4 * g) * 2) = wv; } }
    u32x4 rq[4], rk[4], rv; float rig = 0.f, rlf = 0.f;
    const u32x4 z4 = (u32x4){0u, 0u, 0u, 0u};
#define ML_PREFETCH(c) do { const int t0_ = (c) * 64; \
        _Pragma("unroll") for (int i_ = 0; i_ < 4; ++i_) { const int id_ = tid + 512 * i_, r_ = id_ >> 5, ch_ = id_ & 31; \
            if (!smp || r_ < L) { rq[i_] = *(const u32x4*)(qb + (size_t)(t0_ + r_) * DM + ch_ * 8); rk[i_] = *(const u32x4*)(kb + (size_t)(t0_ + r_) * DM + ch_ * 8); } else { rq[i_] = z4; rk[i_] = z4; } } \
        { const int r_ = tid >> 3, ch_ = tid & 7; rv = (!smp || r_ < L) ? *(const u32x4*)(vb + (size_t)(t0_ + r_) * DM + ch_ * 8) : z4; } \
        if (tid < 64) { if (!smp || tid < L) { rig = IFb[(size_t)(t0_ + tid) * 8 + h]; rlf = IFb[(size_t)(t0_ + tid) * 8 + 4 + h]; } else { rig = -INFINITY; rlf = 0.f; } } } while (0)
    ML_PREFETCH(0);
    bf16x8 ones; { const short o1 = (short)0x3F80;
#pragma unroll
        for (int j = 0; j < 8; ++j) ones[j] = o1; }
    const int tt = w >> 1, hb = (w & 1) * 2;
    for (int c = 0; c < nch; ++c) {
        const int t0 = c * 64;
#pragma unroll
        for (int i = 0; i < 4; ++i) { const int id = tid + 512 * i, r = id >> 5, ch = id & 31;
            *(LAS u32x4*)(lds + ML_QS + r * 528 + ch * 16) = rq[i]; *(LAS u32x4*)(lds + ML_KS + r * 528 + ch * 16) = rk[i]; }
        const u32x4 vcur = rv;
        { const int r = tid >> 3, ch = tid & 7; *(LAS u32x4*)(lds + ML_VS + r * 144 + ch * 16) = vcur; }
        if (tid < 64) { IG[tid] = rig; LF[tid] = rlf; }
        BAR_LDS();
        if (c + 1 < nch) ML_PREFETCH(c + 1);
        float decay, m_next;
        {
            const float bc = wave_scan_add(LF[lane]);
            const float gs = IG[lane] - bc;
            const float cm = wave_scan_max(gs);
            const float Mt = fmaxf(m_state, cm);
            const float ML_ = __builtin_bit_cast(float, __builtin_amdgcn_readlane(__builtin_bit_cast(int, Mt), 63));
            const float bL = __builtin_bit_cast(float, __builtin_amdgcn_readlane(__builtin_bit_cast(int, bc), 63));
            GGw[lane] = gs; MMw[lane] = Mt; SIw[lane] = __expf(m_state - Mt); EMw[lane] = __expf(-(bc + Mt)); WSw[lane] = __expf(gs - ML_);
            decay = __expf(m_state - ML_); m_next = bL + ML_;
        }
        { const int r = tid >> 3, ch = tid & 7; const float wsr = WSw[r];
          u32x4 o; o.x = pk2(bflo(vcur.x) * wsr, bfhi(vcur.x) * wsr); o.y = pk2(bflo(vcur.y) * wsr, bfhi(vcur.y) * wsr); o.z = pk2(bflo(vcur.z) * wsr, bfhi(vcur.z) * wsr); o.w = pk2(bflo(vcur.w) * wsr, bfhi(vcur.w) * wsr);
          *(LAS u32x4*)(lds + ML_VW + r * 144 + ch * 16) = o; }
        {
            bf16x8 qf[8];
#pragma unroll
            for (int kk = 0; kk < 8; ++kk) qf[kk] = *(const LAS bf16x8*)(lds + ML_QS + (tt * 16 + li) * 528 + (kk * 32 + g * 8) * 2);
            const float mt = MMw[tt * 16 + li];
            const int tq = tt * 16 + li;
            bf16x8 ap[2];
#pragma unroll
            for (int ks = 0; ks < 2; ++ks) {
                float pv[8];
#pragma unroll
                for (int hh = 0; hh < 2; ++hh) { const int st = 2 * ks + hh;
                    if (st <= tt) { f32x4 sa = (f32x4){0.f, 0.f, 0.f, 0.f};
#pragma unroll
                        for (int kk = 0; kk < 8; ++kk) { const bf16x8 kf = *(const LAS bf16x8*)(lds + ML_KS + (st * 16 + li) * 528 + (kk * 32 + g * 8) * 2); sa = __builtin_amdgcn_mfma_f32_16x16x32_bf16(kf, qf[kk], sa, 0, 0, 0); }
                        const f32x4 gv = *(const LAS f32x4*)(GGw + st * 16 + 4 * g);
#pragma unroll
                        for (int r = 0; r < 4; ++r) { const int sidx = st * 16 + 4 * g + r; pv[hh * 4 + r] = (sidx <= tq) ? sa[r] * __expf(gv[r] - mt) : 0.f; }
                    } else {
#pragma unroll
                        for (int r = 0; r < 4; ++r) pv[hh * 4 + r] = 0.f; } }
                union { u32x4 u; bf16x8 v; } cvt; cvt.u.x = pk2(pv[0], pv[1]); cvt.u.y = pk2(pv[2], pv[3]); cvt.u.z = pk2(pv[4], pv[5]); cvt.u.w = pk2(pv[6], pv[7]);
                ap[ks] = cvt.v;
            }
            f32x4 na[2], nq = (f32x4){0.f, 0.f, 0.f, 0.f}, ra = (f32x4){0.f, 0.f, 0.f, 0.f};
            na[0] = (f32x4){0.f, 0.f, 0.f, 0.f}; na[1] = na[0];
#pragma unroll
            for (int kk = 0; kk < 8; ++kk) {
                const bf16x8 c0 = *(const LAS bf16x8*)(lds + ML_CB + ((hb + 0) * 16 + li) * 528 + (kk * 32 + g * 8) * 2);
                const bf16x8 c1 = *(const LAS bf16x8*)(lds + ML_CB + ((hb + 1) * 16 + li) * 528 + (kk * 32 + g * 8) * 2);
                const bf16x8 cn = *(const LAS bf16x8*)(lds + ML_CB + 64 * 528 + (kk * 32 + g * 8) * 2);
                na[0] = __builtin_amdgcn_mfma_f32_16x16x32_bf16(qf[kk], c0, na[0], 0, 0, 0);
                na[1] = __builtin_amdgcn_mfma_f32_16x16x32_bf16(qf[kk], c1, na[1], 0, 0, 0);
                nq = __builtin_amdgcn_mfma_f32_16x16x32_bf16(qf[kk], cn, nq, 0, 0, 0);
            }
            const f32x4 si = *(const LAS f32x4*)(SIw + tt * 16 + 4 * g), em = *(const LAS f32x4*)(EMw + tt * 16 + 4 * g);
            na[0] = na[0] * si; na[1] = na[1] * si;
#pragma unroll
            for (int ks = 0; ks < 2; ++ks) if (2 * ks <= tt) {
                ra = __builtin_amdgcn_mfma_f32_16x16x32_bf16(ap[ks], ones, ra, 0, 0, 0);
#pragma unroll
                for (int j = 0; j < 2; ++j) {
                    const s16x4 v0 = __builtin_amdgcn_ds_read_tr16_b64_v4i16((LAS s16x4*)(lds + ML_VS + (ks * 32 + g * 4 + q4) * 144 + ((hb + j) * 16 + 4 * p4) * 2));
                    const s16x4 v1 = __builtin_amdgcn_ds_read_tr16_b64_v4i16((LAS s16x4*)(lds + ML_VS + (ks * 32 + 16 + g * 4 + q4) * 144 + ((hb + j) * 16 + 4 * p4) * 2));
                    bf16x8 bv; bv[0] = v0[0]; bv[1] = v0[1]; bv[2] = v0[2]; bv[3] = v0[3]; bv[4] = v1[0]; bv[5] = v1[1]; bv[6] = v1[2]; bv[7] = v1[3];
                    na[j] = __builtin_amdgcn_mfma_f32_16x16x32_bf16(ap[ks], bv, na[j], 0, 0, 0);
                }
            }
#pragma unroll
            for (int r = 0; r < 4; ++r) { const int t = tt * 16 + 4 * g + r;
                const float den = si[r] * nq[r] + ra[r]; const float inv = __builtin_amdgcn_rcpf(fmaxf(fabsf(den), em[r]));
                const float h0 = na[0][r] * inv, h1 = na[1][r] * inv;
                *(LAS bf16_t*)(lds + ML_HS + t * 144 + ((hb + 0) * 16 + li) * 2) = (bf16_t)f2bf(h0);
                *(LAS bf16_t*)(lds + ML_HS + t * 144 + ((hb + 1) * 16 + li) * 2) = (bf16_t)f2bf(h1);
                float sq = h0 * h0 + h1 * h1;
                sq = row16_sum(sq);
                HSQ[t * 2 + (w & 1)] = sq; }
        }
        BAR_LDS();
        u32x4 ogv = (u32x4){0u, 0u, 0u, 0u};
        { const int r = tid >> 3, ch = tid & 7; if (!smp || r < L) ogv = *(const u32x4*)(ogb + (size_t)(t0 + r) * DM + ch * 8); }
        if (tid < L && !dry) HSSb[(size_t)(t0 + tid) * 16] = HSQ[tid * 2] + HSQ[tid * 2 + 1];
        {
            bf16x8 bvw[2], bws[2];
#pragma unroll
            for (int ks = 0; ks < 2; ++ks) {
                const s16x4 v0 = __builtin_amdgcn_ds_read_tr16_b64_v4i16((LAS s16x4*)(lds + ML_VW + (ks * 32 + g * 8 + 0 + q4) * 144 + (vt * 16 + 4 * p4) * 2));
                const s16x4 v1 = __builtin_amdgcn_ds_read_tr16_b64_v4i16((LAS s16x4*)(lds + ML_VW + (ks * 32 + g * 8 + 4 + q4) * 144 + (vt * 16 + 4 * p4) * 2));
                bvw[ks][0] = v0[0]; bvw[ks][1] = v0[1]; bvw[ks][2] = v0[2]; bvw[ks][3] = v0[3]; bvw[ks][4] = v1[0]; bvw[ks][5] = v1[1]; bvw[ks][6] = v1[2]; bvw[ks][7] = v1[3];
                const f32x4 w0 = *(const LAS f32x4*)(WSw + ks * 32 + g * 8), w1 = *(const LAS f32x4*)(WSw + ks * 32 + g * 8 + 4);
                union { u32x4 u; bf16x8 v; } cvt; cvt.u.x = pk2(w0[0], w0[1]); cvt.u.y = pk2(w0[2], w0[3]); cvt.u.z = pk2(w1[0], w1[1]); cvt.u.w = pk2(w1[2], w1[3]);
                if (li != 0) cvt.u = (u32x4){0u, 0u, 0u, 0u};
                bws[ks] = cvt.v; }
            nst[0] = nst[0] * decay; nst[1] = nst[1] * decay;
#pragma unroll
            for (int i = 0; i < 8; ++i) { const int kt = ktb + i; cst[i] = cst[i] * decay;
                const bool mine = ((i >> 1) == (w & 3));
#pragma unroll
                for (int ks = 0; ks < 2; ++ks) {
                    const s16x4 k0 = __builtin_amdgcn_ds_read_tr16_b64_v4i16((LAS s16x4*)(lds + ML_KS + (ks * 32 + g * 8 + 0 + q4) * 528 + (kt * 16 + 4 * p4) * 2));
                    const s16x4 k1 = __builtin_amdgcn_ds_read_tr16_b64_v4i16((LAS s16x4*)(lds + ML_KS + (ks * 32 + g * 8 + 4 + q4) * 528 + (kt * 16 + 4 * p4) * 2));
                    bf16x8 ak; ak[0] = k0[0]; ak[1] = k0[1]; ak[2] = k0[2]; ak[3] = k0[3]; ak[4] = k1[0]; ak[5] = k1[1]; ak[6] = k1[2]; ak[7] = k1[3];
                    cst[i] = __builtin_amdgcn_mfma_f32_16x16x32_bf16(ak, bvw[ks], cst[i], 0, 0, 0);
                    if (mine) nst[i & 1] = __builtin_amdgcn_mfma_f32_16x16x32_bf16(ak, bws[ks], nst[i & 1], 0, 0, 0); }
                u32x2 wv; wv.x = pk2(cst[i][0], cst[i][1]); wv.y = pk2(cst[i][2], cst[i][3]);
                *(LAS u32x2*)(lds + ML_CB + (vt * 16 + li) * 528 + (kt * 16 + 4 * g) * 2) = wv; }
            if (li == 0) {
#pragma unroll
                for (int q = 0; q < 2; ++q) { u32x2 wv; wv.x = pk2(nst[q][0], nst[q][1]); wv.y = pk2(nst[q][2], nst[q][3]);
                    *(LAS u32x2*)(lds + ML_CB + 64 * 528 + ((ktb + i0 + q) * 16 + 4 * g) * 2) = wv; } }
        }
        { const int r = tid >> 3, ch = tid & 7; if ((!smp || r < L) && !dry) { const u32x4 hv = *(const LAS u32x4*)(lds + ML_HS + r * 144 + ch * 16); u32x4 o;
            o.x = pk2(bflo(hv.x) * bflo(ogv.x), bfhi(hv.x) * bfhi(ogv.x)); o.y = pk2(bflo(hv.y) * bflo(ogv.y), bfhi(hv.y) * bfhi(ogv.y));
            o.z = pk2(bflo(hv.z) * bflo(ogv.z), bfhi(hv.z) * bfhi(ogv.z)); o.w = pk2(bflo(hv.w) * bflo(ogv.w), bfhi(hv.w) * bfhi(ogv.w));
            *(u32x4*)(vb + (size_t)(t0 + r) * DM + ch * 8) = o; } }
        BAR_LDS();
        m_state = m_next;
    }
    if (!dry) {
        float* Co = p.out + (smp ? O_CS : O_CP) + (size_t)bh * 65536 + (size_t)(vs * 64 + vt * 16 + li) * 256;
#pragma unroll
        for (int i = 0; i < 8; ++i) *(f32x4*)(Co + (ktb + i) * 16 + 4 * g) = cst[i];
        if (vs == 0) {
            if (li == 0) {
#pragma unroll
                for (int q = 0; q < 2; ++q) *(f32x4*)(p.out + (smp ? O_NS : O_NP) + bh * 256 + (ktb + i0 + q) * 16 + 4 * g) = nst[q]; }
            if (tid == 0) p.out[(smp ? O_MS : O_MP) + bh] = m_state; }
    }
    __syncthreads();
#undef ML_PREFETCH
}

constexpr int RG_XR = 0, RG_XC = 18432, RG_W = 36864, RG_EX = 71680, RG_HC = 72704, RG_ZS = 73216;
__device__ __forceinline__ void rglru_item(const Params& p, LAS unsigned char* lds, int b, int n, int hf, bool smp, bool dry) {
    int tid_ = threadIdx.x; asm volatile("" : "+v"(tid_));
    const int tid = tid_, lane = tid & 63, w = __builtin_amdgcn_readfirstlane(tid >> 6), g = lane >> 4, li = lane & 15;
    unsigned char* ws = p.ws;
    const int L = smp ? DSEQ : SEQ, ntile = smp ? 1 : SEQ / 64;
    const int row0 = smp ? NTP + b * DSEQ : b * SEQ;
    const bf16_t* xbp = (smp ? (const bf16_t*)(ws + WS_SMALL + SM_XB * SMALL_B) + (size_t)(b * DSEQ) * DM : (const bf16_t*)(ws + WS_XB) + (size_t)row0 * DM) + n * 128;
    bf16_t* zbp = (smp ? (bf16_t*)(ws + WS_SMALL + SM_SZB * SMALL_B) + (size_t)(b * DSEQ) * DM : (bf16_t*)(ws + WS_SZB) + (size_t)row0 * DM) + n * 128 + hf * 64;
    const float* cvs = p.in[8] + (size_t)b * 3 * DM + n * 128;
    LAS float* EX = (LAS float*)(lds + RG_EX); LAS float* HC = (LAS float*)(lds + RG_HC);
    for (int id = tid; id < 2 * 64 * 16; id += 512) { const int gt = id >> 10, j = (id >> 4) & 63, ch = id & 15;
        *(LAS u32x4*)(lds + RG_W + (gt * 64 + j) * 272 + ch * 16) = *(const u32x4*)((const bf16_t*)(ws + (gt ? WS_WRXT : WS_WRAT)) + (size_t)n * 16384 + (size_t)(hf * 64 + j) * 128 + ch * 8); }
    const int jt = w & 3, th = w >> 2, jc = jt * 16 + li, chn = n * 128 + hf * 64 + jc;
    const float bra = p.in[18][chn], brx = p.in[20][chn];
    float spl; { const float lm = p.in[21][chn]; spl = fmaxf(-lm, 0.f) + log1pf(__expf(-fabsf(lm))); }
    float gw_[4]; const float gb_ = p.in[16][chn];
#pragma unroll
    for (int j = 0; j < 4; ++j) gw_[j] = p.in[15][j * DM + chn];
    const int c2 = tid & 63, tq = tid >> 6;
    float cw[4][2], cb[2];
#pragma unroll
    for (int j = 0; j < 4; ++j) { cw[j][0] = p.in[15][j * DM + n * 128 + 2 * c2]; cw[j][1] = p.in[15][j * DM + n * 128 + 2 * c2 + 1]; }
    cb[0] = p.in[16][n * 128 + 2 * c2]; cb[1] = p.in[16][n * 128 + 2 * c2 + 1];
    if (tid < 64) { HC[tid] = smp ? p.in[7][b * DM + n * 128 + hf * 64 + tid] : 0.f; }
    u32x4 rx[3], rzv;
    const u32x4 z4 = (u32x4){0u, 0u, 0u, 0u};
#define RG_PREFETCH(tl) do { const int t0_ = (tl) * 64; \
        _Pragma("unroll") for (int i_ = 0; i_ < 3; ++i_) { const int id_ = tid + 512 * i_, r_ = id_ >> 4, ch_ = id_ & 15, tok_ = t0_ - 3 + r_; rx[i_] = z4; \
            if (id_ < 67 * 16) { if (tok_ >= 0 && (!smp || tok_ < L)) rx[i_] = *(const u32x4*)(xbp + (size_t)tok_ * DM + ch_ * 8); \
                else if (tok_ < 0 && smp) { const float* s_ = cvs + (size_t)(tok_ + 3) * DM + ch_ * 8; const f32x4 a_ = *(const f32x4*)s_, b_ = *(const f32x4*)(s_ + 4); \
                    rx[i_].x = pk2(a_[0], a_[1]); rx[i_].y = pk2(a_[2], a_[3]); rx[i_].z = pk2(b_[0], b_[1]); rx[i_].w = pk2(b_[2], b_[3]); } } } \
        { const int r_ = tid >> 3, ch_ = tid & 7; rzv = (!smp || t0_ + r_ < L) ? *(const u32x4*)(zbp + (size_t)(t0_ + r_) * DM + ch_ * 8) : z4; } } while (0)
    RG_PREFETCH(0);
    for (int tl = 0; tl < ntile; ++tl) {
        const int t0 = tl * 64;
#pragma unroll
        for (int i = 0; i < 3; ++i) { const int id = tid + 512 * i, r = id >> 4, ch = id & 15; if (id < 67 * 16) *(LAS u32x4*)(lds + RG_XR + r * 272 + ch * 16) = rx[i]; }
        { const int r = tid >> 3, ch = tid & 7; *(LAS u32x4*)(lds + RG_ZS + (tl & 1) * 9216 + r * 144 + ch * 16) = rzv; }
        BAR_LDS();
        if (tl > 0 && !dry) { const int r = tid >> 3, ch = tid & 7;
            *(u32x4*)(zbp + (size_t)(t0 - 64 + r) * DM + ch * 8) = *(const LAS u32x4*)(lds + RG_ZS + ((tl - 1) & 1) * 9216 + r * 144 + ch * 16); }
        if (tl == ntile - 1 && tid < 192 && !dry) {
            const int j = tid >> 6, c = tid & 63, rr = (L - t0) + j;
            p.out[(smp ? O_CVS : O_CVP) + ((size_t)b * 3 + j) * DM + n * 128 + hf * 64 + c] = bf2f(*(const LAS bf16_t*)(lds + RG_XR + rr * 272 + (hf * 64 + c) * 2));
        }
        if (tl + 1 < ntile) RG_PREFETCH(tl + 1);
        { float x0[3], x1[3];
#pragma unroll
          for (int j = 0; j < 3; ++j) { const unsigned wv = *(const LAS unsigned*)(lds + RG_XR + (tq * 8 + j) * 272 + c2 * 4); x0[j] = bflo(wv); x1[j] = bfhi(wv); }
#pragma unroll
          for (int i = 0; i < 8; ++i) { const int t = tq * 8 + i; const unsigned wv = *(const LAS unsigned*)(lds + RG_XR + (t + 3) * 272 + c2 * 4); const float n0 = bflo(wv), n1 = bfhi(wv);
              const float y0 = cb[0] + cw[0][0] * x0[0] + cw[1][0] * x0[1] + cw[2][0] * x0[2] + cw[3][0] * n0;
              const float y1 = cb[1] + cw[0][1] * x1[0] + cw[1][1] * x1[1] + cw[2][1] * x1[2] + cw[3][1] * n1;
              x0[0] = x0[1]; x0[1] = x0[2]; x0[2] = n0; x1[0] = x1[1]; x1[1] = x1[2]; x1[2] = n1;
              *(LAS unsigned*)(lds + RG_XC + t * 272 + c2 * 4) = pk2(y0, y1); } }
        BAR_LDS();
        float av[2][4], bv[2][4], TA[2], TB[2], EA[2], EB[2];
        {
            bf16x8 wr_[4], wi_[4];
#pragma unroll
            for (int kk = 0; kk < 4; ++kk) { wr_[kk] = *(const LAS bf16x8*)(lds + RG_W + jc * 272 + (kk * 32 + g * 8) * 2); wi_[kk] = *(const LAS bf16x8*)(lds + RG_W + (64 + jc) * 272 + (kk * 32 + g * 8) * 2); }
#pragma unroll
            for (int q = 0; q < 2; ++q) { const int tt = 2 * th + q;
                f32x4 ar = (f32x4){0.f, 0.f, 0.f, 0.f}, ai = (f32x4){0.f, 0.f, 0.f, 0.f};
#pragma unroll
                for (int kk = 0; kk < 4; ++kk) { const bf16x8 ax = *(const LAS bf16x8*)(lds + RG_XC + (tt * 16 + li) * 272 + (kk * 32 + g * 8) * 2);
                    ar = __builtin_amdgcn_mfma_f32_16x16x32_bf16(ax, wr_[kk], ar, 0, 0, 0); ai = __builtin_amdgcn_mfma_f32_16x16x32_bf16(ax, wi_[kk], ai, 0, 0, 0); }
                float xw[7];
#pragma unroll
                for (int k = 0; k < 7; ++k) xw[k] = bf2f(*(const LAS bf16_t*)(lds + RG_XR + (tt * 16 + 4 * g + k) * 272 + (hf * 64 + jc) * 2));
                float A4 = 1.f, B4 = 0.f;
#pragma unroll
                for (int r = 0; r < 4; ++r) { const int t = tt * 16 + 4 * g + r;
                    const float xc = gb_ + gw_[0] * xw[r] + gw_[1] * xw[r + 1] + gw_[2] * xw[r + 2] + gw_[3] * xw[r + 3];
                    const float rg = sigm(ar[r] + bra), ig = sigm(ai[r] + brx);
                    const float la = -8.0f * rg * spl; const float a = __expf(la);
                    const float x2 = 2.0f * la;
                    const float pm = x2 * (1.0f + x2 * (0.5f + x2 * (0.16666667f + x2 * (0.041666668f + x2 * (0.0083333338f + x2 * (0.0013888889f + x2 * 0.0001984127f))))));
                    const float om = (x2 > -0.5f) ? -pm : 1.0f - __expf(x2);
                    float mult = __builtin_amdgcn_sqrtf(om); if (!smp && (t0 + t) == 0) mult = 1.0f;
                    const float bt = mult * ig * xc;
                    av[q][r] = a; bv[q][r] = bt; B4 = a * B4 + bt; A4 *= a; }
                { const float pA = __shfl_up(A4, 16), pB = __shfl_up(B4, 16); if (g >= 1) { B4 = A4 * pB + B4; A4 = A4 * pA; } }
                { const float pA = __shfl_up(A4, 32), pB = __shfl_up(B4, 32); if (g >= 2) { B4 = A4 * pB + B4; A4 = A4 * pA; } }
                { const float pA = __shfl_up(A4, 16), pB = __shfl_up(B4, 16); EA[q] = (g >= 1) ? pA : 1.f; EB[q] = (g >= 1) ? pB : 0.f; }
                TA[q] = __shfl(A4, 48 + li); TB[q] = __shfl(B4, 48 + li);
            }
            { EX[(th * 64 + jc) * 2] = TA[0] * TA[1]; EX[(th * 64 + jc) * 2 + 1] = TA[1] * TB[0] + TB[1]; }
        }
        BAR_LDS();
        {
            float hin = HC[(tl & 1) * 64 + jc];
            if (th == 1) hin = EX[jc * 2] * hin + EX[jc * 2 + 1];
            if (th == 1) HC[((tl + 1) & 1) * 64 + jc] = (TA[0] * TA[1]) * hin + (TA[1] * TB[0] + TB[1]);
#pragma unroll
            for (int q = 0; q < 2; ++q) { const int tt = 2 * th + q;
                float hcur = EA[q] * hin + EB[q];
#pragma unroll
                for (int r = 0; r < 4; ++r) { const int tok = t0 + tt * 16 + 4 * g + r;
                    hcur = av[q][r] * hcur + bv[q][r];
                    { LAS bf16_t* zp = (LAS bf16_t*)(lds + RG_ZS + (tl & 1) * 9216 + (tt * 16 + 4 * g + r) * 144 + jc * 2); *zp = (bf16_t)f2bf(bf2f(*zp) * hcur); }
                    if ((!smp || tok < L) && !dry && tok == L - 1) p.out[(smp ? O_HS : O_HP) + (size_t)b * DM + chn] = hcur; }
                hin = TA[q] * hin + TB[q];
            }
        }
    }
    BAR_LDS();
    if (!dry) { const int r = tid >> 3, ch = tid & 7, tlast = (ntile - 1) * 64;
        if (tlast + r < L) *(u32x4*)(zbp + (size_t)(tlast + r) * DM + ch * 8) = *(const LAS u32x4*)(lds + RG_ZS + ((ntile - 1) & 1) * 9216 + r * 144 + ch * 16); }
    __syncthreads();
#undef RG_PREFETCH
}

__device__ __forceinline__ void phase3(const Params& p, LAS unsigned char* lds) {
    const int G = gridDim.x;
    for (int it = blockIdx.x; it < 256; it += G) { const int bh = (it & 7) * 8 + (it >> 5), vs = (it >> 3) & 3; mlstm_item(p, lds, bh >> 2, bh & 3, vs, false, false); }
    for (int it = blockIdx.x; it < 256; it += G) { const int q = (it & 7) * 16 + (it >> 4), hf = (it >> 3) & 1; rglru_item(p, lds, q >> 3, q & 7, hf, false, false); }
    for (int it = blockIdx.x; it < 128; it += G) mlstm_item(p, lds, it >> 4, (it >> 2) & 3, it & 3, true, false);
    for (int it = blockIdx.x; it < 256; it += G) if (it >= 128) { const int q = it - 128; rglru_item(p, lds, q >> 4, (q >> 1) & 7, q & 1, true, false); }
}

__device__ __forceinline__ void phase4(const Params& p) {
    unsigned char* ws = p.ws;
    TV YA{(bf16_t*)(ws + WS_V), (bf16_t*)(ws + WS_SMALL + SM_V * SMALL_B)}, OG{(bf16_t*)(ws + WS_OG), (bf16_t*)(ws + WS_SMALL + SM_OG * SMALL_B)};
    const float* HSS = (const float*)(ws + WS_HSS); const float* gh = p.in[14];
    for (int id = blockIdx.x * 512 + threadIdx.x; id < NTT * 128; id += gridDim.x * 512) {
        const int row = id >> 7, ch = id & 127, hd = ch >> 5;
        const f32x4 hs = *(const f32x4*)(HSS + (size_t)row * 16 + hd * 4);
        const float rs = rsqrtf(((hs[0] + hs[1]) + (hs[2] + hs[3])) * (1.0f / 256.0f) + EPS);
        bf16_t* yp = tv_row(YA, row) + ch * 8; const bf16_t* op = tv_row(OG, row) + ch * 8;
        const u32x4 hv = *(const u32x4*)yp, ov = *(const u32x4*)op; const f32x4 g0 = *(const f32x4*)(gh + ch * 8), g1 = *(const f32x4*)(gh + ch * 8 + 4);
        u32x4 o;
        o.x = pk2(bflo(hv.x) * bflo(ov.x) * rs * g0[0], bfhi(hv.x) * bfhi(ov.x) * rs * g0[1]);
        o.y = pk2(bflo(hv.y) * bflo(ov.y) * rs * g0[2], bfhi(hv.y) * bfhi(ov.y) * rs * g0[3]);
        o.z = pk2(bflo(hv.z) * bflo(ov.z) * rs * g1[0], bfhi(hv.z) * bfhi(ov.z) * rs * g1[1]);
        o.w = pk2(bflo(hv.w) * bflo(ov.w) * rs * g1[2], bfhi(hv.w) * bfhi(ov.w) * rs * g1[3]);
        *(u32x4*)yp = o;
    }
}

__device__ __forceinline__ void phase7(const Params& p) {
    const int lane = threadIdx.x & 63, wave = threadIdx.x >> 6;
    const float* rowss = (const float*)(p.ws + WS_ROWSS); const float* gf = p.in[27];
    f32x4 gv[4];
#pragma unroll
    for (int j = 0; j < 4; ++j) gv[j] = *(const f32x4*)(gf + 4 * lane + 256 * j);
    const bf16_t* ybf = (const bf16_t*)(p.ws + WS_V);
    const int gw = blockIdx.x * 8 + wave, NGW = gridDim.x * 8;
    for (int r0 = gw; r0 < NTP; r0 += 4 * NGW) {
        u32x2 w[4][4]; float part[4];
#pragma unroll
        for (int q = 0; q < 4; ++q) { const int row = r0 + q * NGW; const bool ok = row < NTP; const int rr = ok ? row : r0;
#pragma unroll
            for (int j = 0; j < 4; ++j) w[q][j] = *(const u32x2*)(ybf + (size_t)rr * DM + 4 * lane + 256 * j);
            part[q] = lane < 16 ? rowss[(size_t)rr * 16 + lane] : 0.f; }
#pragma unroll
        for (int q = 0; q < 4; ++q) { const int row = r0 + q * NGW; if (row < NTP) {
            const float rs = rsqrtf(wave_sum(part[q]) * (1.0f / DM) + EPS);
            float* yr = p.out + O_YP + (size_t)row * DM;
#pragma unroll
            for (int j = 0; j < 4; ++j) { const f32x4 v = (f32x4){bflo(w[q][j].x), bfhi(w[q][j].x), bflo(w[q][j].y), bfhi(w[q][j].y)}; *(f32x4*)(yr + 4 * lane + 256 * j) = v * rs * gv[j]; } } }
    }
    for (int row = gw; row < NTS; row += NGW) {
        float* yr = p.out + O_YS + (size_t)row * DM;
        f32x4 v[4]; float part = 0.f;
#pragma unroll
        for (int j = 0; j < 4; ++j) { v[j] = *(const f32x4*)(yr + 4 * lane + 256 * j); part += (v[j][0] * v[j][0] + v[j][1] * v[j][1]) + (v[j][2] * v[j][2] + v[j][3] * v[j][3]); }
        const float rs = rsqrtf(wave_sum(part) * (1.0f / DM) + EPS);
#pragma unroll
        for (int j = 0; j < 4; ++j) *(f32x4*)(yr + 4 * lane + 256 * j) = v[j] * rs * gv[j];
    }
}

__global__ void __launch_bounds__(512) fwd_kernel(Params p) {
    extern __shared__ __attribute__((aligned(16))) unsigned char lds_raw[];
    LAS unsigned char* lds = (LAS unsigned char*)lds_raw;
    unsigned char* ws = p.ws;
    const int lo = p.ph_lo, hi = p.ph_hi;
#ifndef REP2
#define REP2 1
#define REP56 1
#define REP01 1
#ifndef PROBE_MODE
#define PROBE_MODE 0
#endif
#endif
#ifndef PH_MASK
#define PH_MASK 255
#endif
#define IN(k) (((PH_MASK >> (k)) & 1) && lo <= (k) && (k) < hi)
    { volatile LAS unsigned* stw = (volatile LAS unsigned*)(lds + LDS_BARW); if (threadIdx.x < 2) stw[threadIdx.x] = 0u; }
    __syncthreads();
    XcdBarrier xbar = xcd_barrier_post((unsigned*)(ws + WS_BAR), (volatile LAS unsigned*)(lds + LDS_BARW));
#define SEAM(k) do { if (IN(k) && IN((k) + 1)) { xcd_barrier(xbar); } } while (0)
    if (p.ph_hi > 1000) cg::this_grid().sync();
    auto small = [&](int i) { return (bf16_t*)(ws + WS_SMALL + (size_t)i * SMALL_B); };
    TV tU{(bf16_t*)(ws + WS_U), small(SM_U)}, tQ{(bf16_t*)p.out, small(SM_Q)}, tK{(bf16_t*)((unsigned char*)p.out + 64 * MiB), small(SM_K)},
       tV{(bf16_t*)(ws + WS_V), small(SM_V)}, tOG{(bf16_t*)(ws + WS_OG), small(SM_OG)}, tXB{(bf16_t*)(ws + WS_XB), small(SM_XB)},
       tSZB{(bf16_t*)(ws + WS_SZB), small(SM_SZB)}, tGA{(bf16_t*)(ws + WS_GA), small(SM_GA)}, tGB{(bf16_t*)(ws + WS_GB), small(SM_GB)};
    if (IN(0)) { phase0(p, lds); } SEAM(0);
    if (IN(1)) { phase1(p, lds); } SEAM(1);
#if REP01 > 1
    phase0(p, lds); cg::this_grid().sync(); phase1(p, lds); cg::this_grid().sync();
#endif
    if (IN(2)) {
        pg8::StaticOrder S; S.init(129, 36, gridDim.x, blockIdx.x);
        Epi1 E{tQ, tK, tV, tOG, tXB, tSZB, tGA, tGB, p.in[23]};
        Prob1 P{tU, (const bf16_t*)(ws + WS_W1T)};
        pg8::gemm_phase(lds, DM, S, E, P);
    } SEAM(2);
    if (IN(3)) { phase3(p, lds); } SEAM(3);
    if (IN(5)) {
        {
            pg8::PairOrder S0; S0.init(128, 4, gridDim.x, blockIdx.x);
            const int ord = threadIdx.x >> 8, rl = threadIdx.x & 255; pg8::Unit u0;
            if (S0.next(2 * ord, u0)) { const float* hss = (const float*)(ws + WS_HSS) + (size_t)(u0.pm * 256 + rl) * 16; f32x4 o;
#pragma unroll
                for (int hd = 0; hd < 4; ++hd) { const f32x4 hs = *(const f32x4*)(hss + hd * 4); o[hd] = rsqrtf(((hs[0] + hs[1]) + (hs[2] + hs[3])) * (1.0f / 256.0f) + EPS); }
                *(LAS f32x4*)(lds + RS_OFF + (ord * 256 + rl) * 16) = o; }
            __syncthreads();
        }
        pg8::PairOrder S; S.init(128, 4, gridDim.x, blockIdx.x);
        Epi2 E{tGA, tGB, tU};
        Prob2 P{tV, tSZB, (const bf16_t*)(ws + WS_WAT), (const bf16_t*)(ws + WS_WBT)};
        pg8::gemm_phase(lds, DM, S, E, P);
        mini_gemm2(p, lds);
#if REP56 > 1
        cg::this_grid().sync();
        pg8::gemm_phase(lds, DM, S, E, P);
#endif
    } SEAM(5);
    if (IN(6)) {
        pg8::StaticOrder S; S.init(128, 4, gridDim.x, blockIdx.x);
        Epi3 E{p.in[0], (bf16_t*)(ws + WS_V), (const float*)(ws + WS_MODG), (float*)(ws + WS_ROWSS)};
        Prob3 P{tU, (const bf16_t*)(ws + WS_WOT)};
        pg8::gemm_phase(lds, DM, S, E, P);
        mini_gemm3(p, lds);
#if REP56 > 1
        cg::this_grid().sync();
        pg8::gemm_phase(lds, DM, S, E, P);
#endif
    } SEAM(6);
    if (IN(7)) { phase7(p); }
#if SYNC_PROBE
    for (int i_ = 0; i_ < 8; ++i_) cg::this_grid().sync();
#endif
#undef IN
#undef SEAM
}

extern "C" void kernel_launch(void* const* d_in, const int* in_sizes, int n_in, void* d_out, int out_size, void* d_ws, size_t ws_size, hipStream_t stream) {
    static int grid = 0;
    if (grid == 0) {
        if (n_in != 28 || out_size != (int)O_END || ws_size < WS_END) { fprintf(stderr, "kernel_launch: unexpected shapes (n_in %d out %d ws %zu)\n", n_in, out_size, ws_size); grid = -1; return; }
        int dev = 0, cus = 0, per_cu = 0;
        hipGetDevice(&dev); hipDeviceGetAttribute(&cus, hipDeviceAttributeMultiprocessorCount, dev);
        hipFuncSetAttribute((const void*)fwd_kernel, hipFuncAttributeMaxDynamicSharedMemorySize, LDS_BYTES);
        hipOccupancyMaxActiveBlocksPerMultiprocessor(&per_cu, (const void*)fwd_kernel, 512, LDS_BYTES);
        if (per_cu < 1) { fprintf(stderr, "kernel_launch: occupancy query says %d blocks per CU\n", per_cu); grid = -1; return; }
        grid = cus;
        (void)hipGetLastError();
    }
    if (grid < 0) return;
    Params p{};
    for (int i = 0; i < 28; ++i) p.in[i] = (const float*)d_in[i];
    p.out = (float*)d_out; p.ws = (unsigned char*)d_ws; p.probe = PROBE_MODE;
#if MK_ONE_LAUNCH
    if (hipMemsetAsync((char*)d_ws + WS_BAR, 0, 16384, stream) != hipSuccess) { fprintf(stderr, "kernel_launch: memset of the barrier words failed\n"); return; }
    p.ph_lo = 0; p.ph_hi = 8;
    void* args[] = {&p};
    hipError_t e = hipLaunchCooperativeKernel((const void*)fwd_kernel, dim3(grid), dim3(512), args, LDS_BYTES, stream);
    if (e != hipSuccess) fprintf(stderr, "cooperative launch failed: %s (grid %d)\n", hipGetErrorString(e), grid);
#else
    for (int k = 0; k < 8; ++k) { p.ph_lo = k; p.ph_hi = k + 1; hipLaunchKernelGGL(fwd_kernel, dim3(grid), dim3(512), LDS_BYTES, stream, p); }
#endif
}
```

```cpp
#include <hip/hip_runtime.h>
#include <hip/hip_cooperative_groups.h>
#include <cstdio>
#include <cstdint>
namespace cg = cooperative_groups;

#ifndef GEMM_DRAIN
#define GEMM_DRAIN 0
#endif
#ifndef SYNC_PROBE
#define SYNC_PROBE 0
#endif
#ifndef MK_ONE_LAUNCH
#define MK_ONE_LAUNCH 1
#endif

#define LAS __attribute__((address_space(3)))
typedef unsigned short bf16_t;
typedef short bf16x8 __attribute__((ext_vector_type(8)));
typedef short s16x4 __attribute__((ext_vector_type(4)));
typedef float f32x4 __attribute__((ext_vector_type(4)));
typedef unsigned u32x4 __attribute__((ext_vector_type(4)));
typedef unsigned u32x2 __attribute__((ext_vector_type(2)));

constexpr int DM = 1024, NTP = 32768, NTS = 128, NTT = NTP + NTS, SEQ = 2048, DSEQ = 16;
constexpr int DIN = 7176;
constexpr float EPS = 1e-6f;
constexpr size_t MiB = 1u << 20;
constexpr size_t WS_U = 0 * MiB, WS_V = 64 * MiB, WS_OG = 128 * MiB, WS_XB = 192 * MiB, WS_SZB = 256 * MiB, WS_GA = 320 * MiB, WS_GB = 384 * MiB;
constexpr size_t WS_W1T = 448 * MiB, WS_WAT = 466 * MiB, WS_WBT = 468 * MiB, WS_WOT = 470 * MiB, WS_WRAT = 472 * MiB, WS_WRXT = 472 * MiB + 256 * 1024;
constexpr size_t WS_SMALL = 473 * MiB, SMALL_B = 512 * 1024;
enum { SM_U = 0, SM_Q, SM_K, SM_V, SM_OG, SM_XB, SM_SZB, SM_GA, SM_GB, SM_N };
constexpr size_t WS_IF = 478 * MiB, WS_HSS = 480 * MiB, WS_ROWSS = 483 * MiB, WS_MODP = 486 * MiB, WS_WIF = 488 * MiB, WS_BAR = 489 * MiB, WS_END = 490 * MiB, WS_MODG = 487 * MiB + 256 * 1024;
constexpr size_t O_YP = 0, O_YS = 33554432, O_CP = 33685504, O_NP = 37879808, O_MP = 37896192, O_HP = 37896256, O_CVP = 37912640,
                 O_CS = 37961792, O_NS = 40058944, O_MS = 40067136, O_HS = 40067168, O_CVS = 40075360, O_END = 40099936;
constexpr int LDS_BYTES = 151552, LDS_BARW = 151040, RS_OFF = 131072, PF_OFF = 139264;

struct Params { const float* in[28]; float* out; unsigned char* ws; int ph_lo, ph_hi, probe, pad; };

typedef float f32x2_t __attribute__((ext_vector_type(2)));
typedef __bf16 bf16x2_t __attribute__((ext_vector_type(2)));
__device__ __forceinline__ unsigned pk2(float lo, float hi) { f32x2_t v = {lo, hi}; bf16x2_t b = __builtin_convertvector(v, bf16x2_t); return __builtin_bit_cast(unsigned, b); }
__device__ __forceinline__ unsigned f2bf(float f) { return pk2(f, 0.f) & 0xffffu; }
__device__ __forceinline__ float bf2f(unsigned b) { return __uint_as_float(b << 16); }
__device__ __forceinline__ float bflo(unsigned w) { return __uint_as_float(w << 16); }
__device__ __forceinline__ float bfhi(unsigned w) { return __uint_as_float(w & 0xffff0000u); }
__device__ __forceinline__ float sigm(float x) { return __builtin_amdgcn_rcpf(1.0f + __expf(-x)); }
__device__ __forceinline__ float wave_sum_bperm(float v) {
#pragma unroll
    for (int o = 1; o < 64; o <<= 1) v += __shfl_xor(v, o);
    return v;
}

template <int CTRL, int ROWMASK> __device__ __forceinline__ float dpp_f(float oldv, float src) {
    return __builtin_bit_cast(float, __builtin_amdgcn_update_dpp(__builtin_bit_cast(int, oldv), __builtin_bit_cast(int, src), CTRL, ROWMASK, 0xf, false)); }
__device__ __forceinline__ float row16_sum(float v) {
    v += dpp_f<0xB1, 0xf>(0.f, v); v += dpp_f<0x4E, 0xf>(0.f, v); v += dpp_f<0x124, 0xf>(0.f, v); v += dpp_f<0x128, 0xf>(0.f, v); return v; }
__device__ __forceinline__ float wave_sum(float v) {
    v = row16_sum(v);
    const int iv = __builtin_bit_cast(int, v);
    const float r0 = __builtin_bit_cast(float, __builtin_amdgcn_readlane(iv, 0)), r1 = __builtin_bit_cast(float, __builtin_amdgcn_readlane(iv, 16));
    const float r2 = __builtin_bit_cast(float, __builtin_amdgcn_readlane(iv, 32)), r3 = __builtin_bit_cast(float, __builtin_amdgcn_readlane(iv, 48));
    return (r0 + r1) + (r2 + r3);
}
__device__ __forceinline__ float wave_scan_add(float v) {
    v += dpp_f<0x111, 0xf>(0.f, v); v += dpp_f<0x112, 0xf>(0.f, v); v += dpp_f<0x114, 0xf>(0.f, v); v += dpp_f<0x118, 0xf>(0.f, v);
    v += dpp_f<0x142, 0xa>(0.f, v); v += dpp_f<0x143, 0xc>(0.f, v); return v; }
__device__ __forceinline__ float wave_scan_max(float v) {
    const float ninf = -INFINITY;
    v = fmaxf(v, dpp_f<0x111, 0xf>(ninf, v)); v = fmaxf(v, dpp_f<0x112, 0xf>(ninf, v)); v = fmaxf(v, dpp_f<0x114, 0xf>(ninf, v)); v = fmaxf(v, dpp_f<0x118, 0xf>(ninf, v));
    v = fmaxf(v, dpp_f<0x142, 0xa>(ninf, v)); v = fmaxf(v, dpp_f<0x143, 0xc>(ninf, v)); return v; }
#define LDS_WAIT() asm volatile("s_waitcnt lgkmcnt(0)" ::: "memory")
#define BAR_LDS() do { asm volatile("s_waitcnt lgkmcnt(0)" ::: "memory"); __builtin_amdgcn_s_barrier(); asm volatile("" ::: "memory"); } while (0)

namespace pg8 {
constexpr int BM = 256, BK = 64, HALF = 128, HTB = HALF * BK * 2, STAGE_BYTES = 8 * HTB, NXCD = 8, WGM = 8;
__host__ __device__ __forceinline__ int lds_byte(int r, int c) { const int st = (r >> 4) * 2 + (c >> 5), rr = r & 15, cc = c & 31, ob = rr * 64 + cc * 2; return st * 1024 + (ob ^ (((ob >> 9) & 1) << 5)); }
__host__ __device__ __forceinline__ void stage_rc(int b, int& R, int& C) { const int st = b / 1024, sb = b % 1024, swz = sb ^ (((sb >> 9) & 1) << 5); R = (st >> 1) * 16 + swz / 64; C = (st & 1) * 32 + (swz % 64) / 2; }
__host__ __device__ __forceinline__ int perm32(int rho) { const int n = rho >> 4, i = rho & 15; return 8 * (i >> 2) + 4 * n + (i & 3); }

struct Unit { int pm, pn, sub, slot; };
struct StaticOrder {
    int nM, nN, nwg, G, c;
    __device__ void init(int nM_, int nN_, int G_, int c_) { nM = nM_; nN = nN_; nwg = nM * nN; G = G_; c = c_; }
    __device__ bool tile(int i, Unit& u) const {
        const long L = (long)i * G + c; if (L >= nwg) return false;
        int wgid = (int)L; { const int q = nwg / NXCD, r = nwg % NXCD, xcd = wgid % NXCD, off = wgid / NXCD; wgid = (xcd < r ? xcd * (q + 1) : r * (q + 1) + (xcd - r) * q) + off; }
        const int nig = WGM * nN, gid = wgid / nig, fm = gid * WGM, gsz = (nM - fm) < WGM ? (nM - fm) : WGM;
        u.pm = fm + ((wgid % nig) % gsz); u.pn = (wgid % nig) / gsz; u.sub = 0; u.slot = 0; return true;
    }
    __device__ bool next(int i, Unit& u) const { return tile(i, u); }
};
struct PairOrder : StaticOrder {
    __device__ bool next(int i, Unit& u) const { if (!tile(i >> 1, u)) return false; u.sub = i & 1; u.slot = (i >> 1) & 1; return true; }
};
__device__ __forceinline__ unsigned cvt_pk_bf16(float lo, float hi) { return pk2(lo, hi); }

template <class Epi, class Sched, class Prob>
__device__ __forceinline__ void gemm_phase(LAS unsigned char* lds, const int K, const Sched& S, const Epi& E, const Prob& P) {
    const int tid = threadIdx.x, wid = __builtin_amdgcn_readfirstlane(tid >> 6), lane = tid & 63, wr = wid >> 2, wc = wid & 3, fr = lane & 15, fq = lane >> 4;
    const int nt = K / BK;
    unsigned voffA[2], voffB[2];
#pragma unroll
    for (int i = 0; i < 2; ++i) { int R, C; stage_rc(tid * 16 + i * 8192, R, C); const int Rb = Epi::PERM ? ((R & ~31) + perm32(R & 31)) : R;
        voffA[i] = (unsigned)(R * K + C) * 2u; voffB[i] = (unsigned)(Rb * K + C) * 2u; }
    const size_t kstep = (size_t)(BK * 2);
    const size_t hstep = (size_t)HALF * K * 2;
    const unsigned ldsw = (unsigned)wid * 1024u;
    const int aoff = lds_byte(wr * 64 + fr, fq * 8), boff = lds_byte(wc * 32 + fr, fq * 8);
#define PG8_SA(b, h) (((b) * 2 + (h)) * HTB)
#define PG8_SB(b, h) ((4 + (b) * 2 + (h)) * HTB)
#define PG8_STAGE(bufoff, gbase, voff) do { _Pragma("unroll") for (int _i = 0; _i < 2; ++_i) \
        __builtin_amdgcn_global_load_lds((const unsigned*)((const char*)(gbase) + (voff)[_i]), (LAS unsigned*)(lds + (bufoff) + ldsw + _i * 8192), 16, 0, 0); } while (0)
#define PG8_LDA(dst, b, h) do { _Pragma("unroll") for (int m = 0; m < 4; ++m) _Pragma("unroll") for (int k = 0; k < 2; ++k) dst[m][k] = *(const LAS bf16x8*)(lds + PG8_SA(b, h) + aoff + m * 2048 + k * 1024); } while (0)
#define PG8_LDB(dst, b, h) do { _Pragma("unroll") for (int n = 0; n < 2; ++n) _Pragma("unroll") for (int k = 0; k < 2; ++k) dst[n][k] = *(const LAS bf16x8*)(lds + PG8_SB(b, h) + boff + n * 2048 + k * 1024); } while (0)
#define PG8_MMA(ai, bj, At, Bt) do { __builtin_amdgcn_s_setprio(1); _Pragma("unroll") for (int m = 0; m < 4; ++m) _Pragma("unroll") for (int n = 0; n < 2; ++n) _Pragma("unroll") for (int k = 0; k < 2; ++k) \
        acc[ai][bj][m][n] = __builtin_amdgcn_mfma_f32_16x16x32_bf16(Bt[n][k], At[m][k], acc[ai][bj][m][n], 0, 0, 0); __builtin_amdgcn_s_setprio(0); } while (0)
#define PG8_WAIT_V(n) asm volatile("s_waitcnt vmcnt(" #n ")" ::: "memory")
#define PG8_WAIT_L(n) asm volatile("s_waitcnt lgkmcnt(" #n ")" ::: "memory")
#define PG8_BAR __builtin_amdgcn_s_barrier()
#define PG8_SCHED __builtin_amdgcn_sched_barrier(0)
    Unit cur, nxt; int ui = 0;
    if (!S.next(0, cur)) return;
    f32x4 acc[2][2][4][2];
#pragma unroll
    for (int a = 0; a < 2; ++a)
#pragma unroll
        for (int b = 0; b < 2; ++b)
#pragma unroll
            for (int m = 0; m < 4; ++m)
#pragma unroll
                for (int n = 0; n < 2; ++n) acc[a][b][m][n] = (f32x4){0.f, 0.f, 0.f, 0.f};
    bf16x8 At[4][2], B0[2][2], B1[2][2];
    const char* cA = P.a(cur); const char* cB = P.b(cur);
    PG8_STAGE(PG8_SB(0, 0), cB, voffB); PG8_STAGE(PG8_SA(0, 0), cA, voffA); PG8_STAGE(PG8_SB(0, 1), cB + hstep, voffB); PG8_STAGE(PG8_SA(0, 1), cA + hstep, voffA);
    if (wr == 1) PG8_BAR;
    PG8_WAIT_V(4); PG8_BAR;
    PG8_STAGE(PG8_SB(1, 0), cB + kstep, voffB); PG8_STAGE(PG8_SA(1, 0), cA + kstep, voffA); PG8_STAGE(PG8_SB(1, 1), cB + hstep + kstep, voffB);
    PG8_WAIT_V(6); PG8_BAR;
    for (;;) {
        const bool has_next = S.next(ui + 1, nxt);
        const char* nA = has_next ? P.a(nxt) : cA; const char* nB = has_next ? P.b(nxt) : cB;
        for (int t = 0; t < nt; t += 2) {
            const bool last = (t == nt - 2);
#if GEMM_DRAIN
            PG8_WAIT_V(0);
#endif
            E.mid(acc, cur, t, wr, fr, lds);
            const char* a1 = cA + (size_t)(t + 1) * kstep;
            const char* a2 = last ? nA : cA + (size_t)(t + 2) * kstep; const char* b2 = last ? nB : cB + (size_t)(t + 2) * kstep;
            const char* a3 = a2 + kstep; const char* b3 = b2 + kstep;
            PG8_LDB(B0, 0, 0); PG8_SCHED; PG8_LDA(At, 0, 0); PG8_STAGE(PG8_SA(1, 1), a1 + hstep, voffA);
            PG8_WAIT_L(8); PG8_BAR; PG8_WAIT_L(0); PG8_MMA(0, 0, At, B0); PG8_BAR; PG8_SCHED;
            PG8_LDB(B1, 0, 1); PG8_STAGE(PG8_SB(0, 0), b2, voffB);
            PG8_BAR; PG8_WAIT_L(0); PG8_MMA(0, 1, At, B1); PG8_BAR;
            PG8_LDA(At, 0, 1); PG8_STAGE(PG8_SA(0, 0), a2, voffA);
            PG8_BAR; PG8_WAIT_L(0); PG8_MMA(1, 0, At, B0); PG8_BAR; PG8_SCHED;
            PG8_STAGE(PG8_SB(0, 1), b2 + hstep, voffB);
            PG8_WAIT_V(6); PG8_BAR; PG8_MMA(1, 1, At, B1); PG8_BAR;
            PG8_LDB(B0, 1, 0); PG8_SCHED; PG8_LDA(At, 1, 0); PG8_STAGE(PG8_SA(0, 1), a2 + hstep, voffA);
            PG8_WAIT_L(8); PG8_BAR; PG8_WAIT_L(0); PG8_MMA(0, 0, At, B0); PG8_BAR; PG8_SCHED;
            PG8_LDB(B1, 1, 1); PG8_STAGE(PG8_SB(1, 0), b3, voffB);
            PG8_BAR; PG8_WAIT_L(0); PG8_MMA(0, 1, At, B1); PG8_BAR;
            PG8_LDA(At, 1, 1); PG8_STAGE(PG8_SA(1, 0), a3, voffA);
            PG8_BAR; PG8_WAIT_L(0); PG8_MMA(1, 0, At, B0); PG8_BAR; PG8_SCHED;
            PG8_STAGE(PG8_SB(1, 1), b3 + hstep, voffB);
            PG8_WAIT_V(6); PG8_BAR; PG8_MMA(1, 1, At, B1); PG8_BAR;
        }
        E(acc, cur, wr, wc, fr, fq, lds);
        if (!has_next) break;
        cur = nxt; cA = nA; cB = nB; ++ui;
    }
    PG8_WAIT_V(0);
    if (wr == 0) PG8_BAR;
    PG8_BAR;
#undef PG8_SA
#undef PG8_SB
#undef PG8_STAGE
#undef PG8_LDA
#undef PG8_LDB
#undef PG8_MMA
#undef PG8_WAIT_V
#undef PG8_WAIT_L
#undef PG8_BAR
#undef PG8_SCHED
}
#define ACC_ZERO(acc) do { _Pragma("unroll") for (int a_ = 0; a_ < 2; ++a_) _Pragma("unroll") for (int b_ = 0; b_ < 2; ++b_) _Pragma("unroll") for (int m_ = 0; m_ < 4; ++m_) _Pragma("unroll") for (int n_ = 0; n_ < 2; ++n_) acc[a_][b_][m_][n_] = (f32x4){0.f, 0.f, 0.f, 0.f}; } while (0)
}


#define XB_TMO      128
#define XB_XCNT(j)  (256  + 64 * (j))
#define XB_XSUB(j)  (1280 + 64 * (j))
#define XB_XGEN(j)  (2304 + 64 * (j))
#define XB_TOP      3328
#define XB_TOPGEN   3392
#define XCD_BAR_WORDS 3456
#define XB_SPIN_CAP (1u << 18)

__device__ __forceinline__ unsigned xb_ld(unsigned* p)              { return __hip_atomic_load(p, __ATOMIC_RELAXED, __HIP_MEMORY_SCOPE_AGENT); }
__device__ __forceinline__ unsigned xb_add(unsigned* p, unsigned v) { return __hip_atomic_fetch_add(p, v, __ATOMIC_RELAXED, __HIP_MEMORY_SCOPE_AGENT); }
__device__ __forceinline__ unsigned xb_xcc_id() { return (unsigned)__builtin_amdgcn_s_getreg((3 << 11) | 20) & 0xFu; }
#define XB_SPIN(cond, bar) do { unsigned _sp = 0; while (cond) { __builtin_amdgcn_s_sleep(1); \
    if ((++_sp & 255u) == 0u) { if (xb_ld(&(bar)[XB_TMO])) break; if (_sp > XB_SPIN_CAP) { atomicAdd(&(bar)[XB_TMO], 1u); break; } } } } while (0)

struct XcdBarrier {
    unsigned* bar; unsigned x;
    volatile LAS unsigned* st;
};

__device__ __forceinline__ XcdBarrier xcd_barrier_post(unsigned* bar, volatile LAS unsigned* st) {
    XcdBarrier b; b.bar = bar; b.x = xb_xcc_id(); b.st = st;
    if (threadIdx.x == 0) (void)xb_add(&bar[XB_XCNT(b.x)], 1u);
    return b;
}
__device__ __forceinline__ void xcd_barrier_complete(unsigned* bar, unsigned x, unsigned& nloc, unsigned& nx) {
    const unsigned G = gridDim.x * gridDim.y * gridDim.z;
    unsigned sum, cnt, mine, sp = 0u;
    for (;;) {
        sum = 0u; cnt = 0u; mine = 0u;
#pragma unroll
        for (unsigned j = 0; j < 16; ++j) { const unsigned c = xb_ld(&bar[XB_XCNT(j)]); sum += c; cnt += (c > 0u) ? 1u : 0u; mine = (j == x) ? c : mine; }
        if (sum == G) break;
        __builtin_amdgcn_s_sleep(1);
        if ((++sp & 255u) == 0u) { if (xb_ld(&bar[XB_TMO])) break; if (sp > XB_SPIN_CAP) { atomicAdd(&bar[XB_TMO], 1u); break; } }
    }
    nloc = mine > 0u ? mine : 1u; nx = cnt > 0u ? cnt : 1u;
}

__device__ __forceinline__ void xcd_barrier(const XcdBarrier& b) {
    asm volatile("s_waitcnt vmcnt(0)" ::: "memory");
    __syncthreads();
    if (threadIdx.x == 0) {
        unsigned* bar = b.bar;
        __builtin_amdgcn_s_waitcnt(0);
        unsigned nloc = b.st[0], nx = b.st[1];
        if (nloc == 0u) { xcd_barrier_complete(bar, b.x, nloc, nx); b.st[0] = nloc; b.st[1] = nx; }
        const unsigned old = xb_add(&bar[XB_XSUB(b.x)], 1u);
        const unsigned gen = old / nloc;
        if (old + 1u == (gen + 1u) * nloc) {
            __builtin_amdgcn_fence(__ATOMIC_RELEASE, "agent");
            asm volatile("s_waitcnt vmcnt(0)" ::: "memory");
            const unsigned og = xb_add(&bar[XB_TOP], 1u);
            const unsigned tg = og / nx;
            if (og + 1u == (tg + 1u) * nx) xb_add(&bar[XB_TOPGEN], 1u);
            else XB_SPIN(xb_ld(&bar[XB_TOPGEN]) == tg, bar);
            __builtin_amdgcn_fence(__ATOMIC_ACQUIRE, "agent");
            xb_add(&bar[XB_XGEN(b.x)], 1u);
            asm volatile("s_waitcnt vmcnt(0)" ::: "memory");
        } else {
            XB_SPIN(xb_ld(&bar[XB_XGEN(b.x)]) == gen, bar);
            __builtin_amdgcn_fence(__ATOMIC_ACQUIRE, "agent");
            asm volatile("s_waitcnt vmcnt(0)" ::: "memory");
        }
    }
    __syncthreads();
}


struct TV { bf16_t* big; bf16_t* sm; };
__device__ __forceinline__ bf16_t* tv_tile(const TV& t, int pm) { return pm < 128 ? t.big + (size_t)pm * 256 * DM : t.sm; }
__device__ __forceinline__ bf16_t* tv_row(const TV& t, int row) { return row < NTP ? t.big + (size_t)row * DM : t.sm + (size_t)(row - NTP) * DM; }

struct Epi1 {
    static constexpr bool PERM = true;
    __device__ __forceinline__ void mid(f32x4 (&)[2][2][4][2], const pg8::Unit&, int, int, int, LAS unsigned char*) const {}
    TV Q, K, V, OG, XB, SZB, GA, GB; const float* b_gate;
    __device__ __forceinline__ void operator()(f32x4 (&acc)[2][2][4][2], const pg8::Unit& u, int wr, int wc, int fr, int fq, LAS unsigned char* lds) const {
        const int pn = u.pn; int type, colt; TV tv; const float* bias = nullptr;
        if (pn < 4) { type = 0; tv = Q; colt = pn * 256; }
        else if (pn < 8) { type = 1; tv = K; colt = (pn - 4) * 256; }
        else if (pn < 12) { type = 0; tv = V; colt = (pn - 8) * 256; }
        else if (pn < 20) { type = 2; tv = OG; colt = (pn - 12) * 128; }
        else if (pn < 24) { type = 0; tv = XB; colt = (pn - 20) * 256; }
        else if (pn < 28) { type = 3; tv = SZB; colt = (pn - 24) * 256; }
        else { type = 4; tv = GA; colt = (pn - 28) * 128; bias = b_gate + colt; }
        bf16_t* base = tv_tile(tv, u.pm);
        const int nai = (u.pm < 128) ? 2 : 1;
        const int cl = wc * 32 + 8 * fq;
        if (type == 2) {
#pragma unroll
            for (int ai = 0; ai < 2; ++ai) if (ai < nai)
#pragma unroll
                for (int m = 0; m < 4; ++m) {
                    bf16_t* rowp = base + (size_t)(ai * 128 + wr * 64 + m * 16 + fr) * DM + colt + cl;
                    float v[8];
#pragma unroll
                    for (int n = 0; n < 2; ++n)
#pragma unroll
                        for (int j = 0; j < 4; ++j) { const float o = acc[ai][0][m][n][j], z = acc[ai][1][m][n][j]; v[n * 4 + j] = sigm(o) * z * sigm(z); }
                    u32x4 w; w.x = pg8::cvt_pk_bf16(v[0], v[1]); w.y = pg8::cvt_pk_bf16(v[2], v[3]); w.z = pg8::cvt_pk_bf16(v[4], v[5]); w.w = pg8::cvt_pk_bf16(v[6], v[7]);
                    *(u32x4*)rowp = w;
                }
        } else if (type == 4) {
            f32x4 bv[2][2];
#pragma unroll
            for (int bj = 0; bj < 2; ++bj)
#pragma unroll
                for (int n = 0; n < 2; ++n) bv[bj][n] = *(const f32x4*)(bias + bj * 1024 + cl + 4 * n);
            bf16_t* baseb = tv_tile(GB, u.pm);
#pragma unroll
            for (int ai = 0; ai < 2; ++ai) if (ai < nai)
#pragma unroll
                for (int m = 0; m < 4; ++m) {
                    const size_t ro = (size_t)(ai * 128 + wr * 64 + m * 16 + fr) * DM + colt + cl;
                    float vr[8], vg[8];
#pragma unroll
                    for (int n = 0; n < 2; ++n)
#pragma unroll
                        for (int j = 0; j < 4; ++j) { const float ea = __expf(-(acc[ai][0][m][n][j] + bv[0][n][j])), eb = __expf(-fmaxf(acc[ai][1][m][n][j] + bv[1][n][j], -30.f));
                            vg[n * 4 + j] = __builtin_amdgcn_rcpf(1.0f + eb); vr[n * 4 + j] = (1.0f + eb) * __builtin_amdgcn_rcpf(1.0f + ea); }
                    u32x4 w; w.x = pg8::cvt_pk_bf16(vr[0], vr[1]); w.y = pg8::cvt_pk_bf16(vr[2], vr[3]); w.z = pg8::cvt_pk_bf16(vr[4], vr[5]); w.w = pg8::cvt_pk_bf16(vr[6], vr[7]);
                    *(u32x4*)(base + ro) = w;
                    w.x = pg8::cvt_pk_bf16(vg[0], vg[1]); w.y = pg8::cvt_pk_bf16(vg[2], vg[3]); w.z = pg8::cvt_pk_bf16(vg[4], vg[5]); w.w = pg8::cvt_pk_bf16(vg[6], vg[7]);
                    *(u32x4*)(baseb + ro) = w;
                }
        } else {
            const float sc = (type == 1) ? 0.0625f : 1.0f; const bool silu = (type == 3);
#pragma unroll
            for (int ai = 0; ai < 2; ++ai) if (ai < nai)
#pragma unroll
                for (int m = 0; m < 4; ++m) {
                    bf16_t* rowp = base + (size_t)(ai * 128 + wr * 64 + m * 16 + fr) * DM + colt + cl;
#pragma unroll
                    for (int bj = 0; bj < 2; ++bj) {
                        float v[8];
#pragma unroll
                        for (int n = 0; n < 2; ++n)
#pragma unroll
                            for (int j = 0; j < 4; ++j) { float x = acc[ai][bj][m][n][j] * sc; if (silu) x = x * sigm(x); v[n * 4 + j] = x; }
                        u32x4 w; w.x = pg8::cvt_pk_bf16(v[0], v[1]); w.y = pg8::cvt_pk_bf16(v[2], v[3]); w.z = pg8::cvt_pk_bf16(v[4], v[5]); w.w = pg8::cvt_pk_bf16(v[6], v[7]);
                        *(u32x4*)(rowp + bj * 128) = w;
                    }
                }
        }
        ACC_ZERO(acc);
    }
};
struct Prob1 { TV U; const bf16_t* W;
    __device__ __forceinline__ const char* a(const pg8::Unit& u) const { return (const char*)tv_tile(U, u.pm); }
    __device__ __forceinline__ const char* b(const pg8::Unit& u) const { return (const char*)(W + (size_t)u.pn * 256 * DM); } };

struct Epi2 {
    static constexpr bool PERM = true;
    __device__ __forceinline__ void mid(f32x4 (&acc)[2][2][4][2], const pg8::Unit& u, int t, int wr, int fr, LAS unsigned char* lds) const {
        if (u.sub != 0 || t == 0 || (t & 3) != 0) return;
        const int hd = t >> 2;
        const LAS float* RS = (const LAS float*)(lds + RS_OFF) + u.slot * 1024;
#pragma unroll
        for (int ai = 0; ai < 2; ++ai)
#pragma unroll
            for (int m = 0; m < 4; ++m) { const int rl = ai * 128 + wr * 64 + m * 16 + fr;
                const float ratio = RS[rl * 4 + hd - 1] * __builtin_amdgcn_rcpf(RS[rl * 4 + hd]);
#pragma unroll
                for (int bj = 0; bj < 2; ++bj)
#pragma unroll
                    for (int n = 0; n < 2; ++n) acc[ai][bj][m][n] = acc[ai][bj][m][n] * ratio; }
    }
    TV GA, GB, MG;
    __device__ __forceinline__ void operator()(f32x4 (&acc)[2][2][4][2], const pg8::Unit& u, int wr, int wc, int fr, int fq, LAS unsigned char* lds) const {
        const bf16_t* ga = tv_tile(GA, u.pm); const bf16_t* gb = tv_tile(GB, u.pm); bf16_t* mg = tv_tile(MG, u.pm);
        {
            int t_ = threadIdx.x; asm volatile("" : "+v"(t_));
            const unsigned off0 = (unsigned)(((t_ >> 6) * 32 + (t_ & 63) / 4) << 11) + (unsigned)((t_ & 3) << 7);
            const char* gbt = (const char*)(gb + u.pn * 256); const char* gat = (const char*)(ga + u.pn * 256);
#pragma unroll
            for (int q = 0; q < 2; ++q) __builtin_amdgcn_global_load_lds((const unsigned*)((u.sub == 0 ? gat : gbt) + off0 + q * 32768u), (LAS unsigned*)(lds + PF_OFF), 16, 0, 0);
        }
        const int nai = (u.pm < 128) ? 2 : 1;
        const int col0 = u.pn * 256 + wc * 32 + 8 * fq;
#pragma unroll
        for (int ai = 0; ai < 2; ++ai) if (ai < nai)
#pragma unroll
            for (int m = 0; m < 4; ++m) {
                const size_t ro = (size_t)(ai * 128 + wr * 64 + m * 16 + fr) * DM + col0;
                const float rs3 = ((const LAS float*)(lds + RS_OFF))[u.slot * 1024 + (ai * 128 + wr * 64 + m * 16 + fr) * 4 + 3];
#pragma unroll
                for (int bj = 0; bj < 2; ++bj) {
                    const u32x4 gbw = *(const u32x4*)((u.sub == 0 ? ga : gb) + ro + bj * 128);
                    float gbv[8] = {bflo(gbw.x), bfhi(gbw.x), bflo(gbw.y), bfhi(gbw.y), bflo(gbw.z), bfhi(gbw.z), bflo(gbw.w), bfhi(gbw.w)};
                    if (u.sub == 0) {
#pragma unroll
                        for (int n = 0; n < 2; ++n)
#pragma unroll
                            for (int j = 0; j < 4; ++j) acc[ai][bj][m][n][j] *= rs3 * gbv[n * 4 + j];
                    } else {
                        float v[8];
#pragma unroll
                        for (int n = 0; n < 2; ++n)
#pragma unroll
                            for (int j = 0; j < 4; ++j) v[n * 4 + j] = acc[ai][bj][m][n][j] * gbv[n * 4 + j];
                        u32x4 w; w.x = pg8::cvt_pk_bf16(v[0], v[1]); w.y = pg8::cvt_pk_bf16(v[2], v[3]); w.z = pg8::cvt_pk_bf16(v[4], v[5]); w.w = pg8::cvt_pk_bf16(v[6], v[7]);
                        *(u32x4*)(mg + ro + bj * 128) = w;
                    }
                }
            }
        if (u.sub == 1) ACC_ZERO(acc);
    }
};
struct Prob2 { TV YA, YB; const bf16_t* WA; const bf16_t* WB;
    __device__ __forceinline__ const char* a(const pg8::Unit& u) const { return (const char*)tv_tile(u.sub ? YB : YA, u.pm); }
    __device__ __forceinline__ const char* b(const pg8::Unit& u) const { return (const char*)((u.sub ? WB : WA) + (size_t)u.pn * 256 * DM); } };

struct Epi3 {
    static constexpr bool PERM = true;
    __device__ __forceinline__ void mid(f32x4 (&)[2][2][4][2], const pg8::Unit&, int, int, int, LAS unsigned char*) const {}
    const float* xp; bf16_t* yb; const float* modg; float* rowss;
    __device__ __forceinline__ void operator()(f32x4 (&acc)[2][2][4][2], const pg8::Unit& u, int wr, int wc, int fr, int fq, LAS unsigned char* lds) const {
        const int col0 = u.pn * 256 + wc * 32 + 8 * fq;
        const float* xb = xp + (size_t)u.pm * 256 * DM;
        int t_ = threadIdx.x; asm volatile("" : "+v"(t_));
        const int rl_ = (t_ >> 8) * 64 + (t_ & 15);
        {
            const char* xt = (const char*)(xb + u.pn * 256);
            const unsigned off0 = (unsigned)(((t_ >> 6) * 32 + (t_ & 63) / 8) << 12) + (unsigned)((t_ & 7) << 7);
#pragma unroll
            for (int q = 0; q < 4; ++q) __builtin_amdgcn_global_load_lds((const unsigned*)(xt + off0 + q * 32768u), (LAS unsigned*)(lds + PF_OFF), 16, 0, 0);
        }
        bf16_t* ob = yb + (size_t)u.pm * 256 * DM;
        const float* gp = modg + (u.pm >> 3) * DM + col0;
#pragma unroll
        for (int ai = 0; ai < 2; ++ai)
#pragma unroll
            for (int m = 0; m < 4; ++m) {
                const int rl = ai * 128 + wr * 64 + m * 16 + fr;
                const size_t ro = (size_t)rl * DM + col0;
                float ss = 0.f;
#pragma unroll
                for (int bj = 0; bj < 2; ++bj) {
                    const f32x4 y0 = *(const f32x4*)(xb + ro + bj * 128) + *(const f32x4*)(gp + bj * 128) * acc[ai][bj][m][0];
                    const f32x4 y1 = *(const f32x4*)(xb + ro + bj * 128 + 4) + *(const f32x4*)(gp + bj * 128 + 4) * acc[ai][bj][m][1];
                    ss += ((y0[0] * y0[0] + y0[1] * y0[1]) + (y0[2] * y0[2] + y0[3] * y0[3])) + ((y1[0] * y1[0] + y1[1] * y1[1]) + (y1[2] * y1[2] + y1[3] * y1[3]));
                    u32x4 w; w.x = pk2(y0[0], y0[1]); w.y = pk2(y0[2], y0[3]); w.z = pk2(y1[0], y1[1]); w.w = pk2(y1[2], y1[3]);
                    *(u32x4*)(ob + ro + bj * 128) = w;
                }
                ss += __shfl_xor(ss, 16); ss += __shfl_xor(ss, 32);
                if (fq == 0) rowss[((size_t)u.pm * 256 + ai * 128 + m * 16 + rl_) * 16 + u.pn * 4 + (t_ >> 6 & 3)] = ss;
            }
        ACC_ZERO(acc);
    }
};
struct Prob3 { TV MG; const bf16_t* WO;
    __device__ __forceinline__ const char* a(const pg8::Unit& u) const { return (const char*)tv_tile(MG, u.pm); }
    __device__ __forceinline__ const char* b(const pg8::Unit& u) const { return (const char*)(WO + (size_t)u.pn * 256 * DM); } };


__device__ __forceinline__ void mini_gemm2(const Params& p, LAS unsigned char* lds) {
    const int lane = threadIdx.x & 63, wave = threadIdx.x >> 6, g = lane >> 4, li = lane & 15, tsel = wave >> 2, ksl = wave & 3;
    unsigned char* ws = p.ws;
    const bf16_t* ya = (const bf16_t*)(ws + WS_SMALL + SM_V * SMALL_B); const bf16_t* yb = (const bf16_t*)(ws + WS_SMALL + SM_SZB * SMALL_B);
    const bf16_t* ga = (const bf16_t*)(ws + WS_SMALL + SM_GA * SMALL_B); const bf16_t* gb = (const bf16_t*)(ws + WS_SMALL + SM_GB * SMALL_B);
    bf16_t* mg = (bf16_t*)(ws + WS_SMALL + SM_U * SMALL_B);
    const bf16_t* wa = (const bf16_t*)(ws + WS_WAT); const bf16_t* wb = (const bf16_t*)(ws + WS_WBT);
    LAS float* red = (LAS float*)lds;
    for (int t0 = blockIdx.x * 2; t0 < 512; t0 += gridDim.x * 2) {
        const int wt = t0 + tsel, r0 = (wt >> 6) * 16, c0 = (wt & 63) * 16;
        const bf16_t* pa = ya + (size_t)(r0 + li) * DM + ksl * 256 + 8 * g; const bf16_t* pb = yb + (size_t)(r0 + li) * DM + ksl * 256 + 8 * g;
        const bf16_t* qa = wa + (size_t)(c0 + li) * DM + ksl * 256 + 8 * g; const bf16_t* qb = wb + (size_t)(c0 + li) * DM + ksl * 256 + 8 * g;
        f32x4 a1 = (f32x4){0.f, 0.f, 0.f, 0.f}, a2 = (f32x4){0.f, 0.f, 0.f, 0.f};
#pragma unroll
        for (int k0 = 0; k0 < 256; k0 += 32) {
            a1 = __builtin_amdgcn_mfma_f32_16x16x32_bf16(*(const bf16x8*)(pa + k0), *(const bf16x8*)(qa + k0), a1, 0, 0, 0);
            a2 = __builtin_amdgcn_mfma_f32_16x16x32_bf16(*(const bf16x8*)(pb + k0), *(const bf16x8*)(qb + k0), a2, 0, 0, 0);
        }
        { const float* hss = (const float*)(ws + WS_HSS);
#pragma unroll
          for (int r = 0; r < 4; ++r) { const f32x4 hs = *(const f32x4*)(hss + (size_t)(NTP + r0 + 4 * g + r) * 16 + ksl * 4);
              a1[r] *= rsqrtf(((hs[0] + hs[1]) + (hs[2] + hs[3])) * (1.0f / 256.0f) + EPS); } }
        *(LAS f32x4*)(red + (wave * 64 + lane) * 8) = a1; *(LAS f32x4*)(red + (wave * 64 + lane) * 8 + 4) = a2;
        __syncthreads();
        if (ksl == 0) {
#pragma unroll
            for (int q = 1; q < 4; ++q) { a1 += *(const LAS f32x4*)(red + ((wave + q) * 64 + lane) * 8); a2 += *(const LAS f32x4*)(red + ((wave + q) * 64 + lane) * 8 + 4); }
#pragma unroll
            for (int r = 0; r < 4; ++r) { const size_t o = (size_t)(r0 + 4 * g + r) * DM + c0 + li;
                mg[o] = (bf16_t)f2bf(bf2f(gb[o]) * (bf2f(ga[o]) * a1[r] + a2[r])); }
        }
        __syncthreads();
    }
}
__device__ __forceinline__ void mini_gemm3(const Params& p, LAS unsigned char* lds) {
    const int lane = threadIdx.x & 63, wave = threadIdx.x >> 6, g = lane >> 4, li = lane & 15, tsel = wave >> 2, ksl = wave & 3;
    unsigned char* ws = p.ws;
    const bf16_t* mg = (const bf16_t*)(ws + WS_SMALL + SM_U * SMALL_B); const bf16_t* wo = (const bf16_t*)(ws + WS_WOT);
    const float* modg = (const float*)(ws + WS_MODG);
    LAS float* red = (LAS float*)lds;
    for (int t0 = blockIdx.x * 2; t0 < 512; t0 += gridDim.x * 2) {
        const int wt = t0 + tsel, r0 = (wt >> 6) * 16, c0 = (wt & 63) * 16;
        const bf16_t* pa = mg + (size_t)(r0 + li) * DM + ksl * 256 + 8 * g; const bf16_t* qa = wo + (size_t)(c0 + li) * DM + ksl * 256 + 8 * g;
        f32x4 a1 = (f32x4){0.f, 0.f, 0.f, 0.f};
#pragma unroll
        for (int k0 = 0; k0 < 256; k0 += 32) a1 = __builtin_amdgcn_mfma_f32_16x16x32_bf16(*(const bf16x8*)(pa + k0), *(const bf16x8*)(qa + k0), a1, 0, 0, 0);
        *(LAS f32x4*)(red + (wave * 64 + lane) * 4) = a1;
        __syncthreads();
        if (ksl == 0) {
#pragma unroll
            for (int q = 1; q < 4; ++q) a1 += *(const LAS f32x4*)(red + ((wave + q) * 64 + lane) * 4);
#pragma unroll
            for (int r = 0; r < 4; ++r) { const int row = r0 + 4 * g + r, col = c0 + li;
                p.out[O_YS + (size_t)row * DM + col] = p.in[1][(size_t)row * DM + col] + modg[(16 + (row >> 4)) * DM + col] * a1[r]; }
        }
        __syncthreads();
    }
}

__device__ __forceinline__ void transpose_item(const float* W, int ldw, int col0, int k0, bf16_t* WT, int ldt, int row0, LAS float* scr, int lane, const float* kscale = nullptr) {
#pragma unroll
    for (int i = 0; i < 32; ++i) { const int kk = 2 * i + (lane >> 5); float v = W[(size_t)(k0 + kk) * ldw + col0 + (lane & 31)]; if (kscale) v *= kscale[k0 + kk]; scr[kk * 33 + (lane & 31)] = v; }
    LDS_WAIT(); asm volatile("" ::: "memory");
    const int c = lane & 7;
#pragma unroll
    for (int j = 0; j < 4; ++j) { const int n = (lane >> 3) + 8 * j; const LAS float* s = scr + (8 * c) * 33 + n;
        u32x4 o; o.x = pk2(s[0 * 33], s[1 * 33]); o.y = pk2(s[2 * 33], s[3 * 33]); o.z = pk2(s[4 * 33], s[5 * 33]); o.w = pk2(s[6 * 33], s[7 * 33]);
        *(u32x4*)(WT + (size_t)(row0 + n) * ldt + k0 + 8 * c) = o; }
    LDS_WAIT(); asm volatile("" ::: "memory");
}

__device__ __forceinline__ void phase0(const Params& p, LAS unsigned char* lds) {
    const int tid = threadIdx.x, lane = tid & 63, wave = tid >> 6, G = gridDim.x;
    unsigned char* ws = p.ws;
    for (int it = blockIdx.x; it < 192; it += G) {
        const int cgp = it % 48, ks = it / 48;
        LAS float* cs = (LAS float*)lds;
        LAS float* red = (LAS float*)(lds + 24576);
        for (int i = tid; i < 24 * 256; i += 512) { const int b = i >> 8, k = i & 255; cs[k * 24 + b] = (b < 16) ? p.in[2][b * DM + ks * 256 + k] : p.in[3][(b - 16) * DM + ks * 256 + k]; }
        __syncthreads();
        const int col = tid & 63, kq = tid >> 6;
        float a[24];
#pragma unroll
        for (int b = 0; b < 24; ++b) a[b] = 0.f;
        const float* wm = p.in[9] + (size_t)(ks * 256 + kq * 32) * 3072 + cgp * 64 + col;
        for (int kb = 0; kb < 32; kb += 8) {
            float wv[8];
#pragma unroll
            for (int i = 0; i < 8; ++i) wv[i] = wm[(size_t)(kb + i) * 3072];
#pragma unroll
            for (int i = 0; i < 8; ++i) {
#pragma unroll
                for (int b = 0; b < 24; ++b) a[b] += cs[(kq * 32 + kb + i) * 24 + b] * wv[i];
                asm volatile("" ::: "memory"); }
        }
#pragma unroll
        for (int b = 0; b < 24; ++b) red[(kq * 24 + b) * 64 + col] = a[b];
        __syncthreads();
        float* modp = (float*)(ws + WS_MODP);
        for (int i = tid; i < 24 * 64; i += 512) { const int b = i >> 6, c = i & 63; float s = 0.f;
#pragma unroll
            for (int q = 0; q < 8; ++q) s += red[(q * 24 + b) * 64 + c];
            modp[((size_t)ks * 24 + b) * 3072 + cgp * 64 + c] = s; }
        __syncthreads();
    }
    { float* wif = (float*)(ws + WS_WIF);
      for (int i = blockIdx.x * 512 + tid; i < 8 * DM; i += G * 512) { const int g = i >> 10, k = i & 1023; wif[i] = p.in[12][(size_t)k * DIN + 5120 + g]; } }
    LAS float* scr = (LAS float*)(lds + wave * 16384);
    const int gw = blockIdx.x * 8 + wave, NGW = G * 8;
    constexpr int I_W1 = 288 * 16, I_SQ = 32 * 16, I_R = 64, NIT = I_W1 + 3 * I_SQ + 2 * I_R;
    for (int it = gw; it < NIT; it += NGW) {
        int r = it;
        if (r < I_W1) {
            const int rg = r >> 4, kb = r & 15, pn = rg >> 3, c0 = (rg & 7) * 32; const float* W; int ldw, col;
            if (pn < 12) { W = p.in[12]; ldw = DIN; col = rg * 32; }
            else if (pn < 20) { W = p.in[12]; ldw = DIN; const int j = pn - 12; col = (c0 < 128) ? 3072 + 128 * j + c0 : 4096 + 128 * j + (c0 - 128); }
            else if (pn < 24) { W = p.in[12]; ldw = DIN; col = 5128 + (rg * 32 - 5120); }
            else if (pn < 28) { W = p.in[12]; ldw = DIN; col = 6152 + (rg * 32 - 6144); }
            else { W = p.in[22]; ldw = 2048; const int j = pn - 28; col = (c0 < 128) ? 128 * j + c0 : 1024 + 128 * j + (c0 - 128); }
            transpose_item(W, ldw, col, kb * 64, (bf16_t*)(ws + WS_W1T), DM, rg * 32, scr, lane); continue; }
        r -= I_W1;
        if (r < 3 * I_SQ) { const int w = r / I_SQ, q = r % I_SQ, rg = q >> 4, kb = q & 15;
            transpose_item(p.in[24 + w], DM, rg * 32, kb * 64, (bf16_t*)(ws + (w == 0 ? WS_WAT : (w == 1 ? WS_WBT : WS_WOT))), DM, rg * 32, scr, lane, w == 0 ? p.in[14] : nullptr); continue; }
        r -= 3 * I_SQ;
        { const int w = r / I_R, q = r % I_R, n = q >> 3, rg = (q >> 1) & 3, kb = q & 1;
          transpose_item(p.in[w ? 19 : 17] + (size_t)n * 16384, 128, rg * 32, kb * 64, (bf16_t*)(ws + (w ? WS_WRXT : WS_WRAT)) + (size_t)n * 16384, 128, rg * 32, scr, lane); }
    }
}

__device__ __forceinline__ void phase1(const Params& p, LAS unsigned char* lds) {
    const int tid = threadIdx.x, lane = tid & 63, wave = tid >> 6, G = gridDim.x;
    unsigned char* ws = p.ws;
    LAS float* wif = (LAS float*)lds;
    { const float* src = (const float*)(ws + WS_WIF); for (int i = tid; i < 8 * DM; i += 512) wif[i] = src[i]; }
    __syncthreads();
    const float* modp = (const float*)(ws + WS_MODP); const float* b_mod = p.in[10]; const float* g_norm = p.in[11]; const float* b_if = p.in[13];
    float* IF = (float*)(ws + WS_IF);
    TV U{(bf16_t*)(ws + WS_U), (bf16_t*)(ws + WS_SMALL + SM_U * SMALL_B)};
    { float* modg = (float*)(ws + WS_MODG);
      for (int i = blockIdx.x * 512 + tid; i < 24 * DM; i += G * 512) { const int b = i >> 10, c = i & 1023; float s = b_mod[2048 + c];
#pragma unroll
          for (int ks = 0; ks < 4; ++ks) s += modp[((size_t)ks * 24 + b) * 3072 + 2048 + c];
          modg[i] = s; } }
    const bool h32 = (lane & 32) != 0, h16 = (lane & 16) != 0, h8 = (lane & 8) != 0;
    const int gi = (h32 ? 4 : 0) + (h16 ? 2 : 0) + (h8 ? 1 : 0);
    const float bif = b_if[gi];
    for (int wi = blockIdx.x * 8 + wave; wi < NTP / 16 + NTS; wi += G * 8) {
        const int row0 = wi < NTP / 16 ? wi * 16 : NTP + (wi - NTP / 16), nrow = wi < NTP / 16 ? 16 : 1;
        const int bidx = row0 < NTP ? (row0 >> 11) : 16 + ((row0 - NTP) >> 4);
        f32x4 sc[4], sh[4];
#pragma unroll
        for (int j = 0; j < 4; ++j) { const int idx = 4 * lane + 256 * j;
            f32x4 s = *(const f32x4*)(b_mod + idx), c = *(const f32x4*)(b_mod + 1024 + idx);
#pragma unroll
            for (int ks = 0; ks < 4; ++ks) { const float* mp = modp + ((size_t)ks * 24 + bidx) * 3072; s += *(const f32x4*)(mp + idx); c += *(const f32x4*)(mp + 1024 + idx); }
            sh[j] = s; sc[j] = *(const f32x4*)(g_norm + idx) * (c + 1.0f); }
        const float* xbase = row0 < NTP ? p.in[0] + (size_t)row0 * DM : p.in[1] + (size_t)(row0 - NTP) * DM;
        f32x4 nv[4];
#pragma unroll
        for (int j = 0; j < 4; ++j) nv[j] = *(const f32x4*)(xbase + 4 * lane + 256 * j);
        for (int r = 0; r < nrow; ++r) {
            const int row = row0 + r;
            f32x4 v[4]; float ss = 0.f;
#pragma unroll
            for (int j = 0; j < 4; ++j) { v[j] = nv[j]; ss += (v[j][0] * v[j][0] + v[j][1] * v[j][1]) + (v[j][2] * v[j][2] + v[j][3] * v[j][3]); }
            if (r + 1 < nrow) {
#pragma unroll
                for (int j = 0; j < 4; ++j) nv[j] = *(const f32x4*)(xbase + (size_t)(r + 1) * DM + 4 * lane + 256 * j); }
            const float rs = rsqrtf(wave_sum(ss) * (1.0f / DM) + EPS);
            bf16_t* ur = tv_row(U, row);
            float d[8];
#pragma unroll
            for (int g = 0; g < 8; ++g) d[g] = 0.f;
#pragma unroll
            for (int j = 0; j < 4; ++j) { v[j] = v[j] * rs * sc[j] + sh[j];
                u32x2 w; w.x = pk2(v[j][0], v[j][1]); w.y = pk2(v[j][2], v[j][3]); *(u32x2*)(ur + 4 * lane + 256 * j) = w;
#pragma unroll
                for (int g = 0; g < 8; ++g) { const f32x4 wv = *(const LAS f32x4*)(wif + g * DM + 4 * lane + 256 * j); d[g] += (v[j][0] * wv[0] + v[j][1] * wv[1]) + (v[j][2] * wv[2] + v[j][3] * wv[3]); } }
            float e[4], f[2], gs;
#pragma unroll
            for (int i = 0; i < 4; ++i) { const float send = h32 ? d[i] : d[i + 4], keep = h32 ? d[i + 4] : d[i]; e[i] = keep + __shfl_xor(send, 32); }
#pragma unroll
            for (int i = 0; i < 2; ++i) { const float send = h16 ? e[i] : e[i + 2], keep = h16 ? e[i + 2] : e[i]; f[i] = keep + __shfl_xor(send, 16); }
            { const float send = h8 ? f[0] : f[1], keep = h8 ? f[1] : f[0]; gs = keep + __shfl_xor(send, 8); }
            gs += __shfl_xor(gs, 4); gs += __shfl_xor(gs, 2); gs += __shfl_xor(gs, 1);
            if ((lane & 7) == 0) { float x = gs + bif;
                if (gi >= 4) x = fminf(x, 0.f) - __logf(1.0f + __expf(-fabsf(x)));
                IF[(size_t)row * 8 + gi] = x; }
        }
    }
}

constexpr int ML_QS = 0, ML_KS = 33792, ML_CB = 67584, ML_VS = 109824, ML_VW = 119040, ML_HS = 128256, ML_F = 137472;
__device__ __forceinline__ void mlstm_item(const Params& p, LAS unsigned char* lds, int b, int h, int vs, bool smp, bool dry) {
    int tid_ = threadIdx.x; asm volatile("" : "+v"(tid_));
    const int tid = tid_, lane = tid & 63, w = __builtin_amdgcn_readfirstlane(tid >> 6), g = lane >> 4, li = lane & 15, q4 = li >> 2, p4 = li & 3;
    unsigned char* ws = p.ws;
    const int L = smp ? DSEQ : 64, nch = smp ? 1 : SEQ / 64;
    const int row0 = smp ? NTP + b * DSEQ : b * SEQ;
    const bf16_t* qb = (smp ? (const bf16_t*)(ws + WS_SMALL + SM_Q * SMALL_B) + (size_t)(b * DSEQ) * DM : (const bf16_t*)(p.out) + (size_t)row0 * DM) + h * 256;
    const bf16_t* kb = (smp ? (const bf16_t*)(ws + WS_SMALL + SM_K * SMALL_B) + (size_t)(b * DSEQ) * DM : (const bf16_t*)((unsigned char*)p.out + 64 * MiB) + (size_t)row0 * DM) + h * 256;
    bf16_t* vb = (smp ? (bf16_t*)(ws + WS_SMALL + SM_V * SMALL_B) + (size_t)(b * DSEQ) * DM : (bf16_t*)(ws + WS_V) + (size_t)row0 * DM) + h * 256 + vs * 64;
    const float* IFb = (const float*)(ws + WS_IF) + (size_t)row0 * 8;
    float* HSSb = (float*)(ws + WS_HSS) + (size_t)row0 * 16 + h * 4 + vs;
    const bf16_t* ogb = (smp ? (const bf16_t*)(ws + WS_SMALL + SM_OG * SMALL_B) + (size_t)(b * DSEQ) * DM : (const bf16_t*)(ws + WS_OG) + (size_t)row0 * DM) + h * 256 + vs * 64;
    LAS float* F = (LAS float*)(lds + ML_F);
    LAS float *IG = F, *LF = F + 64, *HSQ = F + 128;
    LAS float *GGw = F + 264 + 320 * w, *MMw = GGw + 64, *SIw = GGw + 128, *EMw = GGw + 192, *WSw = GGw + 256;
    const int bh = b * 4 + h;
    const int vt = w & 3, ktb = (w >> 2) * 8, i0 = 2 * (w & 3);
    f32x4 cst[8], nst[2];
    float m_state;
    if (smp) {
        const float* C0 = p.in[4] + (size_t)bh * 65536 + (size_t)(vs * 64 + vt * 16 + li) * 256;
#pragma unroll
        for (int i = 0; i < 8; ++i) cst[i] = *(const f32x4*)(C0 + (ktb + i) * 16 + 4 * g);
#pragma unroll
        for (int q = 0; q < 2; ++q) nst[q] = (li == 0) ? *(const f32x4*)(p.in[5] + bh * 256 + (ktb + i0 + q) * 16 + 4 * g) : (f32x4){0.f, 0.f, 0.f, 0.f};
        m_state = p.in[6][bh];
    } else {
#pragma unroll
        for (int i = 0; i < 8; ++i) cst[i] = (f32x4){0.f, 0.f, 0.f, 0.f};
        nst[0] = (f32x4){0.f, 0.f, 0.f, 0.f}; nst[1] = nst[0];
        m_state = 0.f;
    }
#pragma unroll
    for (int i = 0; i < 8; ++i) { u32x2 wv; wv.x = pk2(cst[i][0], cst[i][1]); wv.y = pk2(cst[i][2], cst[i][3]);
        *(LAS u32x2*)(lds + ML_CB + (vt * 16 + li) * 528 + ((ktb + i) * 16 + 4 * g) * 2) = wv; }
    if (li == 0) {
#pragma unroll
        for (int q = 0; q < 2; ++q) { u32x2 wv; wv.x = pk2(nst[q][0], nst[q][1]); wv.y = pk2(nst[q][2], nst[q][3]);
            *(LAS u32x2*)(lds + ML_CB + 64 * 528 + ((ktb + i0 + q) * 16 + 4 * g) * 2) = wv; } }
    u32x4 rq[4], rk[4], rv; float rig = 0.f, rlf = 0.f;
    const u32x4 z4 = (u32x4){0u, 0u, 0u, 0u};
#define ML_PREFETCH(c) do { const int t0_ = (c) * 64; \
        _Pragma("unroll") for (int i_ = 0; i_ < 4; ++i_) { const int id_ = tid + 512 * i_, r_ = id_ >> 5, ch_ = id_ & 31; \
            if (!smp || r_ < L) { rq[i_] = *(const u32x4*)(qb + (size_t)(t0_ + r_) * DM + ch_ * 8); rk[i_] = *(const u32x4*)(kb + (size_t)(t0_ + r_) * DM + ch_ * 8); } else { rq[i_] = z4; rk[i_] = z4; } } \
        { const int r_ = tid >> 3, ch_ = tid & 7; rv = (!smp || r_ < L) ? *(const u32x4*)(vb + (size_t)(t0_ + r_) * DM + ch_ * 8) : z4; } \
        if (tid < 64) { if (!smp || tid < L) { rig = IFb[(size_t)(t0_ + tid) * 8 + h]; rlf = IFb[(size_t)(t0_ + tid) * 8 + 4 + h]; } else { rig = -INFINITY; rlf = 0.f; } } } while (0)
    ML_PREFETCH(0);
    bf16x8 ones; { const short o1 = (short)0x3F80;
#pragma unroll
        for (int j = 0; j < 8; ++j) ones[j] = o1; }
    const int tt = w >> 1, hb = (w & 1) * 2;
    for (int c = 0; c < nch; ++c) {
        const int t0 = c * 64;
#pragma unroll
        for (int i = 0; i < 4; ++i) { const int id = tid + 512 * i, r = id >> 5, ch = id & 31;
            *(LAS u32x4*)(lds + ML_QS + r * 528 + ch * 16) = rq[i]; *(LAS u32x4*)(lds + ML_KS + r * 528 + ch * 16) = rk[i]; }
        const u32x4 vcur = rv;
        { const int r = tid >> 3, ch = tid & 7; *(LAS u32x4*)(lds + ML_VS + r * 144 + ch * 16) = vcur; }
        if (tid < 64) { IG[tid] = rig; LF[tid] = rlf; }
        BAR_LDS();
        if (c + 1 < nch) ML_PREFETCH(c + 1);
        float decay, m_next;
        {
            const float bc = wave_scan_add(LF[lane]);
            const float gs = IG[lane] - bc;
            const float cm = wave_scan_max(gs);
            const float Mt = fmaxf(m_state, cm);
            const float ML_ = __builtin_bit_cast(float, __builtin_amdgcn_readlane(__builtin_bit_cast(int, Mt), 63));
            const float bL = __builtin_bit_cast(float, __builtin_amdgcn_readlane(__builtin_bit_cast(int, bc), 63));
            GGw[lane] = gs; MMw[lane] = Mt; SIw[lane] = __expf(m_state - Mt); EMw[lane] = __expf(-(bc + Mt)); WSw[lane] = __expf(gs - ML_);
            decay = __expf(m_state - ML_); m_next = bL + ML_;
        }
        { const int r = tid >> 3, ch = tid & 7; const float wsr = WSw[r];
          u32x4 o; o.x = pk2(bflo(vcur.x) * wsr, bfhi(vcur.x) * wsr); o.y = pk2(bflo(vcur.y) * wsr, bfhi(vcur.y) * wsr); o.z = pk2(bflo(vcur.z) * wsr, bfhi(vcur.z) * wsr); o.w = pk2(bflo(vcur.w) * wsr, bfhi(vcur.w) * wsr);
          *(LAS u32x4*)(lds + ML_VW + r * 144 + ch * 16) = o; }
        {
            bf16x8 qf[8];
#pragma unroll
            for (int kk = 0; kk < 8; ++kk) qf[kk] = *(const LAS bf16x8*)(lds + ML_QS + (tt * 16 + li) * 528 + (kk * 32 + g * 8) * 2);
            const float mt = MMw[tt * 16 + li];
            const int tq = tt * 16 + li;
            bf16x8 ap[2];
#pragma unroll
            for (int ks = 0; ks < 2; ++ks) {
                float pv[8];
#pragma unroll
                for (int hh = 0; hh < 2; ++hh) { const int st = 2 * ks + hh;
                    if (st <= tt) { f32x4 sa = (f32x4){0.f, 0.f, 0.f, 0.f};
#pragma unroll
                        for (int kk = 0; kk < 8; ++kk) { const bf16x8 kf = *(const LAS bf16x8*)(lds + ML_KS + (st * 16 + li) * 528 + (kk * 32 + g * 8) * 2); sa = __builtin_amdgcn_mfma_f32_16x16x32_bf16(kf, qf[kk], sa, 0, 0, 0); }
                        const f32x4 gv = *(const LAS f32x4*)(GGw + st * 16 + 4 * g);
#pragma unroll
                        for (int r = 0; r < 4; ++r) { const int sidx = st * 16 + 4 * g + r; pv[hh * 4 + r] = (sidx <= tq) ? sa[r] * __expf(gv[r] - mt) : 0.f; }
                    } else {
#pragma unroll
                        for (int r = 0; r < 4; ++r) pv[hh * 4 + r] = 0.f; } }
                union { u32x4 u; bf16x8 v; } cvt; cvt.u.x = pk2(pv[0], pv[1]); cvt.u.y = pk2(pv[2], pv[3]); cvt.u.z = pk2(pv[4], pv[5]); cvt.u.w = pk2(pv[6], pv[7]);
                ap[ks] = cvt.v;
            }
            f32x4 na[2], nq = (f32x4){0.f, 0.f, 0.f, 0.f}, ra = (f32x4){0.f, 0.f, 0.f, 0.f};
            na[0] = (f32x4){0.f, 0.f, 0.f, 0.f}; na[1] = na[0];
#pragma unroll
            for (int kk = 0; kk < 8; ++kk) {
                const bf16x8 c0 = *(const LAS bf16x8*)(lds + ML_CB + ((hb + 0) * 16 + li) * 528 + (kk * 32 + g * 8) * 2);
                const bf16x8 c1 = *(const LAS bf16x8*)(lds + ML_CB + ((hb + 1) * 16 + li) * 528 + (kk * 32 + g * 8) * 2);
                const bf16x8 cn = *(const LAS bf16x8*)(lds + ML_CB + 64 * 528 + (kk * 32 + g * 8) * 2);
                na[0] = __builtin_amdgcn_mfma_f32_16x16x32_bf16(qf[kk], c0, na[0], 0, 0, 0);
                na[1] = __builtin_amdgcn_mfma_f32_16x16x32_bf16(qf[kk], c1, na[1], 0, 0, 0);
                nq = __builtin_amdgcn_mfma_f32_16x16x32_bf16(qf[kk], cn, nq, 0, 0, 0);
            }
            const f32x4 si = *(const LAS f32x4*)(SIw + tt * 16 + 4 * g), em = *(const LAS f32x4*)(EMw + tt * 16 + 4 * g);
            na[0] = na[0] * si; na[1] = na[1] * si;
#pragma unroll
            for (int ks = 0; ks < 2; ++ks) if (2 * ks <= tt) {
                ra = __builtin_amdgcn_mfma_f32_16x16x32_bf16(ap[ks], ones, ra, 0, 0, 0);
#pragma unroll
                for (int j = 0; j < 2; ++j) {
                    const s16x4 v0 = __builtin_amdgcn_ds_read_tr16_b64_v4i16((LAS s16x4*)(lds + ML_VS + (ks * 32 + g * 4 + q4) * 144 + ((hb + j) * 16 + 4 * p4) * 2));
                    const s16x4 v1 = __builtin_amdgcn_ds_read_tr16_b64_v4i16((LAS s16x4*)(lds + ML_VS + (ks * 32 + 16 + g * 4 + q4) * 144 + ((hb + j) * 16 + 4 * p4) * 2));
                    bf16x8 bv; bv[0] = v0[0]; bv[1] = v0[1]; bv[2] = v0[2]; bv[3] = v0[3]; bv[4] = v1[0]; bv[5] = v1[1]; bv[6] = v1[2]; bv[7] = v1[3];
                    na[j] = __builtin_amdgcn_mfma_f32_16x16x32_bf16(ap[ks], bv, na[j], 0, 0, 0);
                }
            }
#pragma unroll
            for (int r = 0; r < 4; ++r) { const int t = tt * 16 + 4 * g + r;
                const float den = si[r] * nq[r] + ra[r]; const float inv = __builtin_amdgcn_rcpf(fmaxf(fabsf(den), em[r]));
                const float h0 = na[0][r] * inv, h1 = na[1][r] * inv;
                *(LAS bf16_t*)(lds + ML_HS + t * 144 + ((hb + 0) * 16 + li) * 2) = (bf16_t)f2bf(h0);
                *(LAS bf16_t*)(lds + ML_HS + t * 144 + ((hb + 1) * 16 + li) * 2) = (bf16_t)f2bf(h1);
                float sq = h0 * h0 + h1 * h1;
                sq = row16_sum(sq);
                HSQ[t * 2 + (w & 1)] = sq; }
        }
        BAR_LDS();
        u32x4 ogv = (u32x4){0u, 0u, 0u, 0u};
        { const int r = tid >> 3, ch = tid & 7; if (!smp || r < L) ogv = *(const u32x4*)(ogb + (size_t)(t0 + r) * DM + ch * 8); }
        if (tid < L && !dry) HSSb[(size_t)(t0 + tid) * 16] = HSQ[tid * 2] + HSQ[tid * 2 + 1];
        {
            bf16x8 bvw[2], bws[2];
#pragma unroll
            for (int ks = 0; ks < 2; ++ks) {
                const s16x4 v0 = __builtin_amdgcn_ds_read_tr16_b64_v4i16((LAS s16x4*)(lds + ML_VW + (ks * 32 + g * 8 + 0 + q4) * 144 + (vt * 16 + 4 * p4) * 2));
                const s16x4 v1 = __builtin_amdgcn_ds_read_tr16_b64_v4i16((LAS s16x4*)(lds + ML_VW + (ks * 32 + g * 8 + 4 + q4) * 144 + (vt * 16 + 4 * p4) * 2));
                bvw[ks][0] = v0[0]; bvw[ks][1] = v0[1]; bvw[ks][2] = v0[2]; bvw[ks][3] = v0[3]; bvw[ks][4] = v1[0]; bvw[ks][5] = v1[1]; bvw[ks][6] = v1[2]; bvw[ks][7] = v1[3];
                const f32x4 w0 = *(const LAS f32x4*)(WSw + ks * 32 + g * 8), w1 = *(const LAS f32x4*)(WSw + ks * 32 + g * 8 + 4);
                union { u32x4 u; bf16x8 v; } cvt; cvt.u.x = pk2(w0[0], w0[1]); cvt.u.y = pk2(w0[2], w0[3]); cvt.u.z = pk2(w1[0], w1[1]); cvt.u.w = pk2(w1[2], w1[3]);
                if (li != 0) cvt.u = (u32x4){0u, 0u, 0u, 0u};
                bws[ks] = cvt.v; }
            nst[0] = nst[0] * decay; nst[1] = nst[1] * decay;
#pragma unroll
            for (int i = 0; i < 8; ++i) { const int kt = ktb + i; cst[i] = cst[i] * decay;
                const bool mine = ((i >> 1) == (w & 3));
#pragma unroll
                for (int ks = 0; ks < 2; ++ks) {
                    const s16x4 k0 = __builtin_amdgcn_ds_read_tr16_b64_v4i16((LAS s16x4*)(lds + ML_KS + (ks * 32 + g * 8 + 0 + q4) * 528 + (kt * 16 + 4 * p4) * 2));
                    const s16x4 k1 = __builtin_amdgcn_ds_read_tr16_b64_v4i16((LAS s16x4*)(lds + ML_KS + (ks * 32 + g * 8 + 4 + q4) * 528 + (kt * 16 + 4 * p4) * 2));
                    bf16x8 ak; ak[0] = k0[0]; ak[1] = k0[1]; ak[2] = k0[2]; ak[3] = k0[3]; ak[4] = k1[0]; ak[5] = k1[1]; ak[6] = k1[2]; ak[7] = k1[3];
                    cst[i] = __builtin_amdgcn_mfma_f32_16x16x32_bf16(ak, bvw[ks], cst[i], 0, 0, 0);
                    if (mine) nst[i & 1] = __builtin_amdgcn_mfma_f32_16x16x32_bf16(ak, bws[ks], nst[i & 1], 0, 0, 0); }
                u32x2 wv; wv.x = pk2(cst[i][0], cst[i][1]); wv.y = pk2(cst[i][2], cst[i][3]);
                *(LAS u32x2*)(lds + ML_CB + (vt * 16 + li) * 528 + (kt * 16 + 4 * g) * 2) = wv; }
            if (li == 0) {
#pragma unroll
                for (int q = 0; q < 2; ++q) { u32x2 wv; wv.x = pk2(nst[q][0], nst[q][1]); wv.y = pk2(nst[q][2], nst[q][3]);
                    *(LAS u32x2*)(lds + ML_CB + 64 * 528 + ((ktb + i0 + q) * 16 + 4 * g) * 2) = wv; } }
        }
        { const int r = tid >> 3, ch = tid & 7; if ((!smp || r < L) && !dry) { const u32x4 hv = *(const LAS u32x4*)(lds + ML_HS + r * 144 + ch * 16); u32x4 o;
            o.x = pk2(bflo(hv.x) * bflo(ogv.x), bfhi(hv.x) * bfhi(ogv.x)); o.y = pk2(bflo(hv.y) * bflo(ogv.y), bfhi(hv.y) * bfhi(ogv.y));
            o.z = pk2(bflo(hv.z) * bflo(ogv.z), bfhi(hv.z) * bfhi(ogv.z)); o.w = pk2(bflo(hv.w) * bflo(ogv.w), bfhi(hv.w) * bfhi(ogv.w));
            *(u32x4*)(vb + (size_t)(t0 + r) * DM + ch * 8) = o; } }
        BAR_LDS();
        m_state = m_next;
    }
    if (!dry) {
        float* Co = p.out + (smp ? O_CS : O_CP) + (size_t)bh * 65536 + (size_t)(vs * 64 + vt * 16 + li) * 256;
#pragma unroll
        for (int i = 0; i < 8; ++i) *(f32x4*)(Co + (ktb + i) * 16 + 4 * g) = cst[i];
        if (vs == 0) {
            if (li == 0) {
#pragma unroll
                for (int q = 0; q < 2; ++q) *(f32x4*)(p.out + (smp ? O_NS : O_NP) + bh * 256 + (ktb + i0 + q) * 16 + 4 * g) = nst[q]; }
            if (tid == 0) p.out[(smp ? O_MS : O_MP) + bh] = m_state; }
    }
    __syncthreads();
#undef ML_PREFETCH
}

constexpr int RG_XR = 0, RG_XC = 18432, RG_W = 36864, RG_EX = 71680, RG_HC = 72704, RG_ZS = 73216;
__device__ __forceinline__ void rglru_item(const Params& p, LAS unsigned char* lds, int b, int n, int hf, bool smp, bool dry) {
    int tid_ = threadIdx.x; asm volatile("" : "+v"(tid_));
    const int tid = tid_, lane = tid & 63, w = __builtin_amdgcn_readfirstlane(tid >> 6), g = lane >> 4, li = lane & 15;
    unsigned char* ws = p.ws;
    const int L = smp ? DSEQ : SEQ, ntile = smp ? 1 : SEQ / 64;
    const int row0 = smp ? NTP + b * DSEQ : b * SEQ;
    const bf16_t* xbp = (smp ? (const bf16_t*)(ws + WS_SMALL + SM_XB * SMALL_B) + (size_t)(b * DSEQ) * DM : (const bf16_t*)(ws + WS_XB) + (size_t)row0 * DM) + n * 128;
    bf16_t* zbp = (smp ? (bf16_t*)(ws + WS_SMALL + SM_SZB * SMALL_B) + (size_t)(b * DSEQ) * DM : (bf16_t*)(ws + WS_SZB) + (size_t)row0 * DM) + n * 128 + hf * 64;
    const float* cvs = p.in[8] + (size_t)b * 3 * DM + n * 128;
    LAS float* EX = (LAS float*)(lds + RG_EX); LAS float* HC = (LAS float*)(lds + RG_HC);
    for (int id = tid; id < 2 * 64 * 16; id += 512) { const int gt = id >> 10, j = (id >> 4) & 63, ch = id & 15;
        *(LAS u32x4*)(lds + RG_W + (gt * 64 + j) * 272 + ch * 16) = *(const u32x4*)((const bf16_t*)(ws + (gt ? WS_WRXT : WS_WRAT)) + (size_t)n * 16384 + (size_t)(hf * 64 + j) * 128 + ch * 8); }
    const int jt = w & 3, th = w >> 2, jc = jt * 16 + li, chn = n * 128 + hf * 64 + jc;
    const float bra = p.in[18][chn], brx = p.in[20][chn];
    float spl; { const float lm = p.in[21][chn]; spl = fmaxf(-lm, 0.f) + log1pf(__expf(-fabsf(lm))); }
    float gw_[4]; const float gb_ = p.in[16][chn];
#pragma unroll
    for (int j = 0; j < 4; ++j) gw_[j] = p.in[15][j * DM + chn];
    const int c2 = tid & 63, tq = tid >> 6;
    float cw[4][2], cb[2];
#pragma unroll
    for (int j = 0; j < 4; ++j) { cw[j][0] = p.in[15][j * DM + n * 128 + 2 * c2]; cw[j][1] = p.in[15][j * DM + n * 128 + 2 * c2 + 1]; }
    cb[0] = p.in[16][n * 128 + 2 * c2]; cb[1] = p.in[16][n * 128 + 2 * c2 + 1];
    if (tid < 64) { HC[tid] = smp ? p.in[7][b * DM + n * 128 + hf * 64 + tid] : 0.f; }
    u32x4 rx[3], rzv;
    const u32x4 z4 = (u32x4){0u, 0u, 0u, 0u};
#define RG_PREFETCH(tl) do { const int t0_ = (tl) * 64; \
        _Pragma("unroll") for (int i_ = 0; i_ < 3; ++i_) { const int id_ = tid + 512 * i_, r_ = id_ >> 4, ch_ = id_ & 15, tok_ = t0_ - 3 + r_; rx[i_] = z4; \
            if (id_ < 67 * 16) { if (tok_ >= 0 && (!smp || tok_ < L)) rx[i_] = *(const u32x4*)(xbp + (size_t)tok_ * DM + ch_ * 8); \
                else if (tok_ < 0 && smp) { const float* s_ = cvs + (size_t)(tok_ + 3) * DM + ch_ * 8; const f32x4 a_ = *(const f32x4*)s_, b_ = *(const f32x4*)(s_ + 4); \
                    rx[i_].x = pk2(a_[0], a_[1]); rx[i_].y = pk2(a_[2], a_[3]); rx[i_].z = pk2(b_[0], b_[1]); rx[i_].w = pk2(b_[2], b_[3]); } } } \
        { const int r_ = tid >> 3, ch_ = tid & 7; rzv = (!smp || t0_ + r_ < L) ? *(const u32x4*)(zbp + (size_t)(t0_ + r_) * DM + ch_ * 8) : z4; } } while (0)
    RG_PREFETCH(0);
    for (int tl = 0; tl < ntile; ++tl) {
        const int t0 = tl * 64;
#pragma unroll
        for (int i = 0; i < 3; ++i) { const int id = tid + 512 * i, r = id >> 4, ch = id & 15; if (id < 67 * 16) *(LAS u32x4*)(lds + RG_XR + r * 272 + ch * 16) = rx[i]; }
        { const int r = tid >> 3, ch = tid & 7; *(LAS u32x4*)(lds + RG_ZS + (tl & 1) * 9216 + r * 144 + ch * 16) = rzv; }
        BAR_LDS();
        if (tl > 0 && !dry) { const int r = tid >> 3, ch = tid & 7;
            *(u32x4*)(zbp + (size_t)(t0 - 64 + r) * DM + ch * 8) = *(const LAS u32x4*)(lds + RG_ZS + ((tl - 1) & 1) * 9216 + r * 144 + ch * 16); }
        if (tl == ntile - 1 && tid < 192 && !dry) {
            const int j = tid >> 6, c = tid & 63, rr = (L - t0) + j;
            p.out[(smp ? O_CVS : O_CVP) + ((size_t)b * 3 + j) * DM + n * 128 + hf * 64 + c] = bf2f(*(const LAS bf16_t*)(lds + RG_XR + rr * 272 + (hf * 64 + c) * 2));
        }
        if (tl + 1 < ntile) RG_PREFETCH(tl + 1);
        { float x0[3], x1[3];
#pragma unroll
          for (int j = 0; j < 3; ++j) { const unsigned wv = *(const LAS unsigned*)(lds + RG_XR + (tq * 8 + j) * 272 + c2 * 4); x0[j] = bflo(wv); x1[j] = bfhi(wv); }
#pragma unroll
          for (int i = 0; i < 8; ++i) { const int t = tq * 8 + i; const unsigned wv = *(const LAS unsigned*)(lds + RG_XR + (t + 3) * 272 + c2 * 4); const float n0 = bflo(wv), n1 = bfhi(wv);
              const float y0 = cb[0] + cw[0][0] * x0[0] + cw[1][0] * x0[1] + cw[2][0] * x0[2] + cw[3][0] * n0;
              const float y1 = cb[1] + cw[0][1] * x1[0] + cw[1][1] * x1[1] + cw[2][1] * x1[2] + cw[3][1] * n1;
              x0[0] = x0[1]; x0[1] = x0[2]; x0[2] = n0; x1[0] = x1[1]; x1[1] = x1[2]; x1[2] = n1;
              *(LAS unsigned*)(lds + RG_XC + t * 272 + c2 * 4) = pk2(y0, y1); } }
        BAR_LDS();
        float av[2][4], bv[2][4], TA[2], TB[2], EA[2], EB[2];
        {
            bf16x8 wr_[4], wi_[4];
#pragma unroll
            for (int kk = 0; kk < 4; ++kk) { wr_[kk] = *(const LAS bf16x8*)(lds + RG_W + jc * 272 + (kk * 32 + g * 8) * 2); wi_[kk] = *(const LAS bf16x8*)(lds + RG_W + (64 + jc) * 272 + (kk * 32 + g * 8) * 2); }
#pragma unroll
            for (int q = 0; q < 2; ++q) { const int tt = 2 * th + q;
                f32x4 ar = (f32x4){0.f, 0.f, 0.f, 0.f}, ai = (f32x4){0.f, 0.f, 0.f, 0.f};
#pragma unroll
                for (int kk = 0; kk < 4; ++kk) { const bf16x8 ax = *(const LAS bf16x8*)(lds + RG_XC + (tt * 16 + li) * 272 + (kk * 32 + g * 8) * 2);
                    ar = __builtin_amdgcn_mfma_f32_16x16x32_bf16(ax, wr_[kk], ar, 0, 0, 0); ai = __builtin_amdgcn_mfma_f32_16x16x32_bf16(ax, wi_[kk], ai, 0, 0, 0); }
                float xw[7];
#pragma unroll
                for (int k = 0; k < 7; ++k) xw[k] = bf2f(*(const LAS bf16_t*)(lds + RG_XR + (tt * 16 + 4 * g + k) * 272 + (hf * 64 + jc) * 2));
                float A4 = 1.f, B4 = 0.f;
#pragma unroll
                for (int r = 0; r < 4; ++r) { const int t = tt * 16 + 4 * g + r;
                    const float xc = gb_ + gw_[0] * xw[r] + gw_[1] * xw[r + 1] + gw_[2] * xw[r + 2] + gw_[3] * xw[r + 3];
                    const float rg = sigm(ar[r] + bra), ig = sigm(ai[r] + brx);
                    const float la = -8.0f * rg * spl; const float a = __expf(la);
                    const float x2 = 2.0f * la;
                    const float pm = x2 * (1.0f + x2 * (0.5f + x2 * (0.16666667f + x2 * (0.041666668f + x2 * (0.0083333338f + x2 * (0.0013888889f + x2 * 0.0001984127f))))));
                    const float om = (x2 > -0.5f) ? -pm : 1.0f - __expf(x2);
                    float mult = __builtin_amdgcn_sqrtf(om); if (!smp && (t0 + t) == 0) mult = 1.0f;
                    const float bt = mult * ig * xc;
                    av[q][r] = a; bv[q][r] = bt; B4 = a * B4 + bt; A4 *= a; }
                { const float pA = __shfl_up(A4, 16), pB = __shfl_up(B4, 16); if (g >= 1) { B4 = A4 * pB + B4; A4 = A4 * pA; } }
                { const float pA = __shfl_up(A4, 32), pB = __shfl_up(B4, 32); if (g >= 2) { B4 = A4 * pB + B4; A4 = A4 * pA; } }
                { const float pA = __shfl_up(A4, 16), pB = __shfl_up(B4, 16); EA[q] = (g >= 1) ? pA : 1.f; EB[q] = (g >= 1) ? pB : 0.f; }
                TA[q] = __shfl(A4, 48 + li); TB[q] = __shfl(B4, 48 + li);
            }
            { EX[(th * 64 + jc) * 2] = TA[0] * TA[1]; EX[(th * 64 + jc) * 2 + 1] = TA[1] * TB[0] + TB[1]; }
        }
        BAR_LDS();
        {
            float hin = HC[(tl & 1) * 64 + jc];
            if (th == 1) hin = EX[jc * 2] * hin + EX[jc * 2 + 1];
            if (th == 1) HC[((tl + 1) & 1) * 64 + jc] = (TA[0] * TA[1]) * hin + (TA[1] * TB[0] + TB[1]);
#pragma unroll
            for (int q = 0; q < 2; ++q) { const int tt = 2 * th + q;
                float hcur = EA[q] * hin + EB[q];
#pragma unroll
                for (int r = 0; r < 4; ++r) { const int tok = t0 + tt * 16 + 4 * g + r;
                    hcur = av[q][r] * hcur + bv[q][r];
                    { LAS bf16_t* zp = (LAS bf16_t*)(lds + RG_ZS + (tl & 1) * 9216 + (tt * 16 + 4 * g + r) * 144 + jc * 2); *zp = (bf16_t)f2bf(bf2f(*zp) * hcur); }
                    if ((!smp || tok < L) && !dry && tok == L - 1) p.out[(smp ? O_HS : O_HP) + (size_t)b * DM + chn] = hcur; }
                hin = TA[q] * hin + TB[q];
            }
        }
    }
    BAR_LDS();
    if (!dry) { const int r = tid >> 3, ch = tid & 7, tlast = (ntile - 1) * 64;
        if (tlast + r < L) *(u32x4*)(zbp + (size_t)(tlast + r) * DM + ch * 8) = *(const LAS u32x4*)(lds + RG_ZS + ((ntile - 1) & 1) * 9216 + r * 144 + ch * 16); }
    __syncthreads();
#undef RG_PREFETCH
}

__device__ __forceinline__ void phase3(const Params& p, LAS unsigned char* lds) {
    const int G = gridDim.x;
    for (int it = blockIdx.x; it < 256; it += G) { const int bh = (it & 7) * 8 + (it >> 5), vs = (it >> 3) & 3; mlstm_item(p, lds, bh >> 2, bh & 3, vs, false, false); }
    for (int it = blockIdx.x; it < 256; it += G) { const int q = (it & 7) * 16 + (it >> 4), hf = (it >> 3) & 1; rglru_item(p, lds, q >> 3, q & 7, hf, false, false); }
    for (int it = blockIdx.x; it < 128; it += G) mlstm_item(p, lds, it >> 4, (it >> 2) & 3, it & 3, true, false);
    for (int it = blockIdx.x; it < 256; it += G) if (it >= 128) { const int q = it - 128; rglru_item(p, lds, q >> 4, (q >> 1) & 7, q & 1, true, false); }
}

__device__ __forceinline__ void phase4(const Params& p) {
    unsigned char* ws = p.ws;
    TV YA{(bf16_t*)(ws + WS_V), (bf16_t*)(ws + WS_SMALL + SM_V * SMALL_B)}, OG{(bf16_t*)(ws + WS_OG), (bf16_t*)(ws + WS_SMALL + SM_OG * SMALL_B)};
    const float* HSS = (const float*)(ws + WS_HSS); const float* gh = p.in[14];
    for (int id = blockIdx.x * 512 + threadIdx.x; id < NTT * 128; id += gridDim.x * 512) {
        const int row = id >> 7, ch = id & 127, hd = ch >> 5;
        const f32x4 hs = *(const f32x4*)(HSS + (size_t)row * 16 + hd * 4);
        const float rs = rsqrtf(((hs[0] + hs[1]) + (hs[2] + hs[3])) * (1.0f / 256.0f) + EPS);
        bf16_t* yp = tv_row(YA, row) + ch * 8; const bf16_t* op = tv_row(OG, row) + ch * 8;
        const u32x4 hv = *(const u32x4*)yp, ov = *(const u32x4*)op; const f32x4 g0 = *(const f32x4*)(gh + ch * 8), g1 = *(const f32x4*)(gh + ch * 8 + 4);
        u32x4 o;
        o.x = pk2(bflo(hv.x) * bflo(ov.x) * rs * g0[0], bfhi(hv.x) * bfhi(ov.x) * rs * g0[1]);
        o.y = pk2(bflo(hv.y) * bflo(ov.y) * rs * g0[2], bfhi(hv.y) * bfhi(ov.y) * rs * g0[3]);
        o.z = pk2(bflo(hv.z) * bflo(ov.z) * rs * g1[0], bfhi(hv.z) * bfhi(ov.z) * rs * g1[1]);
        o.w = pk2(bflo(hv.w) * bflo(ov.w) * rs * g1[2], bfhi(hv.w) * bfhi(ov.w) * rs * g1[3]);
        *(u32x4*)yp = o;
    }
}

__device__ __forceinline__ void phase7(const Params& p) {
    const int lane = threadIdx.x & 63, wave = threadIdx.x >> 6;
    const float* rowss = (const float*)(p.ws + WS_ROWSS); const float* gf = p.in[27];
    f32x4 gv[4];
#pragma unroll
    for (int j = 0; j < 4; ++j) gv[j] = *(const f32x4*)(gf + 4 * lane + 256 * j);
    const bf16_t* ybf = (const bf16_t*)(p.ws + WS_V);
    const int gw = blockIdx.x * 8 + wave, NGW = gridDim.x * 8;
    for (int r0 = gw; r0 < NTP; r0 += 4 * NGW) {
        u32x2 w[4][4]; float part[4];
#pragma unroll
        for (int q = 0; q < 4; ++q) { const int row = r0 + q * NGW; const bool ok = row < NTP; const int rr = ok ? row : r0;
#pragma unroll
            for (int j = 0; j < 4; ++j) w[q][j] = *(const u32x2*)(ybf + (size_t)rr * DM + 4 * lane + 256 * j);
            part[q] = lane < 16 ? rowss[(size_t)rr * 16 + lane] : 0.f; }
#pragma unroll
        for (int q = 0; q < 4; ++q) { const int row = r0 + q * NGW; if (row < NTP) {
            const float rs = rsqrtf(wave_sum(part[q]) * (1.0f / DM) + EPS);
            float* yr = p.out + O_YP + (size_t)row * DM;
#pragma unroll
            for (int j = 0; j < 4; ++j) { const f32x4 v = (f32x4){bflo(w[q][j].x), bfhi(w[q][j].x), bflo(w[q][j].y), bfhi(w[q][j].y)}; *(f32x4*)(yr + 4 * lane + 256 * j) = v * rs * gv[j]; } } }
    }
    for (int row = gw; row < NTS; row += NGW) {
        float* yr = p.out + O_YS + (size_t)row * DM;
        f32x4 v[4]; float part = 0.f;
#pragma unroll
        for (int j = 0; j < 4; ++j) { v[j] = *(const f32x4*)(yr + 4 * lane + 256 * j); part += (v[j][0] * v[j][0] + v[j][1] * v[j][1]) + (v[j][2] * v[j][2] + v[j][3] * v[j][3]); }
        const float rs = rsqrtf(wave_sum(part) * (1.0f / DM) + EPS);
#pragma unroll
        for (int j = 0; j < 4; ++j) *(f32x4*)(yr + 4 * lane + 256 * j) = v[j] * rs * gv[j];
    }
}

__global__ void __launch_bounds__(512) fwd_kernel(Params p) {
    extern __shared__ __attribute__((aligned(16))) unsigned char lds_raw[];
    LAS unsigned char* lds = (LAS unsigned char*)lds_raw;
    unsigned char* ws = p.ws;
    const int lo = p.ph_lo, hi = p.ph_hi;
#ifndef REP2
#define REP2 1
#define REP56 1
#define REP01 1
#ifndef PROBE_MODE
#define PROBE_MODE 0
#endif
#endif
#ifndef PH_MASK
#define PH_MASK 255
#endif
#define IN(k) (((PH_MASK >> (k)) & 1) && lo <= (k) && (k) < hi)
    { volatile LAS unsigned* stw = (volatile LAS unsigned*)(lds + LDS_BARW); if (threadIdx.x < 2) stw[threadIdx.x] = 0u; }
    __syncthreads();
    XcdBarrier xbar = xcd_barrier_post((unsigned*)(ws + WS_BAR), (volatile LAS unsigned*)(lds + LDS_BARW));
#define SEAM(k) do { if (IN(k) && IN((k) + 1)) { xcd_barrier(xbar); } } while (0)
    if (p.ph_hi > 1000) cg::this_grid().sync();
    auto small = [&](int i) { return (bf16_t*)(ws + WS_SMALL + (size_t)i * SMALL_B); };
    TV tU{(bf16_t*)(ws + WS_U), small(SM_U)}, tQ{(bf16_t*)p.out, small(SM_Q)}, tK{(bf16_t*)((unsigned char*)p.out + 64 * MiB), small(SM_K)},
       tV{(bf16_t*)(ws + WS_V), small(SM_V)}, tOG{(bf16_t*)(ws + WS_OG), small(SM_OG)}, tXB{(bf16_t*)(ws + WS_XB), small(SM_XB)},
       tSZB{(bf16_t*)(ws + WS_SZB), small(SM_SZB)}, tGA{(bf16_t*)(ws + WS_GA), small(SM_GA)}, tGB{(bf16_t*)(ws + WS_GB), small(SM_GB)};
    if (IN(0)) { phase0(p, lds); } SEAM(0);
    if (IN(1)) { phase1(p, lds); } SEAM(1);
#if REP01 > 1
    phase0(p, lds); cg::this_grid().sync(); phase1(p, lds); cg::this_grid().sync();
#endif
    if (IN(2)) {
        pg8::StaticOrder S; S.init(129, 36, gridDim.x, blockIdx.x);
        Epi1 E{tQ, tK, tV, tOG, tXB, tSZB, tGA, tGB, p.in[23]};
        Prob1 P{tU, (const bf16_t*)(ws + WS_W1T)};
        pg8::gemm_phase(lds, DM, S, E, P);
    } SEAM(2);
    if (IN(3)) { phase3(p, lds); } SEAM(3);
    if (IN(5)) {
        {
            pg8::PairOrder S0; S0.init(128, 4, gridDim.x, blockIdx.x);
            const int ord = threadIdx.x >> 8, rl = threadIdx.x & 255; pg8::Unit u0;
            if (S0.next(2 * ord, u0)) { const float* hss = (const float*)(ws + WS_HSS) + (size_t)(u0.pm * 256 + rl) * 16; f32x4 o;
#pragma unroll
                for (int hd = 0; hd < 4; ++hd) { const f32x4 hs = *(const f32x4*)(hss + hd * 4); o[hd] = rsqrtf(((hs[0] + hs[1]) + (hs[2] + hs[3])) * (1.0f / 256.0f) + EPS); }
                *(LAS f32x4*)(lds + RS_OFF + (ord * 256 + rl) * 16) = o; }
            __syncthreads();
        }
        pg8::PairOrder S; S.init(128, 4, gridDim.x, blockIdx.x);
        Epi2 E{tGA, tGB, tU};
        Prob2 P{tV, tSZB, (const bf16_t*)(ws + WS_WAT), (const bf16_t*)(ws + WS_WBT)};
        pg8::gemm_phase(lds, DM, S, E, P);
        mini_gemm2(p, lds);
#if REP56 > 1
        cg::this_grid().sync();
        pg8::gemm_phase(lds, DM, S, E, P);
#endif
    } SEAM(5);
    if (IN(6)) {
        pg8::StaticOrder S; S.init(128, 4, gridDim.x, blockIdx.x);
        Epi3 E{p.in[0], (bf16_t*)(ws + WS_V), (const float*)(ws + WS_MODG), (float*)(ws + WS_ROWSS)};
        Prob3 P{tU, (const bf16_t*)(ws + WS_WOT)};
        pg8::gemm_phase(lds, DM, S, E, P);
        mini_gemm3(p, lds);
#if REP56 > 1
        cg::this_grid().sync();
        pg8::gemm_phase(lds, DM, S, E, P);
#endif
    } SEAM(6);
    if (IN(7)) { phase7(p); }
#if SYNC_PROBE
    for (int i_ = 0; i_ < 8; ++i_) cg::this_grid().sync();
#endif
#undef IN
#undef SEAM
}

extern "C" void kernel_launch(void* const* d_in, const int* in_sizes, int n_in, void* d_out, int out_size, void* d_ws, size_t ws_size, hipStream_t stream) {
    static int grid = 0;
    if (grid == 0) {
        if (n_in != 28 || out_size != (int)O_END || ws_size < WS_END) { fprintf(stderr, "kernel_launch: unexpected shapes (n_in %d out %d ws %zu)\n", n_in, out_size, ws_size); grid = -1; return; }
        int dev = 0, cus = 0, per_cu = 0;
        hipGetDevice(&dev); hipDeviceGetAttribute(&cus, hipDeviceAttributeMultiprocessorCount, dev);
        hipFuncSetAttribute((const void*)fwd_kernel, hipFuncAttributeMaxDynamicSharedMemorySize, LDS_BYTES);
        hipOccupancyMaxActiveBlocksPerMultiprocessor(&per_cu, (const void*)fwd_kernel, 512, LDS_BYTES);
        if (per_cu < 1) { fprintf(stderr, "kernel_launch: occupancy query says %d blocks per CU\n", per_cu); grid = -1; return; }
        grid = cus;
        (void)hipGetLastError();
    }
    if (grid < 0) return;
    Params p{};
    for (int i = 0; i < 28; ++i) p.in[i] = (const float*)d_in[i];
    p.out = (float*)d_out; p.ws = (unsigned char*)d_ws; p.probe = PROBE_MODE;
#if MK_ONE_LAUNCH
    if (hipMemsetAsync((char*)d_ws + WS_BAR, 0, 16384, stream) != hipSuccess) { fprintf(stderr, "kernel_launch: memset of the barrier words failed\n"); return; }
    p.ph_lo = 0; p.ph_hi = 8;
    void* args[] = {&p};
    hipError_t e = hipLaunchCooperativeKernel((const void*)fwd_kernel, dim3(grid), dim3(512), args, LDS_BYTES, stream);
    if (e != hipSuccess) fprintf(stderr, "cooperative launch failed: %s (grid %d)\n", hipGetErrorString(e), grid);
#else
    for (int k = 0; k < 8; ++k) { p.ph_lo = k; p.ph_hi = k + 1; hipLaunchKernelGGL(fwd_kernel, dim3(grid), dim3(512), LDS_BYTES, stream, p); }
#endif
}
```

```cpp
#include <hip/hip_runtime.h>
#include <hip/hip_cooperative_groups.h>
#include <cstdio>
#include <cstdint>
namespace cg = cooperative_groups;

#ifndef GEMM_DRAIN
#define GEMM_DRAIN 0
#endif
#ifndef SYNC_PROBE
#define SYNC_PROBE 0
#endif
#ifndef MK_ONE_LAUNCH
#define MK_ONE_LAUNCH 1
#endif

#define LAS __attribute__((address_space(3)))
typedef unsigned short bf16_t;
typedef short bf16x8 __attribute__((ext_vector_type(8)));
typedef short s16x4 __attribute__((ext_vector_type(4)));
typedef float f32x4 __attribute__((ext_vector_type(4)));
typedef unsigned u32x4 __attribute__((ext_vector_type(4)));
typedef unsigned u32x2 __attribute__((ext_vector_type(2)));

constexpr int DM = 1024, NTP = 32768, NTS = 128, NTT = NTP + NTS, SEQ = 2048, DSEQ = 16;
constexpr int DIN = 7176;
constexpr float EPS = 1e-6f;
constexpr size_t MiB = 1u << 20;
constexpr size_t WS_U = 0 * MiB, WS_V = 64 * MiB, WS_OG = 128 * MiB, WS_XB = 192 * MiB, WS_SZB = 256 * MiB, WS_GA = 320 * MiB, WS_GB = 384 * MiB;
constexpr size_t WS_W1T = 448 * MiB, WS_WAT = 466 * MiB, WS_WBT = 468 * MiB, WS_WOT = 470 * MiB, WS_WRAT = 472 * MiB, WS_WRXT = 472 * MiB + 256 * 1024;
constexpr size_t WS_SMALL = 473 * MiB, SMALL_B = 512 * 1024;
enum { SM_U = 0, SM_Q, SM_K, SM_V, SM_OG, SM_XB, SM_SZB, SM_GA, SM_GB, SM_N };
constexpr size_t WS_IF = 478 * MiB, WS_HSS = 480 * MiB, WS_ROWSS = 483 * MiB, WS_MODP = 486 * MiB, WS_WIF = 488 * MiB, WS_BAR = 489 * MiB, WS_END = 490 * MiB, WS_MODG = 487 * MiB + 256 * 1024;
constexpr size_t O_YP = 0, O_YS = 33554432, O_CP = 33685504, O_NP = 37879808, O_MP = 37896192, O_HP = 37896256, O_CVP = 37912640,
                 O_CS = 37961792, O_NS = 40058944, O_MS = 40067136, O_HS = 40067168, O_CVS = 40075360, O_END = 40099936;
constexpr int LDS_BYTES = 151552, LDS_BARW = 151040, RS_OFF = 131072, PF_OFF = 139264;

struct Params { const float* in[28]; float* out; unsigned char* ws; int ph_lo, ph_hi, probe, pad; };

typedef float f32x2_t __attribute__((ext_vector_type(2)));
typedef __bf16 bf16x2_t __attribute__((ext_vector_type(2)));
__device__ __forceinline__ unsigned pk2(float lo, float hi) { f32x2_t v = {lo, hi}; bf16x2_t b = __builtin_convertvector(v, bf16x2_t); return __builtin_bit_cast(unsigned, b); }
__device__ __forceinline__ unsigned f2bf(float f) { return pk2(f, 0.f) & 0xffffu; }
__device__ __forceinline__ float bf2f(unsigned b) { return __uint_as_float(b << 16); }
__device__ __forceinline__ float bflo(unsigned w) { return __uint_as_float(w << 16); }
__device__ __forceinline__ float bfhi(unsigned w) { return __uint_as_float(w & 0xffff0000u); }
__device__ __forceinline__ float sigm(float x) { return __builtin_amdgcn_rcpf(1.0f + __expf(-x)); }
__device__ __forceinline__ float wave_sum_bperm(float v) {
#pragma unroll
    for (int o = 1; o < 64; o <<= 1) v += __shfl_xor(v, o);
    return v;
}

template <int CTRL, int ROWMASK> __device__ __forceinline__ float dpp_f(float oldv, float src) {
    return __builtin_bit_cast(float, __builtin_amdgcn_update_dpp(__builtin_bit_cast(int, oldv), __builtin_bit_cast(int, src), CTRL, ROWMASK, 0xf, false)); }
__device__ __forceinline__ float row16_sum(float v) {
    v += dpp_f<0xB1, 0xf>(0.f, v); v += dpp_f<0x4E, 0xf>(0.f, v); v += dpp_f<0x124, 0xf>(0.f, v); v += dpp_f<0x128, 0xf>(0.f, v); return v; }
__device__ __forceinline__ float wave_sum(float v) {
    v = row16_sum(v);
    const int iv = __builtin_bit_cast(int, v);
    const float r0 = __builtin_bit_cast(float, __builtin_amdgcn_readlane(iv, 0)), r1 = __builtin_bit_cast(float, __builtin_amdgcn_readlane(iv, 16));
    const float r2 = __builtin_bit_cast(float, __builtin_amdgcn_readlane(iv, 32)), r3 = __builtin_bit_cast(float, __builtin_amdgcn_readlane(iv, 48));
    return (r0 + r1) + (r2 + r3);
}
__device__ __forceinline__ float wave_scan_add(float v) {
    v += dpp_f<0x111, 0xf>(0.f, v); v += dpp_f<0x112, 0xf>(0.f, v); v += dpp_f<0x114, 0xf>(0.f, v); v += dpp_f<0x118, 0xf>(0.f, v);
    v += dpp_f<0x142, 0xa>(0.f, v); v += dpp_f<0x143, 0xc>(0.f, v); return v; }
__device__ __forceinline__ float wave_scan_max(float v) {
    const float ninf = -INFINITY;
    v = fmaxf(v, dpp_f<0x111, 0xf>(ninf, v)); v = fmaxf(v, dpp_f<0x112, 0xf>(ninf, v)); v = fmaxf(v, dpp_f<0x114, 0xf>(ninf, v)); v = fmaxf(v, dpp_f<0x118, 0xf>(ninf, v));
    v = fmaxf(v, dpp_f<0x142, 0xa>(ninf, v)); v = fmaxf(v, dpp_f<0x143, 0xc>(ninf, v)); return v; }
#define LDS_WAIT() asm volatile("s_waitcnt lgkmcnt(0)" ::: "memory")
#define BAR_LDS() do { asm volatile("s_waitcnt lgkmcnt(0)" ::: "memory"); __builtin_amdgcn_s_barrier(); asm volatile("" ::: "memory"); } while (0)

namespace pg8 {
constexpr int BM = 256, BK = 64, HALF = 128, HTB = HALF * BK * 2, STAGE_BYTES = 8 * HTB, NXCD = 8, WGM = 8;
__host__ __device__ __forceinline__ int lds_byte(int r, int c) { const int st = (r >> 4) * 2 + (c >> 5), rr = r & 15, cc = c & 31, ob = rr * 64 + cc * 2; return st * 1024 + (ob ^ (((ob >> 9) & 1) << 5)); }
__host__ __device__ __forceinline__ void stage_rc(int b, int& R, int& C) { const int st = b / 1024, sb = b % 1024, swz = sb ^ (((sb >> 9) & 1) << 5); R = (st >> 1) * 16 + swz / 64; C = (st & 1) * 32 + (swz % 64) / 2; }
__host__ __device__ __forceinline__ int perm32(int rho) { const int n = rho >> 4, i = rho & 15; return 8 * (i >> 2) + 4 * n + (i & 3); }

struct Unit { int pm, pn, sub, slot; };
struct StaticOrder {
    int nM, nN, nwg, G, c;
    __device__ void init(int nM_, int nN_, int G_, int c_) { nM = nM_; nN = nN_; nwg = nM * nN; G = G_; c = c_; }
    __device__ bool tile(int i, Unit& u) const {
        const long L = (long)i * G + c; if (L >= nwg) return false;
        int wgid = (int)L; { const int q = nwg / NXCD, r = nwg % NXCD, xcd = wgid % NXCD, off = wgid / NXCD; wgid = (xcd < r ? xcd * (q + 1) : r * (q + 1) + (xcd - r) * q) + off; }
        const int nig = WGM * nN, gid = wgid / nig, fm = gid * WGM, gsz = (nM - fm) < WGM ? (nM - fm) : WGM;
        u.pm = fm + ((wgid % nig) % gsz); u.pn = (wgid % nig) / gsz; u.sub = 0; u.slot = 0; return true;
    }
    __device__ bool next(int i, Unit& u) const { return tile(i, u); }
};
struct PairOrder : StaticOrder {
    __device__ bool next(int i, Unit& u) const { if (!tile(i >> 1, u)) return false; u.sub = i & 1; u.slot = (i >> 1) & 1; return true; }
};
__device__ __forceinline__ unsigned cvt_pk_bf16(float lo, float hi) { return pk2(lo, hi); }

template <class Epi, class Sched, class Prob>
__device__ __forceinline__ void gemm_phase(LAS unsigned char* lds, const int K, const Sched& S, const Epi& E, const Prob& P) {
    const int tid = threadIdx.x, wid = __builtin_amdgcn_readfirstlane(tid >> 6), lane = tid & 63, wr = wid >> 2, wc = wid & 3, fr = lane & 15, fq = lane >> 4;
    const int nt = K / BK;
    unsigned voffA[2], voffB[2];
#pragma unroll
    for (int i = 0; i < 2; ++i) { int R, C; stage_rc(tid * 16 + i * 8192, R, C); const int Rb = Epi::PERM ? ((R & ~31) + perm32(R & 31)) : R;
        voffA[i] = (unsigned)(R * K + C) * 2u; voffB[i] = (unsigned)(Rb * K + C) * 2u; }
    const size_t kstep = (size_t)(BK * 2);
    const size_t hstep = (size_t)HALF * K * 2;
    const unsigned ldsw = (unsigned)wid * 1024u;
    const int aoff = lds_byte(wr * 64 + fr, fq * 8), boff = lds_byte(wc * 32 + fr, fq * 8);
#define PG8_SA(b, h) (((b) * 2 + (h)) * HTB)
#define PG8_SB(b, h) ((4 + (b) * 2 + (h)) * HTB)
#define PG8_STAGE(bufoff, gbase, voff) do { _Pragma("unroll") for (int _i = 0; _i < 2; ++_i) \
        __builtin_amdgcn_global_load_lds((const unsigned*)((const char*)(gbase) + (voff)[_i]), (LAS unsigned*)(lds + (bufoff) + ldsw + _i * 8192), 16, 0, 0); } while (0)
#define PG8_LDA(dst, b, h) do { _Pragma("unroll") for (int m = 0; m < 4; ++m) _Pragma("unroll") for (int k = 0; k < 2; ++k) dst[m][k] = *(const LAS bf16x8*)(lds + PG8_SA(b, h) + aoff + m * 2048 + k * 1024); } while (0)
#define PG8_LDB(dst, b, h) do { _Pragma("unroll") for (int n = 0; n < 2; ++n) _Pragma("unroll") for (int k = 0; k < 2; ++k) dst[n][k] = *(const LAS bf16x8*)(lds + PG8_SB(b, h) + boff + n * 2048 + k * 1024); } while (0)
#define PG8_MMA(ai, bj, At, Bt) do { __builtin_amdgcn_sched_barrier(0); _Pragma("unroll") for (int m = 0; m < 4; ++m) _Pragma("unroll") for (int n = 0; n < 2; ++n) _Pragma("unroll") for (int k = 0; k < 2; ++k) \
        acc[ai][bj][m][n] = __builtin_amdgcn_mfma_f32_16x16x32_bf16(Bt[n][k], At[m][k], acc[ai][bj][m][n], 0, 0, 0); __builtin_amdgcn_sched_barrier(0); } while (0)
#define PG8_WAIT_V(n) asm volatile("s_waitcnt vmcnt(" #n ")" ::: "memory")
#define PG8_WAIT_L(n) asm volatile("s_waitcnt lgkmcnt(" #n ")" ::: "memory")
#define PG8_BAR __builtin_amdgcn_s_barrier()
#define PG8_SCHED __builtin_amdgcn_sched_barrier(0)
    Unit cur, nxt; int ui = 0;
    if (!S.next(0, cur)) return;
    f32x4 acc[2][2][4][2];
#pragma unroll
    for (int a = 0; a < 2; ++a)
#pragma unroll
        for (int b = 0; b < 2; ++b)
#pragma unroll
            for (int m = 0; m < 4; ++m)
#pragma unroll
                for (int n = 0; n < 2; ++n) acc[a][b][m][n] = (f32x4){0.f, 0.f, 0.f, 0.f};
    bf16x8 At[4][2], B0[2][2], B1[2][2];
    const char* cA = P.a(cur); const char* cB = P.b(cur);
    PG8_STAGE(PG8_SB(0, 0), cB, voffB); PG8_STAGE(PG8_SA(0, 0), cA, voffA); PG8_STAGE(PG8_SB(0, 1), cB + hstep, voffB); PG8_STAGE(PG8_SA(0, 1), cA + hstep, voffA);
    if (wr == 1) PG8_BAR;
    PG8_WAIT_V(4); PG8_BAR;
    PG8_STAGE(PG8_SB(1, 0), cB + kstep, voffB); PG8_STAGE(PG8_SA(1, 0), cA + kstep, voffA); PG8_STAGE(PG8_SB(1, 1), cB + hstep + kstep, voffB);
    PG8_WAIT_V(6); PG8_BAR;
    for (;;) {
        const bool has_next = S.next(ui + 1, nxt);
        const char* nA = has_next ? P.a(nxt) : cA; const char* nB = has_next ? P.b(nxt) : cB;
        for (int t = 0; t < nt; t += 2) {
            const bool last = (t == nt - 2);
#if GEMM_DRAIN
            PG8_WAIT_V(0);
#endif
            E.mid(acc, cur, t, wr, fr, lds);
            const char* a1 = cA + (size_t)(t + 1) * kstep;
            const char* a2 = last ? nA : cA + (size_t)(t + 2) * kstep; const char* b2 = last ? nB : cB + (size_t)(t + 2) * kstep;
            const char* a3 = a2 + kstep; const char* b3 = b2 + kstep;
            PG8_LDB(B0, 0, 0); PG8_SCHED; PG8_LDA(At, 0, 0); PG8_STAGE(PG8_SA(1, 1), a1 + hstep, voffA);
            PG8_WAIT_L(8); PG8_BAR; PG8_WAIT_L(0); PG8_MMA(0, 0, At, B0); PG8_BAR; PG8_SCHED;
            PG8_LDB(B1, 0, 1); PG8_STAGE(PG8_SB(0, 0), b2, voffB);
            PG8_BAR; PG8_WAIT_L(0); PG8_MMA(0, 1, At, B1); PG8_BAR;
            PG8_LDA(At, 0, 1); PG8_STAGE(PG8_SA(0, 0), a2, voffA);
            PG8_BAR; PG8_WAIT_L(0); PG8_MMA(1, 0, At, B0); PG8_BAR; PG8_SCHED;
            PG8_STAGE(PG8_SB(0, 1), b2 + hstep, voffB);
            PG8_WAIT_V(6); PG8_BAR; PG8_MMA(1, 1, At, B1); PG8_BAR;
            PG8_LDB(B0, 1, 0); PG8_SCHED; PG8_LDA(At, 1, 0); PG8_STAGE(PG8_SA(0, 1), a2 + hstep, voffA);
            PG8_WAIT_L(8); PG8_BAR; PG8_WAIT_L(0); PG8_MMA(0, 0, At, B0); PG8_BAR; PG8_SCHED;
            PG8_LDB(B1, 1, 1); PG8_STAGE(PG8_SB(1, 0), b3, voffB);
            PG8_BAR; PG8_WAIT_L(0); PG8_MMA(0, 1, At, B1); PG8_BAR;
            PG8_LDA(At, 1, 1); PG8_STAGE(PG8_SA(1, 0), a3, voffA);
            PG8_BAR; PG8_WAIT_L(0); PG8_MMA(1, 0, At, B0); PG8_BAR; PG8_SCHED;
            PG8_STAGE(PG8_SB(1, 1), b3 + hstep, voffB);
            PG8_WAIT_V(6); PG8_BAR; PG8_MMA(1, 1, At, B1); PG8_BAR;
        }
        E(acc, cur, wr, wc, fr, fq, lds);
        if (!has_next) break;
        cur = nxt; cA = nA; cB = nB; ++ui;
    }
    PG8_WAIT_V(0);
    if (wr == 0) PG8_BAR;
    PG8_BAR;
#undef PG8_SA
#undef PG8_SB
#undef PG8_STAGE
#undef PG8_LDA
#undef PG8_LDB
#undef PG8_MMA
#undef PG8_WAIT_V
#undef PG8_WAIT_L
#undef PG8_BAR
#undef PG8_SCHED
}
#define ACC_ZERO(acc) do { _Pragma("unroll") for (int a_ = 0; a_ < 2; ++a_) _Pragma("unroll") for (int b_ = 0; b_ < 2; ++b_) _Pragma("unroll") for (int m_ = 0; m_ < 4; ++m_) _Pragma("unroll") for (int n_ = 0; n_ < 2; ++n_) acc[a_][b_][m_][n_] = (f32x4){0.f, 0.f, 0.f, 0.f}; } while (0)
}


#define XB_TMO      128
#define XB_XCNT(j)  (256  + 64 * (j))
#define XB_XSUB(j)  (1280 + 64 * (j))
#define XB_XGEN(j)  (2304 + 64 * (j))
#define XB_TOP      3328
#define XB_TOPGEN   3392
#define XCD_BAR_WORDS 3456
#define XB_SPIN_CAP (1u << 18)

__device__ __forceinline__ unsigned xb_ld(unsigned* p)              { return __hip_atomic_load(p, __ATOMIC_RELAXED, __HIP_MEMORY_SCOPE_AGENT); }
__device__ __forceinline__ unsigned xb_add(unsigned* p, unsigned v) { return __hip_atomic_fetch_add(p, v, __ATOMIC_RELAXED, __HIP_MEMORY_SCOPE_AGENT); }
__device__ __forceinline__ unsigned xb_xcc_id() { return (unsigned)__builtin_amdgcn_s_getreg((3 << 11) | 20) & 0xFu; }
#define XB_SPIN(cond, bar) do { unsigned _sp = 0; while (cond) { __builtin_amdgcn_s_sleep(1); \
    if ((++_sp & 255u) == 0u) { if (xb_ld(&(bar)[XB_TMO])) break; if (_sp > XB_SPIN_CAP) { atomicAdd(&(bar)[XB_TMO], 1u); break; } } } } while (0)

struct XcdBarrier {
    unsigned* bar; unsigned x;
    volatile LAS unsigned* st;
};

__device__ __forceinline__ XcdBarrier xcd_barrier_post(unsigned* bar, volatile LAS unsigned* st) {
    XcdBarrier b; b.bar = bar; b.x = xb_xcc_id(); b.st = st;
    if (threadIdx.x == 0) (void)xb_add(&bar[XB_XCNT(b.x)], 1u);
    return b;
}
__device__ __forceinline__ void xcd_barrier_complete(unsigned* bar, unsigned x, unsigned& nloc, unsigned& nx) {
    const unsigned G = gridDim.x * gridDim.y * gridDim.z;
    unsigned sum, cnt, mine, sp = 0u;
    for (;;) {
        sum = 0u; cnt = 0u; mine = 0u;
#pragma unroll
        for (unsigned j = 0; j < 16; ++j) { const unsigned c = xb_ld(&bar[XB_XCNT(j)]); sum += c; cnt += (c > 0u) ? 1u : 0u; mine = (j == x) ? c : mine; }
        if (sum == G) break;
        __builtin_amdgcn_s_sleep(1);
        if ((++sp & 255u) == 0u) { if (xb_ld(&bar[XB_TMO])) break; if (sp > XB_SPIN_CAP) { atomicAdd(&bar[XB_TMO], 1u); break; } }
    }
    nloc = mine > 0u ? mine : 1u; nx = cnt > 0u ? cnt : 1u;
}

__device__ __forceinline__ void xcd_barrier(const XcdBarrier& b) {
    asm volatile("s_waitcnt vmcnt(0)" ::: "memory");
    __syncthreads();
    if (threadIdx.x == 0) {
        unsigned* bar = b.bar;
        __builtin_amdgcn_s_waitcnt(0);
        unsigned nloc = b.st[0], nx = b.st[1];
        if (nloc == 0u) { xcd_barrier_complete(bar, b.x, nloc, nx); b.st[0] = nloc; b.st[1] = nx; }
        const unsigned old = xb_add(&bar[XB_XSUB(b.x)], 1u);
        const unsigned gen = old / nloc;
        if (old + 1u == (gen + 1u) * nloc) {
            __builtin_amdgcn_fence(__ATOMIC_RELEASE, "agent");
            asm volatile("s_waitcnt vmcnt(0)" ::: "memory");
            const unsigned og = xb_add(&bar[XB_TOP], 1u);
            const unsigned tg = og / nx;
            if (og + 1u == (tg + 1u) * nx) xb_add(&bar[XB_TOPGEN], 1u);
            else XB_SPIN(xb_ld(&bar[XB_TOPGEN]) == tg, bar);
            __builtin_amdgcn_fence(__ATOMIC_ACQUIRE, "agent");
            xb_add(&bar[XB_XGEN(b.x)], 1u);
            asm volatile("s_waitcnt vmcnt(0)" ::: "memory");
        } else {
            XB_SPIN(xb_ld(&bar[XB_XGEN(b.x)]) == gen, bar);
            __builtin_amdgcn_fence(__ATOMIC_ACQUIRE, "agent");
            asm volatile("s_waitcnt vmcnt(0)" ::: "memory");
        }
    }
    __syncthreads();
}


struct TV { bf16_t* big; bf16_t* sm; };
__device__ __forceinline__ bf16_t* tv_tile(const TV& t, int pm) { return pm < 128 ? t.big + (size_t)pm * 256 * DM : t.sm; }
__device__ __forceinline__ bf16_t* tv_row(const TV& t, int row) { return row < NTP ? t.big + (size_t)row * DM : t.sm + (size_t)(row - NTP) * DM; }

struct Epi1 {
    static constexpr bool PERM = true;
    __device__ __forceinline__ void mid(f32x4 (&)[2][2][4][2], const pg8::Unit&, int, int, int, LAS unsigned char*) const {}
    TV Q, K, V, OG, XB, SZB, GA, GB; const float* b_gate;
    __device__ __forceinline__ void operator()(f32x4 (&acc)[2][2][4][2], const pg8::Unit& u, int wr, int wc, int fr, int fq, LAS unsigned char* lds) const {
        const int pn = u.pn; int type, colt; TV tv; const float* bias = nullptr;
        if (pn < 4) { type = 0; tv = Q; colt = pn * 256; }
        else if (pn < 8) { type = 1; tv = K; colt = (pn - 4) * 256; }
        else if (pn < 12) { type = 0; tv = V; colt = (pn - 8) * 256; }
        else if (pn < 20) { type = 2; tv = OG; colt = (pn - 12) * 128; }
        else if (pn < 24) { type = 0; tv = XB; colt = (pn - 20) * 256; }
        else if (pn < 28) { type = 3; tv = SZB; colt = (pn - 24) * 256; }
        else { type = 4; tv = GA; colt = (pn - 28) * 128; bias = b_gate + colt; }
        bf16_t* base = tv_tile(tv, u.pm);
        const int nai = (u.pm < 128) ? 2 : 1;
        const int cl = wc * 32 + 8 * fq;
        if (type == 2) {
#pragma unroll
            for (int ai = 0; ai < 2; ++ai) if (ai < nai)
#pragma unroll
                for (int m = 0; m < 4; ++m) {
                    bf16_t* rowp = base + (size_t)(ai * 128 + wr * 64 + m * 16 + fr) * DM + colt + cl;
                    float v[8];
#pragma unroll
                    for (int n = 0; n < 2; ++n)
#pragma unroll
                        for (int j = 0; j < 4; ++j) { const float o = acc[ai][0][m][n][j], z = acc[ai][1][m][n][j]; v[n * 4 + j] = sigm(o) * z * sigm(z); }
                    u32x4 w; w.x = pg8::cvt_pk_bf16(v[0], v[1]); w.y = pg8::cvt_pk_bf16(v[2], v[3]); w.z = pg8::cvt_pk_bf16(v[4], v[5]); w.w = pg8::cvt_pk_bf16(v[6], v[7]);
                    *(u32x4*)rowp = w;
                }
        } else if (type == 4) {
            f32x4 bv[2][2];
#pragma unroll
            for (int bj = 0; bj < 2; ++bj)
#pragma unroll
                for (int n = 0; n < 2; ++n) bv[bj][n] = *(const f32x4*)(bias + bj * 1024 + cl + 4 * n);
            bf16_t* baseb = tv_tile(GB, u.pm);
#pragma unroll
            for (int ai = 0; ai < 2; ++ai) if (ai < nai)
#pragma unroll
                for (int m = 0; m < 4; ++m) {
                    const size_t ro = (size_t)(ai * 128 + wr * 64 + m * 16 + fr) * DM + colt + cl;
                    float vr[8], vg[8];
#pragma unroll
                    for (int n = 0; n < 2; ++n)
#pragma unroll
                        for (int j = 0; j < 4; ++j) { const float ea = __expf(-(acc[ai][0][m][n][j] + bv[0][n][j])), eb = __expf(-fmaxf(acc[ai][1][m][n][j] + bv[1][n][j], -30.f));
                            vg[n * 4 + j] = __builtin_amdgcn_rcpf(1.0f + eb); vr[n * 4 + j] = (1.0f + eb) * __builtin_amdgcn_rcpf(1.0f + ea); }
                    u32x4 w; w.x = pg8::cvt_pk_bf16(vr[0], vr[1]); w.y = pg8::cvt_pk_bf16(vr[2], vr[3]); w.z = pg8::cvt_pk_bf16(vr[4], vr[5]); w.w = pg8::cvt_pk_bf16(vr[6], vr[7]);
                    *(u32x4*)(base + ro) = w;
                    w.x = pg8::cvt_pk_bf16(vg[0], vg[1]); w.y = pg8::cvt_pk_bf16(vg[2], vg[3]); w.z = pg8::cvt_pk_bf16(vg[4], vg[5]); w.w = pg8::cvt_pk_bf16(vg[6], vg[7]);
                    *(u32x4*)(baseb + ro) = w;
                }
        } else {
            const float sc = (type == 1) ? 0.0625f : 1.0f; const bool silu = (type == 3);
#pragma unroll
            for (int ai = 0; ai < 2; ++ai) if (ai < nai)
#pragma unroll
                for (int m = 0; m < 4; ++m) {
                    bf16_t* rowp = base + (size_t)(ai * 128 + wr * 64 + m * 16 + fr) * DM + colt + cl;
#pragma unroll
                    for (int bj = 0; bj < 2; ++bj) {
                        float v[8];
#pragma unroll
                        for (int n = 0; n < 2; ++n)
#pragma unroll
                            for (int j = 0; j < 4; ++j) { float x = acc[ai][bj][m][n][j] * sc; if (silu) x = x * sigm(x); v[n * 4 + j] = x; }
                        u32x4 w; w.x = pg8::cvt_pk_bf16(v[0], v[1]); w.y = pg8::cvt_pk_bf16(v[2], v[3]); w.z = pg8::cvt_pk_bf16(v[4], v[5]); w.w = pg8::cvt_pk_bf16(v[6], v[7]);
                        *(u32x4*)(rowp + bj * 128) = w;
                    }
                }
        }
        ACC_ZERO(acc);
    }
};
struct Prob1 { TV U; const bf16_t* W;
    __device__ __forceinline__ const char* a(const pg8::Unit& u) const { return (const char*)tv_tile(U, u.pm); }
    __device__ __forceinline__ const char* b(const pg8::Unit& u) const { return (const char*)(W + (size_t)u.pn * 256 * DM); } };

struct Epi2 {
    static constexpr bool PERM = true;
    __device__ __forceinline__ void mid(f32x4 (&acc)[2][2][4][2], const pg8::Unit& u, int t, int wr, int fr, LAS unsigned char* lds) const {
        if (u.sub != 0 || t == 0 || (t & 3) != 0) return;
        const int hd = t >> 2;
        const LAS float* RS = (const LAS float*)(lds + RS_OFF) + u.slot * 1024;
#pragma unroll
        for (int ai = 0; ai < 2; ++ai)
#pragma unroll
            for (int m = 0; m < 4; ++m) { const int rl = ai * 128 + wr * 64 + m * 16 + fr;
                const float ratio = RS[rl * 4 + hd - 1] * __builtin_amdgcn_rcpf(RS[rl * 4 + hd]);
#pragma unroll
                for (int bj = 0; bj < 2; ++bj)
#pragma unroll
                    for (int n = 0; n < 2; ++n) acc[ai][bj][m][n] = acc[ai][bj][m][n] * ratio; }
    }
    TV GA, GB, MG;
    __device__ __forceinline__ void operator()(f32x4 (&acc)[2][2][4][2], const pg8::Unit& u, int wr, int wc, int fr, int fq, LAS unsigned char* lds) const {
        const bf16_t* ga = tv_tile(GA, u.pm); const bf16_t* gb = tv_tile(GB, u.pm); bf16_t* mg = tv_tile(MG, u.pm);
        {
            int t_ = threadIdx.x; asm volatile("" : "+v"(t_));
            const unsigned off0 = (unsigned)(((t_ >> 6) * 32 + (t_ & 63) / 4) << 11) + (unsigned)((t_ & 3) << 7);
            const char* gbt = (const char*)(gb + u.pn * 256); const char* gat = (const char*)(ga + u.pn * 256);
#pragma unroll
            for (int q = 0; q < 2; ++q) __builtin_amdgcn_global_load_lds((const unsigned*)((u.sub == 0 ? gat : gbt) + off0 + q * 32768u), (LAS unsigned*)(lds + PF_OFF), 16, 0, 0);
        }
        const int nai = (u.pm < 128) ? 2 : 1;
        const int col0 = u.pn * 256 + wc * 32 + 8 * fq;
#pragma unroll
        for (int ai = 0; ai < 2; ++ai) if (ai < nai)
#pragma unroll
            for (int m = 0; m < 4; ++m) {
                const size_t ro = (size_t)(ai * 128 + wr * 64 + m * 16 + fr) * DM + col0;
                const float rs3 = ((const LAS float*)(lds + RS_OFF))[u.slot * 1024 + (ai * 128 + wr * 64 + m * 16 + fr) * 4 + 3];
#pragma unroll
                for (int bj = 0; bj < 2; ++bj) {
                    const u32x4 gbw = *(const u32x4*)((u.sub == 0 ? ga : gb) + ro + bj * 128);
                    float gbv[8] = {bflo(gbw.x), bfhi(gbw.x), bflo(gbw.y), bfhi(gbw.y), bflo(gbw.z), bfhi(gbw.z), bflo(gbw.w), bfhi(gbw.w)};
                    if (u.sub == 0) {
#pragma unroll
                        for (int n = 0; n < 2; ++n)
#pragma unroll
                            for (int j = 0; j < 4; ++j) acc[ai][bj][m][n][j] *= rs3 * gbv[n * 4 + j];
                    } else {
                        float v[8];
#pragma unroll
                        for (int n = 0; n < 2; ++n)
#pragma unroll
                            for (int j = 0; j < 4; ++j) v[n * 4 + j] = acc[ai][bj][m][n][j] * gbv[n * 4 + j];
                        u32x4 w; w.x = pg8::cvt_pk_bf16(v[0], v[1]); w.y = pg8::cvt_pk_bf16(v[2], v[3]); w.z = pg8::cvt_pk_bf16(v[4], v[5]); w.w = pg8::cvt_pk_bf16(v[6], v[7]);
                        *(u32x4*)(mg + ro + bj * 128) = w;
                    }
                }
            }
        if (u.sub == 1) ACC_ZERO(acc);
    }
};
struct Prob2 { TV YA, YB; const bf16_t* WA; const bf16_t* WB;
    __device__ __forceinline__ const char* a(const pg8::Unit& u) const { return (const char*)tv_tile(u.sub ? YB : YA, u.pm); }
    __device__ __forceinline__ const char* b(const pg8::Unit& u) const { return (const char*)((u.sub ? WB : WA) + (size_t)u.pn * 256 * DM); } };

struct Epi3 {
    static constexpr bool PERM = true;
    __device__ __forceinline__ void mid(f32x4 (&)[2][2][4][2], const pg8::Unit&, int, int, int, LAS unsigned char*) const {}
    const float* xp; bf16_t* yb; const float* modg; float* rowss;
    __device__ __forceinline__ void operator()(f32x4 (&acc)[2][2][4][2], const pg8::Unit& u, int wr, int wc, int fr, int fq, LAS unsigned char* lds) const {
        const int col0 = u.pn * 256 + wc * 32 + 8 * fq;
        const float* xb = xp + (size_t)u.pm * 256 * DM;
        int t_ = threadIdx.x; asm volatile("" : "+v"(t_));
        const int rl_ = (t_ >> 8) * 64 + (t_ & 15);
        {
            const char* xt = (const char*)(xb + u.pn * 256);
            const unsigned off0 = (unsigned)(((t_ >> 6) * 32 + (t_ & 63) / 8) << 12) + (unsigned)((t_ & 7) << 7);
#pragma unroll
            for (int q = 0; q < 4; ++q) __builtin_amdgcn_global_load_lds((const unsigned*)(xt + off0 + q * 32768u), (LAS unsigned*)(lds + PF_OFF), 16, 0, 0);
        }
        bf16_t* ob = yb + (size_t)u.pm * 256 * DM;
        const float* gp = modg + (u.pm >> 3) * DM + col0;
#pragma unroll
        for (int ai = 0; ai < 2; ++ai)
#pragma unroll
            for (int m = 0; m < 4; ++m) {
                const int rl = ai * 128 + wr * 64 + m * 16 + fr;
                const size_t ro = (size_t)rl * DM + col0;
                float ss = 0.f;
#pragma unroll
                for (int bj = 0; bj < 2; ++bj) {
                    const f32x4 y0 = *(const f32x4*)(xb + ro + bj * 128) + *(const f32x4*)(gp + bj * 128) * acc[ai][bj][m][0];
                    const f32x4 y1 = *(const f32x4*)(xb + ro + bj * 128 + 4) + *(const f32x4*)(gp + bj * 128 + 4) * acc[ai][bj][m][1];
                    ss += ((y0[0] * y0[0] + y0[1] * y0[1]) + (y0[2] * y0[2] + y0[3] * y0[3])) + ((y1[0] * y1[0] + y1[1] * y1[1]) + (y1[2] * y1[2] + y1[3] * y1[3]));
                    u32x4 w; w.x = pk2(y0[0], y0[1]); w.y = pk2(y0[2], y0[3]); w.z = pk2(y1[0], y1[1]); w.w = pk2(y1[2], y1[3]);
                    *(u32x4*)(ob + ro + bj * 128) = w;
                }
                ss += __shfl_xor(ss, 16); ss += __shfl_xor(ss, 32);
                if (fq == 0) rowss[((size_t)u.pm * 256 + ai * 128 + m * 16 + rl_) * 16 + u.pn * 4 + (t_ >> 6 & 3)] = ss;
            }
        ACC_ZERO(acc);
    }
};
struct Prob3 { TV MG; const bf16_t* WO;
    __device__ __forceinline__ const char* a(const pg8::Unit& u) const { return (const char*)tv_tile(MG, u.pm); }
    __device__ __forceinline__ const char* b(const pg8::Unit& u) const { return (const char*)(WO + (size_t)u.pn * 256 * DM); } };


__device__ __forceinline__ void mini_gemm2(const Params& p, LAS unsigned char* lds) {
    const int lane = threadIdx.x & 63, wave = threadIdx.x >> 6, g = lane >> 4, li = lane & 15, tsel = wave >> 2, ksl = wave & 3;
    unsigned char* ws = p.ws;
    const bf16_t* ya = (const bf16_t*)(ws + WS_SMALL + SM_V * SMALL_B); const bf16_t* yb = (const bf16_t*)(ws + WS_SMALL + SM_SZB * SMALL_B);
    const bf16_t* ga = (const bf16_t*)(ws + WS_SMALL + SM_GA * SMALL_B); const bf16_t* gb = (const bf16_t*)(ws + WS_SMALL + SM_GB * SMALL_B);
    bf16_t* mg = (bf16_t*)(ws + WS_SMALL + SM_U * SMALL_B);
    const bf16_t* wa = (const bf16_t*)(ws + WS_WAT); const bf16_t* wb = (const bf16_t*)(ws + WS_WBT);
    LAS float* red = (LAS float*)lds;
    for (int t0 = blockIdx.x * 2; t0 < 512; t0 += gridDim.x * 2) {
        const int wt = t0 + tsel, r0 = (wt >> 6) * 16, c0 = (wt & 63) * 16;
        const bf16_t* pa = ya + (size_t)(r0 + li) * DM + ksl * 256 + 8 * g; const bf16_t* pb = yb + (size_t)(r0 + li) * DM + ksl * 256 + 8 * g;
        const bf16_t* qa = wa + (size_t)(c0 + li) * DM + ksl * 256 + 8 * g; const bf16_t* qb = wb + (size_t)(c0 + li) * DM + ksl * 256 + 8 * g;
        f32x4 a1 = (f32x4){0.f, 0.f, 0.f, 0.f}, a2 = (f32x4){0.f, 0.f, 0.f, 0.f};
#pragma unroll
        for (int k0 = 0; k0 < 256; k0 += 32) {
            a1 = __builtin_amdgcn_mfma_f32_16x16x32_bf16(*(const bf16x8*)(pa + k0), *(const bf16x8*)(qa + k0), a1, 0, 0, 0);
            a2 = __builtin_amdgcn_mfma_f32_16x16x32_bf16(*(const bf16x8*)(pb + k0), *(const bf16x8*)(qb + k0), a2, 0, 0, 0);
        }
        { const float* hss = (const float*)(ws + WS_HSS);
#pragma unroll
          for (int r = 0; r < 4; ++r) { const f32x4 hs = *(const f32x4*)(hss + (size_t)(NTP + r0 + 4 * g + r) * 16 + ksl * 4);
              a1[r] *= rsqrtf(((hs[0] + hs[1]) + (hs[2] + hs[3])) * (1.0f / 256.0f) + EPS); } }
        *(LAS f32x4*)(red + (wave * 64 + lane) * 8) = a1; *(LAS f32x4*)(red + (wave * 64 + lane) * 8 + 4) = a2;
        __syncthreads();
        if (ksl == 0) {
#pragma unroll
            for (int q = 1; q < 4; ++q) { a1 += *(const LAS f32x4*)(red + ((wave + q) * 64 + lane) * 8); a2 += *(const LAS f32x4*)(red + ((wave + q) * 64 + lane) * 8 + 4); }
#pragma unroll
            for (int r = 0; r < 4; ++r) { const size_t o = (size_t)(r0 + 4 * g + r) * DM + c0 + li;
                mg[o] = (bf16_t)f2bf(bf2f(gb[o]) * (bf2f(ga[o]) * a1[r] + a2[r])); }
        }
        __syncthreads();
    }
}
__device__ __forceinline__ void mini_gemm3(const Params& p, LAS unsigned char* lds) {
    const int lane = threadIdx.x & 63, wave = threadIdx.x >> 6, g = lane >> 4, li = lane & 15, tsel = wave >> 2, ksl = wave & 3;
    unsigned char* ws = p.ws;
    const bf16_t* mg = (const bf16_t*)(ws + WS_SMALL + SM_U * SMALL_B); const bf16_t* wo = (const bf16_t*)(ws + WS_WOT);
    const float* modg = (const float*)(ws + WS_MODG);
    LAS float* red = (LAS float*)lds;
    for (int t0 = blockIdx.x * 2; t0 < 512; t0 += gridDim.x * 2) {
        const int wt = t0 + tsel, r0 = (wt >> 6) * 16, c0 = (wt & 63) * 16;
        const bf16_t* pa = mg + (size_t)(r0 + li) * DM + ksl * 256 + 8 * g; const bf16_t* qa = wo + (size_t)(c0 + li) * DM + ksl * 256 + 8 * g;
        f32x4 a1 = (f32x4){0.f, 0.f, 0.f, 0.f};
#pragma unroll
        for (int k0 = 0; k0 < 256; k0 += 32) a1 = __builtin_amdgcn_mfma_f32_16x16x32_bf16(*(const bf16x8*)(pa + k0), *(const bf16x8*)(qa + k0), a1, 0, 0, 0);
        *(LAS f32x4*)(red + (wave * 64 + lane) * 4) = a1;
        __syncthreads();
        if (ksl == 0) {
#pragma unroll
            for (int q = 1; q < 4; ++q) a1 += *(const LAS f32x4*)(red + ((wave + q) * 64 + lane) * 4);
#pragma unroll
            for (int r = 0; r < 4; ++r) { const int row = r0 + 4 * g + r, col = c0 + li;
                p.out[O_YS + (size_t)row * DM + col] = p.in[1][(size_t)row * DM + col] + modg[(16 + (row >> 4)) * DM + col] * a1[r]; }
        }
        __syncthreads();
    }
}

__device__ __forceinline__ void transpose_item(const float* W, int ldw, int col0, int k0, bf16_t* WT, int ldt, int row0, LAS float* scr, int lane, const float* kscale = nullptr) {
#pragma unroll
    for (int i = 0; i < 32; ++i) { const int kk = 2 * i + (lane >> 5); float v = W[(size_t)(k0 + kk) * ldw + col0 + (lane & 31)]; if (kscale) v *= kscale[k0 + kk]; scr[kk * 33 + (lane & 31)] = v; }
    LDS_WAIT(); asm volatile("" ::: "memory");
    const int c = lane & 7;
#pragma unroll
    for (int j = 0; j < 4; ++j) { const int n = (lane >> 3) + 8 * j; const LAS float* s = scr + (8 * c) * 33 + n;
        u32x4 o; o.x = pk2(s[0 * 33], s[1 * 33]); o.y = pk2(s[2 * 33], s[3 * 33]); o.z = pk2(s[4 * 33], s[5 * 33]); o.w = pk2(s[6 * 33], s[7 * 33]);
        *(u32x4*)(WT + (size_t)(row0 + n) * ldt + k0 + 8 * c) = o; }
    LDS_WAIT(); asm volatile("" ::: "memory");
}

__device__ __forceinline__ void phase0(const Params& p, LAS unsigned char* lds) {
    const int tid = threadIdx.x, lane = tid & 63, wave = tid >> 6, G = gridDim.x;
    unsigned char* ws = p.ws;
    for (int it = blockIdx.x; it < 192; it += G) {
        const int cgp = it % 48, ks = it / 48;
        LAS float* cs = (LAS float*)lds;
        LAS float* red = (LAS float*)(lds + 24576);
        for (int i = tid; i < 24 * 256; i += 512) { const int b = i >> 8, k = i & 255; cs[k * 24 + b] = (b < 16) ? p.in[2][b * DM + ks * 256 + k] : p.in[3][(b - 16) * DM + ks * 256 + k]; }
        __syncthreads();
        const int col = tid & 63, kq = tid >> 6;
        float a[24];
#pragma unroll
        for (int b = 0; b < 24; ++b) a[b] = 0.f;
        const float* wm = p.in[9] + (size_t)(ks * 256 + kq * 32) * 3072 + cgp * 64 + col;
        for (int kb = 0; kb < 32; kb += 8) {
            float wv[8];
#pragma unroll
            for (int i = 0; i < 8; ++i) wv[i] = wm[(size_t)(kb + i) * 3072];
#pragma unroll
            for (int i = 0; i < 8; ++i) {
#pragma unroll
                for (int b = 0; b < 24; ++b) a[b] += cs[(kq * 32 + kb + i) * 24 + b] * wv[i];
                asm volatile("" ::: "memory"); }
        }
#pragma unroll
        for (int b = 0; b < 24; ++b) red[(kq * 24 + b) * 64 + col] = a[b];
        __syncthreads();
        float* modp = (float*)(ws + WS_MODP);
        for (int i = tid; i < 24 * 64; i += 512) { const int b = i >> 6, c = i & 63; float s = 0.f;
#pragma unroll
            for (int q = 0; q < 8; ++q) s += red[(q * 24 + b) * 64 + c];
            modp[((size_t)ks * 24 + b) * 3072 + cgp * 64 + c] = s; }
        __syncthreads();
    }
    { float* wif = (float*)(ws + WS_WIF);
      for (int i = blockIdx.x * 512 + tid; i < 8 * DM; i += G * 512) { const int g = i >> 10, k = i & 1023; wif[i] = p.in[12][(size_t)k * DIN + 5120 + g]; } }
    LAS float* scr = (LAS float*)(lds + wave * 16384);
    const int gw = blockIdx.x * 8 + wave, NGW = G * 8;
    constexpr int I_W1 = 288 * 16, I_SQ = 32 * 16, I_R = 64, NIT = I_W1 + 3 * I_SQ + 2 * I_R;
    for (int it = gw; it < NIT; it += NGW) {
        int r = it;
        if (r < I_W1) {
            const int rg = r >> 4, kb = r & 15, pn = rg >> 3, c0 = (rg & 7) * 32; const float* W; int ldw, col;
            if (pn < 12) { W = p.in[12]; ldw = DIN; col = rg * 32; }
            else if (pn < 20) { W = p.in[12]; ldw = DIN; const int j = pn - 12; col = (c0 < 128) ? 3072 + 128 * j + c0 : 4096 + 128 * j + (c0 - 128); }
            else if (pn < 24) { W = p.in[12]; ldw = DIN; col = 5128 + (rg * 32 - 5120); }
            else if (pn < 28) { W = p.in[12]; ldw = DIN; col = 6152 + (rg * 32 - 6144); }
            else { W = p.in[22]; ldw = 2048; const int j = pn - 28; col = (c0 < 128) ? 128 * j + c0 : 1024 + 128 * j + (c0 - 128); }
            transpose_item(W, ldw, col, kb * 64, (bf16_t*)(ws + WS_W1T), DM, rg * 32, scr, lane); continue; }
        r -= I_W1;
        if (r < 3 * I_SQ) { const int w = r / I_SQ, q = r % I_SQ, rg = q >> 4, kb = q & 15;
            transpose_item(p.in[24 + w], DM, rg * 32, kb * 64, (bf16_t*)(ws + (w == 0 ? WS_WAT : (w == 1 ? WS_WBT : WS_WOT))), DM, rg * 32, scr, lane, w == 0 ? p.in[14] : nullptr); continue; }
        r -= 3 * I_SQ;
        { const int w = r / I_R, q = r % I_R, n = q >> 3, rg = (q >> 1) & 3, kb = q & 1;
          transpose_item(p.in[w ? 19 : 17] + (size_t)n * 16384, 128, rg * 32, kb * 64, (bf16_t*)(ws + (w ? WS_WRXT : WS_WRAT)) + (size_t)n * 16384, 128, rg * 32, scr, lane); }
    }
}

__device__ __forceinline__ void phase1(const Params& p, LAS unsigned char* lds) {
    const int tid = threadIdx.x, lane = tid & 63, wave = tid >> 6, G = gridDim.x;
    unsigned char* ws = p.ws;
    LAS float* wif = (LAS float*)lds;
    { const float* src = (const float*)(ws + WS_WIF); for (int i = tid; i < 8 * DM; i += 512) wif[i] = src[i]; }
    __syncthreads();
    const float* modp = (const float*)(ws + WS_MODP); const float* b_mod = p.in[10]; const float* g_norm = p.in[11]; const float* b_if = p.in[13];
    float* IF = (float*)(ws + WS_IF);
    TV U{(bf16_t*)(ws + WS_U), (bf16_t*)(ws + WS_SMALL + SM_U * SMALL_B)};
    { float* modg = (float*)(ws + WS_MODG);
      for (int i = blockIdx.x * 512 + tid; i < 24 * DM; i += G * 512) { const int b = i >> 10, c = i & 1023; float s = b_mod[2048 + c];
#pragma unroll
          for (int ks = 0; ks < 4; ++ks) s += modp[((size_t)ks * 24 + b) * 3072 + 2048 + c];
          modg[i] = s; } }
    const bool h32 = (lane & 32) != 0, h16 = (lane & 16) != 0, h8 = (lane & 8) != 0;
    const int gi = (h32 ? 4 : 0) + (h16 ? 2 : 0) + (h8 ? 1 : 0);
    const float bif = b_if[gi];
    for (int wi = blockIdx.x * 8 + wave; wi < NTP / 16 + NTS; wi += G * 8) {
        const int row0 = wi < NTP / 16 ? wi * 16 : NTP + (wi - NTP / 16), nrow = wi < NTP / 16 ? 16 : 1;
        const int bidx = row0 < NTP ? (row0 >> 11) : 16 + ((row0 - NTP) >> 4);
        f32x4 sc[4], sh[4];
#pragma unroll
        for (int j = 0; j < 4; ++j) { const int idx = 4 * lane + 256 * j;
            f32x4 s = *(const f32x4*)(b_mod + idx), c = *(const f32x4*)(b_mod + 1024 + idx);
#pragma unroll
            for (int ks = 0; ks < 4; ++ks) { const float* mp = modp + ((size_t)ks * 24 + bidx) * 3072; s += *(const f32x4*)(mp + idx); c += *(const f32x4*)(mp + 1024 + idx); }
            sh[j] = s; sc[j] = *(const f32x4*)(g_norm + idx) * (c + 1.0f); }
        const float* xbase = row0 < NTP ? p.in[0] + (size_t)row0 * DM : p.in[1] + (size_t)(row0 - NTP) * DM;
        f32x4 nv[4];
#pragma unroll
        for (int j = 0; j < 4; ++j) nv[j] = *(const f32x4*)(xbase + 4 * lane + 256 * j);
        for (int r = 0; r < nrow; ++r) {
            const int row = row0 + r;
            f32x4 v[4]; float ss = 0.f;
#pragma unroll
            for (int j = 0; j < 4; ++j) { v[j] = nv[j]; ss += (v[j][0] * v[j][0] + v[j][1] * v[j][1]) + (v[j][2] * v[j][2] + v[j][3] * v[j][3]); }
            if (r + 1 < nrow) {
#pragma unroll
                for (int j = 0; j < 4; ++j) nv[j] = *(const f32x4*)(xbase + (size_t)(r + 1) * DM + 4 * lane + 256 * j); }
            const float rs = rsqrtf(wave_sum(ss) * (1.0f / DM) + EPS);
            bf16_t* ur = tv_row(U, row);
            float d[8];
#pragma unroll
            for (int g = 0; g < 8; ++g) d[g] = 0.f;
#pragma unroll
            for (int j = 0; j < 4; ++j) { v[j] = v[j] * rs * sc[j] + sh[j];
                u32x2 w; w.x = pk2(v[j][0], v[j][1]); w.y = pk2(v[j][2], v[j][3]); *(u32x2*)(ur + 4 * lane + 256 * j) = w;
#pragma unroll
                for (int g = 0; g < 8; ++g) { const f32x4 wv = *(const LAS f32x4*)(wif + g * DM + 4 * lane + 256 * j); d[g] += (v[j][0] * wv[0] + v[j][1] * wv[1]) + (v[j][2] * wv[2] + v[j][3] * wv[3]); } }
            float e[4], f[2], gs;
#pragma unroll
            for (int i = 0; i < 4; ++i) { const float send = h32 ? d[i] : d[i + 4], keep = h32 ? d[i + 4] : d[i]; e[i] = keep + __shfl_xor(send, 32); }
#pragma unroll
            for (int i = 0; i < 2; ++i) { const float send = h16 ? e[i] : e[i + 2], keep = h16 ? e[i + 2] : e[i]; f[i] = keep + __shfl_xor(send, 16); }
            { const float send = h8 ? f[0] : f[1], keep = h8 ? f[1] : f[0]; gs = keep + __shfl_xor(send, 8); }
            gs += __shfl_xor(gs, 4); gs += __shfl_xor(gs, 2); gs += __shfl_xor(gs, 1);
            if ((lane & 7) == 0) { float x = gs + bif;
                if (gi >= 4) x = fminf(x, 0.f) - __logf(1.0f + __expf(-fabsf(x)));
                IF[(size_t)row * 8 + gi] = x; }
        }
    }
}

constexpr int ML_QS = 0, ML_KS = 33792, ML_CB = 67584, ML_VS = 109824, ML_VW = 119040, ML_HS = 128256, ML_F = 137472;
__device__ __forceinline__ void mlstm_item(const Params& p, LAS unsigned char* lds, int b, int h, int vs, bool smp, bool dry) {
    int tid_ = threadIdx.x; asm volatile("" : "+v"(tid_));
    const int tid = tid_, lane = tid & 63, w = __builtin_amdgcn_readfirstlane(tid >> 6), g = lane >> 4, li = lane & 15, q4 = li >> 2, p4 = li & 3;
    unsigned char* ws = p.ws;
    const int L = smp ? DSEQ : 64, nch = smp ? 1 : SEQ / 64;
    const int row0 = smp ? NTP + b * DSEQ : b * SEQ;
    const bf16_t* qb = (smp ? (const bf16_t*)(ws + WS_SMALL + SM_Q * SMALL_B) + (size_t)(b * DSEQ) * DM : (const bf16_t*)(p.out) + (size_t)row0 * DM) + h * 256;
    const bf16_t* kb = (smp ? (const bf16_t*)(ws + WS_SMALL + SM_K * SMALL_B) + (size_t)(b * DSEQ) * DM : (const bf16_t*)((unsigned char*)p.out + 64 * MiB) + (size_t)row0 * DM) + h * 256;
    bf16_t* vb = (smp ? (bf16_t*)(ws + WS_SMALL + SM_V * SMALL_B) + (size_t)(b * DSEQ) * DM : (bf16_t*)(ws + WS_V) + (size_t)row0 * DM) + h * 256 + vs * 64;
    const float* IFb = (const float*)(ws + WS_IF) + (size_t)row0 * 8;
    float* HSSb = (float*)(ws + WS_HSS) + (size_t)row0 * 16 + h * 4 + vs;
    const bf16_t* ogb = (smp ? (const bf16_t*)(ws + WS_SMALL + SM_OG * SMALL_B) + (size_t)(b * DSEQ) * DM : (const bf16_t*)(ws + WS_OG) + (size_t)row0 * DM) + h * 256 + vs * 64;
    LAS float* F = (LAS float*)(lds + ML_F);
    LAS float *IG = F, *LF = F + 64, *HSQ = F + 128;
    LAS float *GGw = F + 264 + 320 * w, *MMw = GGw + 64, *SIw = GGw + 128, *EMw = GGw + 192, *WSw = GGw + 256;
    const int bh = b * 4 + h;
    const int vt = w & 3, ktb = (w >> 2) * 8, i0 = 2 * (w & 3);
    f32x4 cst[8], nst[2];
    float m_state;
    if (smp) {
        const float* C0 = p.in[4] + (size_t)bh * 65536 + (size_t)(vs * 64 + vt * 16 + li) * 256;
#pragma unroll
        for (int i = 0; i < 8; ++i) cst[i] = *(const f32x4*)(C0 + (ktb + i) * 16 + 4 * g);
#pragma unroll
        for (int q = 0; q < 2; ++q) nst[q] = (li == 0) ? *(const f32x4*)(p.in[5] + bh * 256 + (ktb + i0 + q) * 16 + 4 * g) : (f32x4){0.f, 0.f, 0.f, 0.f};
        m_state = p.in[6][bh];
    } else {
#pragma unroll
        for (int i = 0; i < 8; ++i) cst[i] = (f32x4){0.f, 0.f, 0.f, 0.f};
        nst[0] = (f32x4){0.f, 0.f, 0.f, 0.f}; nst[1] = nst[0];
        m_state = 0.f;
    }
#pragma unroll
    for (int i = 0; i < 8; ++i) { u32x2 wv; wv.x = pk2(cst[i][0], cst[i][1]); wv.y = pk2(cst[i][2], cst[i][3]);
        *(LAS u32x2*)(lds + ML_CB + (vt * 16 + li) * 528 + ((ktb + i) * 16 + 4 * g) * 2) = wv; }
    if (li == 0) {
#pragma unroll
        for (int q = 0; q < 2; ++q) { u32x2 wv; wv.x = pk2(nst[q][0], nst[q][1]); wv.y = pk2(nst[q][2], nst[q][3]);
            *(LAS u32x2*)(lds + ML_CB + 64 * 528 + ((ktb + i0 + q) * 16 + 4 * g) * 2) = wv; } }
    u32x4 rq[4], rk[4], rv; float rig = 0.f, rlf = 0.f;
    const u32x4 z4 = (u32x4){0u, 0u, 0u, 0u};
#define ML_PREFETCH(c) do { const int t0_ = (c) * 64; \
        _Pragma("unroll") for (int i_ = 0; i_ < 4; ++i_) { const int id_ = tid + 512 * i_, r_ = id_ >> 5, ch_ = id_ & 31; \
            if (!smp || r_ < L) { rq[i_] = *(const u32x4*)(qb + (size_t)(t0_ + r_) * DM + ch_ * 8); rk[i_] = *(const u32x4*)(kb + (size_t)(t0_ + r_) * DM + ch_ * 8); } else { rq[i_] = z4; rk[i_] = z4; } } \
        { const int r_ = tid >> 3, ch_ = tid & 7; rv = (!smp || r_ < L) ? *(const u32x4*)(vb + (size_t)(t0_ + r_) * DM + ch_ * 8) : z4; } \
        if (tid < 64) { if (!smp || tid < L) { rig = IFb[(size_t)(t0_ + tid) * 8 + h]; rlf = IFb[(size_t)(t0_ + tid) * 8 + 4 + h]; } else { rig = -INFINITY; rlf = 0.f; } } } while (0)
    ML_PREFETCH(0);
    bf16x8 ones; { const short o1 = (short)0x3F80;
#pragma unroll
        for (int j = 0; j < 8; ++j) ones[j] = o1; }
    const int tt = w >> 1, hb = (w & 1) * 2;
    for (int c = 0; c < nch; ++c) {
        const int t0 = c * 64;
#pragma unroll
        for (int i = 0; i < 4; ++i) { const int id = tid + 512 * i, r = id >> 5, ch = id & 31;
            *(LAS u32x4*)(lds + ML_QS + r * 528 + ch * 16) = rq[i]; *(LAS u32x4*)(lds + ML_KS + r * 528 + ch * 16) = rk[i]; }
        const u32x4 vcur = rv;
        { const int r = tid >> 3, ch = tid & 7; *(LAS u32x4*)(lds + ML_VS + r * 144 + ch * 16) = vcur; }
        if (tid < 64) { IG[tid] = rig; LF[tid] = rlf; }
        BAR_LDS();
        if (c + 1 < nch) ML_PREFETCH(c + 1);
        float decay, m_next;
        {
            const float bc = wave_scan_add(LF[lane]);
            const float gs = IG[lane] - bc;
            const float cm = wave_scan_max(gs);
            const float Mt = fmaxf(m_state, cm);
            const float ML_ = __builtin_bit_cast(float, __builtin_amdgcn_readlane(__builtin_bit_cast(int, Mt), 63));
            const float bL = __builtin_bit_cast(float, __builtin_amdgcn_readlane(__builtin_bit_cast(int, bc), 63));
            GGw[lane] = gs; MMw[lane] = Mt; SIw[lane] = __expf(m_state - Mt); EMw[lane] = __expf(-(bc + Mt)); WSw[lane] = __expf(gs - ML_);
            decay = __expf(m_state - ML_); m_next = bL + ML_;
        }
        { const int r = tid >> 3, ch = tid & 7; const float wsr = WSw[r];
          u32x4 o; o.x = pk2(bflo(vcur.x) * wsr, bfhi(vcur.x) * wsr); o.y = pk2(bflo(vcur.y) * wsr, bfhi(vcur.y) * wsr); o.z = pk2(bflo(vcur.z) * wsr, bfhi(vcur.z) * wsr); o.w = pk2(bflo(vcur.w) * wsr, bfhi(vcur.w) * wsr);
          *(LAS u32x4*)(lds + ML_VW + r * 144 + ch * 16) = o; }
        {
            bf16x8 qf[8];
#pragma unroll
            for (int kk = 0; kk < 8; ++kk) qf[kk] = *(const LAS bf16x8*)(lds + ML_QS + (tt * 16 + li) * 528 + (kk * 32 + g * 8) * 2);
            const float mt = MMw[tt * 16 + li];
            const int tq = tt * 16 + li;
            bf16x8 ap[2];
#pragma unroll
            for (int ks = 0; ks < 2; ++ks) {
                float pv[8];
#pragma unroll
                for (int hh = 0; hh < 2; ++hh) { const int st = 2 * ks + hh;
                    if (st <= tt) { f32x4 sa = (f32x4){0.f, 0.f, 0.f, 0.f};
#pragma unroll
                        for (int kk = 0; kk < 8; ++kk) { const bf16x8 kf = *(const LAS bf16x8*)(lds + ML_KS + (st * 16 + li) * 528 + (kk * 32 + g * 8) * 2); sa = __builtin_amdgcn_mfma_f32_16x16x32_bf16(kf, qf[kk], sa, 0, 0, 0); }
                        const f32x4 gv = *(const LAS f32x4*)(GGw + st * 16 + 4 * g);
#pragma unroll
                        for (int r = 0; r < 4; ++r) { const int sidx = st * 16 + 4 * g + r; pv[hh * 4 + r] = (sidx <= tq) ? sa[r] * __expf(gv[r] - mt) : 0.f; }
                    } else {
#pragma unroll
                        for (int r = 0; r < 4; ++r) pv[hh * 4 + r] = 0.f; } }
                union { u32x4 u; bf16x8 v; } cvt; cvt.u.x = pk2(pv[0], pv[1]); cvt.u.y = pk2(pv[2], pv[3]); cvt.u.z = pk2(pv[4], pv[5]); cvt.u.w = pk2(pv[6], pv[7]);
                ap[ks] = cvt.v;
            }
            f32x4 na[2], nq = (f32x4){0.f, 0.f, 0.f, 0.f}, ra = (f32x4){0.f, 0.f, 0.f, 0.f};
            na[0] = (f32x4){0.f, 0.f, 0.f, 0.f}; na[1] = na[0];
#pragma unroll
            for (int kk = 0; kk < 8; ++kk) {
                const bf16x8 c0 = *(const LAS bf16x8*)(lds + ML_CB + ((hb + 0) * 16 + li) * 528 + (kk * 32 + g * 8) * 2);
                const bf16x8 c1 = *(const LAS bf16x8*)(lds + ML_CB + ((hb + 1) * 16 + li) * 528 + (kk * 32 + g * 8) * 2);
                const bf16x8 cn = *(const LAS bf16x8*)(lds + ML_CB + 64 * 528 + (kk * 32 + g * 8) * 2);
                na[0] = __builtin_amdgcn_mfma_f32_16x16x32_bf16(qf[kk], c0, na[0], 0, 0, 0);
                na[1] = __builtin_amdgcn_mfma_f32_16x16x32_bf16(qf[kk], c1, na[1], 0, 0, 0);
                nq = __builtin_amdgcn_mfma_f32_16x16x32_bf16(qf[kk], cn, nq, 0, 0, 0);
            }
            const f32x4 si = *(const LAS f32x4*)(SIw + tt * 16 + 4 * g), em = *(const LAS f32x4*)(EMw + tt * 16 + 4 * g);
            na[0] = na[0] * si; na[1] = na[1] * si;
#pragma unroll
            for (int ks = 0; ks < 2; ++ks) if (2 * ks <= tt) {
                ra = __builtin_amdgcn_mfma_f32_16x16x32_bf16(ap[ks], ones, ra, 0, 0, 0);
#pragma unroll
                for (int j = 0; j < 2; ++j) {
                    const s16x4 v0 = __builtin_amdgcn_ds_read_tr16_b64_v4i16((LAS s16x4*)(lds + ML_VS + (ks * 32 + g * 4 + q4) * 144 + ((hb + j) * 16 + 4 * p4) * 2));
                    const s16x4 v1 = __builtin_amdgcn_ds_read_tr16_b64_v4i16((LAS s16x4*)(lds + ML_VS + (ks * 32 + 16 + g * 4 + q4) * 144 + ((hb + j) * 16 + 4 * p4) * 2));
                    bf16x8 bv; bv[0] = v0[0]; bv[1] = v0[1]; bv[2] = v0[2]; bv[3] = v0[3]; bv[4] = v1[0]; bv[5] = v1[1]; bv[6] = v1[2]; bv[7] = v1[3];
                    na[j] = __builtin_amdgcn_mfma_f32_16x16x32_bf16(ap[ks], bv, na[j], 0, 0, 0);
                }
            }
#pragma unroll
            for (int r = 0; r < 4; ++r) { const int t = tt * 16 + 4 * g + r;
                const float den = si[r] * nq[r] + ra[r]; const float inv = __builtin_amdgcn_rcpf(fmaxf(fabsf(den), em[r]));
                const float h0 = na[0][r] * inv, h1 = na[1][r] * inv;
                *(LAS bf16_t*)(lds + ML_HS + t * 144 + ((hb + 0) * 16 + li) * 2) = (bf16_t)f2bf(h0);
                *(LAS bf16_t*)(lds + ML_HS + t * 144 + ((hb + 1) * 16 + li) * 2) = (bf16_t)f2bf(h1);
                float sq = h0 * h0 + h1 * h1;
                sq = row16_sum(sq);
                HSQ[t * 2 + (w & 1)] = sq; }
        }
        BAR_LDS();
        u32x4 ogv = (u32x4){0u, 0u, 0u, 0u};
        { const int r = tid >> 3, ch = tid & 7; if (!smp || r < L) ogv = *(const u32x4*)(ogb + (size_t)(t0 + r) * DM + ch * 8); }
        if (tid < L && !dry) HSSb[(size_t)(t0 + tid) * 16] = HSQ[tid * 2] + HSQ[tid * 2 + 1];
        {
            bf16x8 bvw[2], bws[2];
#pragma unroll
            for (int ks = 0; ks < 2; ++ks) {
                const s16x4 v0 = __builtin_amdgcn_ds_read_tr16_b64_v4i16((LAS s16x4*)(lds + ML_VW + (ks * 32 + g * 8 + 0 + q4) * 144 + (vt * 16 + 4 * p4) * 2));
                const s16x4 v1 = __builtin_amdgcn_ds_read_tr16_b64_v4i16((LAS s16x4*)(lds + ML_VW + (ks * 32 + g * 8 + 4 + q4) * 144 + (vt * 16 + 4 * p4) * 2));
                bvw[ks][0] = v0[0]; bvw[ks][1] = v0[1]; bvw[ks][2] = v0[2]; bvw[ks][3] = v0[3]; bvw[ks][4] = v1[0]; bvw[ks][5] = v1[1]; bvw[ks][6] = v1[2]; bvw[ks][7] = v1[3];
                const f32x4 w0 = *(const LAS f32x4*)(WSw + ks * 32 + g * 8), w1 = *(const LAS f32x4*)(WSw + ks * 32 + g * 8 + 4);
                union { u32x4 u; bf16x8 v; } cvt; cvt.u.x = pk2(w0[0], w0[1]); cvt.u.y = pk2(w0[2], w0[3]); cvt.u.z = pk2(w1[0], w1[1]); cvt.u.w = pk2(w1[2], w1[3]);
                if (li != 0) cvt.u = (u32x4){0u, 0u, 0u, 0u};
                bws[ks] = cvt.v; }
            nst[0] = nst[0] * decay; nst[1] = nst[1] * decay;
#pragma unroll
            for (int i = 0; i < 8; ++i) { const int kt = ktb + i; cst[i] = cst[i] * decay;
                const bool mine = ((i >> 1) == (w & 3));
#pragma unroll
                for (int ks = 0; ks < 2; ++ks) {
                    const s16x4 k0 = __builtin_amdgcn_ds_read_tr16_b64_v4i16((LAS s16x4*)(lds + ML_KS + (ks * 32 + g * 8 + 0 + q4) * 528 + (kt * 16 + 4 * p4) * 2));
                    const s16x4 k1 = __builtin_amdgcn_ds_read_tr16_b64_v4i16((LAS s16x4*)(lds + ML_KS + (ks * 32 + g * 8 + 4 + q4) * 528 + (kt * 16 + 4 * p4) * 2));
                    bf16x8 ak; ak[0] = k0[0]; ak[1] = k0[1]; ak[2] = k0[2]; ak[3] = k0[3]; ak[4] = k1[0]; ak[5] = k1[1]; ak[6] = k1[2]; ak[7] = k1[3];
                    cst[i] = __builtin_amdgcn_mfma_f32_16x16x32_bf16(ak, bvw[ks], cst[i], 0, 0, 0);
                    if (mine) nst[i & 1] = __builtin_amdgcn_mfma_f32_16x16x32_bf16(ak, bws[ks], nst[i & 1], 0, 0, 0); }
                u32x2 wv; wv.x = pk2(cst[i][0], cst[i][1]); wv.y = pk2(cst[i][2], cst[i][3]);
                *(LAS u32x2*)(lds + ML_CB + (vt * 16 + li) * 528 + (kt * 16 + 4 * g) * 2) = wv; }
            if (li == 0) {
#pragma unroll
                for (int q = 0; q < 2; ++q) { u32x2 wv; wv.x = pk2(nst[q][0], nst[q][1]); wv.y = pk2(nst[q][2], nst[q][3]);
                    *(LAS u32x2*)(lds + ML_CB + 64 * 528 + ((ktb + i0 + q) * 16 + 4 * g) * 2) = wv; } }
        }
        { const int r = tid >> 3, ch = tid & 7; if ((!smp || r < L) && !dry) { const u32x4 hv = *(const LAS u32x4*)(lds + ML_HS + r * 144 + ch * 16); u32x4 o;
            o.x = pk2(bflo(hv.x) * bflo(ogv.x), bfhi(hv.x) * bfhi(ogv.x)); o.y = pk2(bflo(hv.y) * bflo(ogv.y), bfhi(hv.y) * bfhi(ogv.y));
            o.z = pk2(bflo(hv.z) * bflo(ogv.z), bfhi(hv.z) * bfhi(ogv.z)); o.w = pk2(bflo(hv.w) * bflo(ogv.w), bfhi(hv.w) * bfhi(ogv.w));
            *(u32x4*)(vb + (size_t)(t0 + r) * DM + ch * 8) = o; } }
        BAR_LDS();
        m_state = m_next;
    }
    if (!dry) {
        float* Co = p.out + (smp ? O_CS : O_CP) + (size_t)bh * 65536 + (size_t)(vs * 64 + vt * 16 + li) * 256;
#pragma unroll
        for (int i = 0; i < 8; ++i) *(f32x4*)(Co + (ktb + i) * 16 + 4 * g) = cst[i];
        if (vs == 0) {
            if (li == 0) {
#pragma unroll
                for (int q = 0; q < 2; ++q) *(f32x4*)(p.out + (smp ? O_NS : O_NP) + bh * 256 + (ktb + i0 + q) * 16 + 4 * g) = nst[q]; }
            if (tid == 0) p.out[(smp ? O_MS : O_MP) + bh] = m_state; }
    }
    __syncthreads();
#undef ML_PREFETCH
}

constexpr int RG_XR = 0, RG_XC = 18432, RG_W = 36864, RG_EX = 71680, RG_HC = 72704, RG_ZS = 73216;
__device__ __forceinline__ void rglru_item(const Params& p, LAS unsigned char* lds, int b, int n, int hf, bool smp, bool dry) {
    int tid_ = threadIdx.x; asm volatile("" : "+v"(tid_));
    const int tid = tid_, lane = tid & 63, w = __builtin_amdgcn_readfirstlane(tid >> 6), g = lane >> 4, li = lane & 15;
    unsigned char* ws = p.ws;
    const int L = smp ? DSEQ : SEQ, ntile = smp ? 1 : SEQ / 64;
    const int row0 = smp ? NTP + b * DSEQ : b * SEQ;
    const bf16_t* xbp = (smp ? (const bf16_t*)(ws + WS_SMALL + SM_XB * SMALL_B) + (size_t)(b * DSEQ) * DM : (const bf16_t*)(ws + WS_XB) + (size_t)row0 * DM) + n * 128;
    bf16_t* zbp = (smp ? (bf16_t*)(ws + WS_SMALL + SM_SZB * SMALL_B) + (size_t)(b * DSEQ) * DM : (bf16_t*)(ws + WS_SZB) + (size_t)row0 * DM) + n * 128 + hf * 64;
    const float* cvs = p.in[8] + (size_t)b * 3 * DM + n * 128;
    LAS float* EX = (LAS float*)(lds + RG_EX); LAS float* HC = (LAS float*)(lds + RG_HC);
    for (int id = tid; id < 2 * 64 * 16; id += 512) { const int gt = id >> 10, j = (id >> 4) & 63, ch = id & 15;
        *(LAS u32x4*)(lds + RG_W + (gt * 64 + j) * 272 + ch * 16) = *(const u32x4*)((const bf16_t*)(ws + (gt ? WS_WRXT : WS_WRAT)) + (size_t)n * 16384 + (size_t)(hf * 64 + j) * 128 + ch * 8); }
    const int jt = w & 3, th = w >> 2, jc = jt * 16 + li, chn = n * 128 + hf * 64 + jc;
    const float bra = p.in[18][chn], brx = p.in[20][chn];
    float spl; { const float lm = p.in[21][chn]; spl = fmaxf(-lm, 0.f) + log1pf(__expf(-fabsf(lm))); }
    float gw_[4]; const float gb_ = p.in[16][chn];
#pragma unroll
    for (int j = 0; j < 4; ++j) gw_[j] = p.in[15][j * DM + chn];
    const int c2 = tid & 63, tq = tid >> 6;
    float cw[4][2], cb[2];
#pragma unroll
    for (int j = 0; j < 4; ++j) { cw[j][0] = p.in[15][j * DM + n * 128 + 2 * c2]; cw[j][1] = p.in[15][j * DM + n * 128 + 2 * c2 + 1]; }
    cb[0] = p.in[16][n * 128 + 2 * c2]; cb[1] = p.in[16][n * 128 + 2 * c2 + 1];
    if (tid < 64) { HC[tid] = smp ? p.in[7][b * DM + n * 128 + hf * 64 + tid] : 0.f; }
    u32x4 rx[3], rzv;
    const u32x4 z4 = (u32x4){0u, 0u, 0u, 0u};
#define RG_PREFETCH(tl) do { const int t0_ = (tl) * 64; \
        _Pragma("unroll") for (int i_ = 0; i_ < 3; ++i_) { const int id_ = tid + 512 * i_, r_ = id_ >> 4, ch_ = id_ & 15, tok_ = t0_ - 3 + r_; rx[i_] = z4; \
            if (id_ < 67 * 16) { if (tok_ >= 0 && (!smp || tok_ < L)) rx[i_] = *(const u32x4*)(xbp + (size_t)tok_ * DM + ch_ * 8); \
                else if (tok_ < 0 && smp) { const float* s_ = cvs + (size_t)(tok_ + 3) * DM + ch_ * 8; const f32x4 a_ = *(const f32x4*)s_, b_ = *(const f32x4*)(s_ + 4); \
                    rx[i_].x = pk2(a_[0], a_[1]); rx[i_].y = pk2(a_[2], a_[3]); rx[i_].z = pk2(b_[0], b_[1]); rx[i_].w = pk2(b_[2], b_[3]); } } } \
        { const int r_ = tid >> 3, ch_ = tid & 7; rzv = (!smp || t0_ + r_ < L) ? *(const u32x4*)(zbp + (size_t)(t0_ + r_) * DM + ch_ * 8) : z4; } } while (0)
    RG_PREFETCH(0);
    for (int tl = 0; tl < ntile; ++tl) {
        const int t0 = tl * 64;
#pragma unroll
        for (int i = 0; i < 3; ++i) { const int id = tid + 512 * i, r = id >> 4, ch = id & 15; if (id < 67 * 16) *(LAS u32x4*)(lds + RG_XR + r * 272 + ch * 16) = rx[i]; }
        { const int r = tid >> 3, ch = tid & 7; *(LAS u32x4*)(lds + RG_ZS + (tl & 1) * 9216 + r * 144 + ch * 16) = rzv; }
        BAR_LDS();
        if (tl > 0 && !dry) { const int r = tid >> 3, ch = tid & 7;
            *(u32x4*)(zbp + (size_t)(t0 - 64 + r) * DM + ch * 8) = *(const LAS u32x4*)(lds + RG_ZS + ((tl - 1) & 1) * 9216 + r * 144 + ch * 16); }
        if (tl == ntile - 1 && tid < 192 && !dry) {
            const int j = tid >> 6, c = tid & 63, rr = (L - t0) + j;
            p.out[(smp ? O_CVS : O_CVP) + ((size_t)b * 3 + j) * DM + n * 128 + hf * 64 + c] = bf2f(*(const LAS bf16_t*)(lds + RG_XR + rr * 272 + (hf * 64 + c) * 2));
        }
        if (tl + 1 < ntile) RG_PREFETCH(tl + 1);
        { float x0[3], x1[3];
#pragma unroll
          for (int j = 0; j < 3; ++j) { const unsigned wv = *(const LAS unsigned*)(lds + RG_XR + (tq * 8 + j) * 272 + c2 * 4); x0[j] = bflo(wv); x1[j] = bfhi(wv); }
#pragma unroll
          for (int i = 0; i < 8; ++i) { const int t = tq * 8 + i; const unsigned wv = *(const LAS unsigned*)(lds + RG_XR + (t + 3) * 272 + c2 * 4); const float n0 = bflo(wv), n1 = bfhi(wv);
              const float y0 = cb[0] + cw[0][0] * x0[0] + cw[1][0] * x0[1] + cw[2][0] * x0[2] + cw[3][0] * n0;
              const float y1 = cb[1] + cw[0][1] * x1[0] + cw[1][1] * x1[1] + cw[2][1] * x1[2] + cw[3][1] * n1;
              x0[0] = x0[1]; x0[1] = x0[2]; x0[2] = n0; x1[0] = x1[1]; x1[1] = x1[2]; x1[2] = n1;
              *(LAS unsigned*)(lds + RG_XC + t * 272 + c2 * 4) = pk2(y0, y1); } }
        BAR_LDS();
        float av[2][4], bv[2][4], TA[2], TB[2], EA[2], EB[2];
        {
            bf16x8 wr_[4], wi_[4];
#pragma unroll
            for (int kk = 0; kk < 4; ++kk) { wr_[kk] = *(const LAS bf16x8*)(lds + RG_W + jc * 272 + (kk * 32 + g * 8) * 2); wi_[kk] = *(const LAS bf16x8*)(lds + RG_W + (64 + jc) * 272 + (kk * 32 + g * 8) * 2); }
#pragma unroll
            for (int q = 0; q < 2; ++q) { const int tt = 2 * th + q;
                f32x4 ar = (f32x4){0.f, 0.f, 0.f, 0.f}, ai = (f32x4){0.f, 0.f, 0.f, 0.f};
#pragma unroll
                for (int kk = 0; kk < 4; ++kk) { const bf16x8 ax = *(const LAS bf16x8*)(lds + RG_XC + (tt * 16 + li) * 272 + (kk * 32 + g * 8) * 2);
                    ar = __builtin_amdgcn_mfma_f32_16x16x32_bf16(ax, wr_[kk], ar, 0, 0, 0); ai = __builtin_amdgcn_mfma_f32_16x16x32_bf16(ax, wi_[kk], ai, 0, 0, 0); }
                float xw[7];
#pragma unroll
                for (int k = 0; k < 7; ++k) xw[k] = bf2f(*(const LAS bf16_t*)(lds + RG_XR + (tt * 16 + 4 * g + k) * 272 + (hf * 64 + jc) * 2));
                float A4 = 1.f, B4 = 0.f;
#pragma unroll
                for (int r = 0; r < 4; ++r) { const int t = tt * 16 + 4 * g + r;
                    const float xc = gb_ + gw_[0] * xw[r] + gw_[1] * xw[r + 1] + gw_[2] * xw[r + 2] + gw_[3] * xw[r + 3];
                    const float rg = sigm(ar[r] + bra), ig = sigm(ai[r] + brx);
                    const float la = -8.0f * rg * spl; const float a = __expf(la);
                    const float x2 = 2.0f * la;
                    const float pm = x2 * (1.0f + x2 * (0.5f + x2 * (0.16666667f + x2 * (0.041666668f + x2 * (0.0083333338f + x2 * (0.0013888889f + x2 * 0.0001984127f))))));
                    const float om = (x2 > -0.5f) ? -pm : 1.0f - __expf(x2);
                    float mult = __builtin_amdgcn_sqrtf(om); if (!smp && (t0 + t) == 0) mult = 1.0f;
                    const float bt = mult * ig * xc;
                    av[q][r] = a; bv[q][r] = bt; B4 = a * B4 + bt; A4 *= a; }
                { const float pA = __shfl_up(A4, 16), pB = __shfl_up(B4, 16); if (g >= 1) { B4 = A4 * pB + B4; A4 = A4 * pA; } }
                { const float pA = __shfl_up(A4, 32), pB = __shfl_up(B4, 32); if (g >= 2) { B4 = A4 * pB + B4; A4 = A4 * pA; } }
                { const float pA = __shfl_up(A4, 16), pB = __shfl_up(B4, 16); EA[q] = (g >= 1) ? pA : 1.f; EB[q] = (g >= 1) ? pB : 0.f; }
                TA[q] = __shfl(A4, 48 + li); TB[q] = __shfl(B4, 48 + li);
            }
            { EX[(th * 64 + jc) * 2] = TA[0] * TA[1]; EX[(th * 64 + jc) * 2 + 1] = TA[1] * TB[0] + TB[1]; }
        }
        BAR_LDS();
        {
            float hin = HC[(tl & 1) * 64 + jc];
            if (th == 1) hin = EX[jc * 2] * hin + EX[jc * 2 + 1];
            if (th == 1) HC[((tl + 1) & 1) * 64 + jc] = (TA[0] * TA[1]) * hin + (TA[1] * TB[0] + TB[1]);
#pragma unroll
            for (int q = 0; q < 2; ++q) { const int tt = 2 * th + q;
                float hcur = EA[q] * hin + EB[q];
#pragma unroll
                for (int r = 0; r < 4; ++r) { const int tok = t0 + tt * 16 + 4 * g + r;
                    hcur = av[q][r] * hcur + bv[q][r];
                    { LAS bf16_t* zp = (LAS bf16_t*)(lds + RG_ZS + (tl & 1) * 9216 + (tt * 16 + 4 * g + r) * 144 + jc * 2); *zp = (bf16_t)f2bf(bf2f(*zp) * hcur); }
                    if ((!smp || tok < L) && !dry && tok == L - 1) p.out[(smp ? O_HS : O_HP) + (size_t)b * DM + chn] = hcur; }
                hin = TA[q] * hin + TB[q];
            }
        }
    }
    BAR_LDS();
    if (!dry) { const int r = tid >> 3, ch = tid & 7, tlast = (ntile - 1) * 64;
        if (tlast + r < L) *(u32x4*)(zbp + (size_t)(tlast + r) * DM + ch * 8) = *(const LAS u32x4*)(lds + RG_ZS + ((ntile - 1) & 1) * 9216 + r * 144 + ch * 16); }
    __syncthreads();
#undef RG_PREFETCH
}

__device__ __forceinline__ void phase3(const Params& p, LAS unsigned char* lds) {
    const int G = gridDim.x;
    for (int it = blockIdx.x; it < 256; it += G) { const int bh = (it & 7) * 8 + (it >> 5), vs = (it >> 3) & 3; mlstm_item(p, lds, bh >> 2, bh & 3, vs, false, false); }
    for (int it = blockIdx.x; it < 256; it += G) { const int q = (it & 7) * 16 + (it >> 4), hf = (it >> 3) & 1; rglru_item(p, lds, q >> 3, q & 7, hf, false, false); }
    for (int it = blockIdx.x; it < 128; it += G) mlstm_item(p, lds, it >> 4, (it >> 2) & 3, it & 3, true, false);
    for (int it = blockIdx.x; it < 256; it += G) if (it >= 128) { const int q = it - 128; rglru_item(p, lds, q >> 4, (q >> 1) & 7, q & 1, true, false); }
}

__device__ __forceinline__ void phase4(const Params& p) {
    unsigned char* ws = p.ws;
    TV YA{(bf16_t*)(ws + WS_V), (bf16_t*)(ws + WS_SMALL + SM_V * SMALL_B)}, OG{(bf16_t*)(ws + WS_OG), (bf16_t*)(ws + WS_SMALL + SM_OG * SMALL_B)};
    const float* HSS = (const float*)(ws + WS_HSS); const float* gh = p.in[14];
    for (int id = blockIdx.x * 512 + threadIdx.x; id < NTT * 128; id += gridDim.x * 512) {
        const int row = id >> 7, ch = id & 127, hd = ch >> 5;
        const f32x4 hs = *(const f32x4*)(HSS + (size_t)row * 16 + hd * 4);
        const float rs = rsqrtf(((hs[0] + hs[1]) + (hs[2] + hs[3])) * (1.0f / 256.0f) + EPS);
        bf16_t* yp = tv_row(YA, row) + ch * 8; const bf16_t* op = tv_row(OG, row) + ch * 8;
        const u32x4 hv = *(const u32x4*)yp, ov = *(const u32x4*)op; const f32x4 g0 = *(const f32x4*)(gh + ch * 8), g1 = *(const f32x4*)(gh + ch * 8 + 4);
        u32x4 o;
        o.x = pk2(bflo(hv.x) * bflo(ov.x) * rs * g0[0], bfhi(hv.x) * bfhi(ov.x) * rs * g0[1]);
        o.y = pk2(bflo(hv.y) * bflo(ov.y) * rs * g0[2], bfhi(hv.y) * bfhi(ov.y) * rs * g0[3]);
        o.z = pk2(bflo(hv.z) * bflo(ov.z) * rs * g1[0], bfhi(hv.z) * bfhi(ov.z) * rs * g1[1]);
        o.w = pk2(bflo(hv.w) * bflo(ov.w) * rs * g1[2], bfhi(hv.w) * bfhi(ov.w) * rs * g1[3]);
        *(u32x4*)yp = o;
    }
}

__device__ __forceinline__ void phase7(const Params& p) {
    const int lane = threadIdx.x & 63, wave = threadIdx.x >> 6;
    const float* rowss = (const float*)(p.ws + WS_ROWSS); const float* gf = p.in[27];
    f32x4 gv[4];
#pragma unroll
    for (int j = 0; j < 4; ++j) gv[j] = *(const f32x4*)(gf + 4 * lane + 256 * j);
    const bf16_t* ybf = (const bf16_t*)(p.ws + WS_V);
    const int gw = blockIdx.x * 8 + wave, NGW = gridDim.x * 8;
    for (int r0 = gw; r0 < NTP; r0 += 4 * NGW) {
        u32x2 w[4][4]; float part[4];
#pragma unroll
        for (int q = 0; q < 4; ++q) { const int row = r0 + q * NGW; const bool ok = row < NTP; const int rr = ok ? row : r0;
#pragma unroll
            for (int j = 0; j < 4; ++j) w[q][j] = *(const u32x2*)(ybf + (size_t)rr * DM + 4 * lane + 256 * j);
            part[q] = lane < 16 ? rowss[(size_t)rr * 16 + lane] : 0.f; }
#pragma unroll
        for (int q = 0; q < 4; ++q) { const int row = r0 + q * NGW; if (row < NTP) {
            const float rs = rsqrtf(wave_sum(part[q]) * (1.0f / DM) + EPS);
            float* yr = p.out + O_YP + (size_t)row * DM;
#pragma unroll
            for (int j = 0; j < 4; ++j) { const f32x4 v = (f32x4){bflo(w[q][j].x), bfhi(w[q][j].x), bflo(w[q][j].y), bfhi(w[q][j].y)}; *(f32x4*)(yr + 4 * lane + 256 * j) = v * rs * gv[j]; } } }
    }
    for (int row = gw; row < NTS; row += NGW) {
        float* yr = p.out + O_YS + (size_t)row * DM;
        f32x4 v[4]; float part = 0.f;
#pragma unroll
        for (int j = 0; j < 4; ++j) { v[j] = *(const f32x4*)(yr + 4 * lane + 256 * j); part += (v[j][0] * v[j][0] + v[j][1] * v[j][1]) + (v[j][2] * v[j][2] + v[j][3] * v[j][3]); }
        const float rs = rsqrtf(wave_sum(part) * (1.0f / DM) + EPS);
#pragma unroll
        for (int j = 0; j < 4; ++j) *(f32x4*)(yr + 4 * lane + 256 * j) = v[j] * rs * gv[j];
    }
}

__global__ void __launch_bounds__(512) fwd_kernel(Params p) {
    extern __shared__ __attribute__((aligned(16))) unsigned char lds_raw[];
    LAS unsigned char* lds = (LAS unsigned char*)lds_raw;
    unsigned char* ws = p.ws;
    const int lo = p.ph_lo, hi = p.ph_hi;
#ifndef REP2
#define REP2 1
#define REP56 1
#define REP01 1
#ifndef PROBE_MODE
#define PROBE_MODE 0
#endif
#endif
#ifndef PH_MASK
#define PH_MASK 255
#endif
#define IN(k) (((PH_MASK >> (k)) & 1) && lo <= (k) && (k) < hi)
    { volatile LAS unsigned* stw = (volatile LAS unsigned*)(lds + LDS_BARW); if (threadIdx.x < 2) stw[threadIdx.x] = 0u; }
    __syncthreads();
    XcdBarrier xbar = xcd_barrier_post((unsigned*)(ws + WS_BAR), (volatile LAS unsigned*)(lds + LDS_BARW));
#define SEAM(k) do { if (IN(k) && IN((k) + 1)) { xcd_barrier(xbar); } } while (0)
    if (p.ph_hi > 1000) cg::this_grid().sync();
    auto small = [&](int i) { return (bf16_t*)(ws + WS_SMALL + (size_t)i * SMALL_B); };
    TV tU{(bf16_t*)(ws + WS_U), small(SM_U)}, tQ{(bf16_t*)p.out, small(SM_Q)}, tK{(bf16_t*)((unsigned char*)p.out + 64 * MiB), small(SM_K)},
       tV{(bf16_t*)(ws + WS_V), small(SM_V)}, tOG{(bf16_t*)(ws + WS_OG), small(SM_OG)}, tXB{(bf16_t*)(ws + WS_XB), small(SM_XB)},
       tSZB{(bf16_t*)(ws + WS_SZB), small(SM_SZB)}, tGA{(bf16_t*)(ws + WS_GA), small(SM_GA)}, tGB{(bf16_t*)(ws + WS_GB), small(SM_GB)};
    if (IN(0)) { phase0(p, lds); } SEAM(0);
    if (IN(1)) { phase1(p, lds); } SEAM(1);
#if REP01 > 1
    phase0(p, lds); cg::this_grid().sync(); phase1(p, lds); cg::this_grid().sync();
#endif
    if (IN(2)) {
        pg8::StaticOrder S; S.init(129, 36, gridDim.x, blockIdx.x);
        Epi1 E{tQ, tK, tV, tOG, tXB, tSZB, tGA, tGB, p.in[23]};
        Prob1 P{tU, (const bf16_t*)(ws + WS_W1T)};
        pg8::gemm_phase(lds, DM, S, E, P);
    } SEAM(2);
    if (IN(3)) { phase3(p, lds); } SEAM(3);
    if (IN(5)) {
        {
            pg8::PairOrder S0; S0.init(128, 4, gridDim.x, blockIdx.x);
            const int ord = threadIdx.x >> 8, rl = threadIdx.x & 255; pg8::Unit u0;
            if (S0.next(2 * ord, u0)) { const float* hss = (const float*)(ws + WS_HSS) + (size_t)(u0.pm * 256 + rl) * 16; f32x4 o;
#pragma unroll
                for (int hd = 0; hd < 4; ++hd) { const f32x4 hs = *(const f32x4*)(hss + hd * 4); o[hd] = rsqrtf(((hs[0] + hs[1]) + (hs[2] + hs[3])) * (1.0f / 256.0f) + EPS); }
                *(LAS f32x4*)(lds + RS_OFF + (ord * 256 + rl) * 16) = o; }
            __syncthreads();
        }
        pg8::PairOrder S; S.init(128, 4, gridDim.x, blockIdx.x);
        Epi2 E{tGA, tGB, tU};
        Prob2 P{tV, tSZB, (const bf16_t*)(ws + WS_WAT), (const bf16_t*)(ws + WS_WBT)};
        pg8::gemm_phase(lds, DM, S, E, P);
        mini_gemm2(p, lds);
#if REP56 > 1
        cg::this_grid().sync();
        pg8::gemm_phase(lds, DM, S, E, P);
#endif
    } SEAM(5);
    if (IN(6)) {
        pg8::StaticOrder S; S.init(128, 4, gridDim.x, blockIdx.x);
        Epi3 E{p.in[0], (bf16_t*)(ws + WS_V), (const float*)(ws + WS_MODG), (float*)(ws + WS_ROWSS)};
        Prob3 P{tU, (const bf16_t*)(ws + WS_WOT)};
        pg8::gemm_phase(lds, DM, S, E, P);
        mini_gemm3(p, lds);
#if REP56 > 1
        cg::this_grid().sync();
        pg8::gemm_phase(lds, DM, S, E, P);
#endif
    } SEAM(6);
    if (IN(7)) { phase7(p); }
#if SYNC_PROBE
    for (int i_ = 0; i_ < 8; ++i_) cg::this_grid().sync();
#endif
#undef IN
#undef SEAM
}

extern "C" void kernel_launch(void* const* d_in, const int* in_sizes, int n_in, void* d_out, int out_size, void* d_ws, size_t ws_size, hipStream_t stream) {
    static int grid = 0;
    if (grid == 0) {
        if (n_in != 28 || out_size != (int)O_END || ws_size < WS_END) { fprintf(stderr, "kernel_launch: unexpected shapes (n_in %d out %d ws %zu)\n", n_in, out_size, ws_size); grid = -1; return; }
        int dev = 0, cus = 0, per_cu = 0;
        hipGetDevice(&dev); hipDeviceGetAttribute(&cus, hipDeviceAttributeMultiprocessorCount, dev);
        hipFuncSetAttribute((const void*)fwd_kernel, hipFuncAttributeMaxDynamicSharedMemorySize, LDS_BYTES);
        hipOccupancyMaxActiveBlocksPerMultiprocessor(&per_cu, (const void*)fwd_kernel, 512, LDS_BYTES);
        if (per_cu < 1) { fprintf(stderr, "kernel_launch: occupancy query says %d blocks per CU\n", per_cu); grid = -1; return; }
        grid = cus;
        (void)hipGetLastError();
    }
    if (grid < 0) return;
    Params p{};
    for (int i = 0; i < 28; ++i) p.in[i] = (const float*)d_in[i];
    p.out = (float*)d_out; p.ws = (unsigned char*)d_ws; p.probe = PROBE_MODE;
#if MK_ONE_LAUNCH
    if (hipMemsetAsync((char*)d_ws + WS_BAR, 0, 16384, stream) != hipSuccess) { fprintf(stderr, "kernel_launch: memset of the barrier words failed\n"); return; }
    p.ph_lo = 0; p.ph_hi = 8;
    void* args[] = {&p};
    hipError_t e = hipLaunchCooperativeKernel((const void*)fwd_kernel, dim3(grid), dim3(512), args, LDS_BYTES, stream);
    if (e != hipSuccess) fprintf(stderr, "cooperative launch failed: %s (grid %d)\n", hipGetErrorString(e), grid);
#else
    for (int k = 0; k < 8; ++k) { p.ph_lo = k; p.ph_hi = k + 1; hipLaunchKernelGGL(fwd_kernel, dim3(grid), dim3(512), LDS_BYTES, stream, p); }
#endif
}
```

```cpp
#include <hip/hip_runtime.h>
#include <hip/hip_cooperative_groups.h>
#include <cstdio>
#include <cstdint>
namespace cg = cooperative_groups;

#ifndef GEMM_DRAIN
#define GEMM_DRAIN 0
#endif
#ifndef SYNC_PROBE
#define SYNC_PROBE 0
#endif
#ifndef MK_ONE_LAUNCH
#define MK_ONE_LAUNCH 1
#endif

#define LAS __attribute__((address_space(3)))
typedef unsigned short bf16_t;
typedef short bf16x8 __attribute__((ext_vector_type(8)));
typedef short s16x4 __attribute__((ext_vector_type(4)));
typedef float f32x4 __attribute__((ext_vector_type(4)));
typedef unsigned u32x4 __attribute__((ext_vector_type(4)));
typedef unsigned u32x2 __attribute__((ext_vector_type(2)));

constexpr int DM = 1024, NTP = 32768, NTS = 128, NTT = NTP + NTS, SEQ = 2048, DSEQ = 16;
constexpr int DIN = 7176;
constexpr float EPS = 1e-6f;
constexpr size_t MiB = 1u << 20;
constexpr size_t WS_U = 0 * MiB, WS_V = 64 * MiB, WS_OG = 128 * MiB, WS_XB = 192 * MiB, WS_SZB = 256 * MiB, WS_GA = 320 * MiB, WS_GB = 384 * MiB;
constexpr size_t WS_W1T = 448 * MiB, WS_WAT = 466 * MiB, WS_WBT = 468 * MiB, WS_WOT = 470 * MiB, WS_WRAT = 472 * MiB, WS_WRXT = 472 * MiB + 256 * 1024;
constexpr size_t WS_SMALL = 473 * MiB, SMALL_B = 512 * 1024;
enum { SM_U = 0, SM_Q, SM_K, SM_V, SM_OG, SM_XB, SM_SZB, SM_GA, SM_GB, SM_N };
constexpr size_t WS_IF = 478 * MiB, WS_HSS = 480 * MiB, WS_ROWSS = 483 * MiB, WS_MODP = 486 * MiB, WS_WIF = 488 * MiB, WS_BAR = 489 * MiB, WS_END = 490 * MiB, WS_MODG = 487 * MiB + 256 * 1024;
constexpr size_t O_YP = 0, O_YS = 33554432, O_CP = 33685504, O_NP = 37879808, O_MP = 37896192, O_HP = 37896256, O_CVP = 37912640,
                 O_CS = 37961792, O_NS = 40058944, O_MS = 40067136, O_HS = 40067168, O_CVS = 40075360, O_END = 40099936;
constexpr int LDS_BYTES = 151552, LDS_BARW = 151040, RS_OFF = 131072, PF_OFF = 139264;

struct Params { const float* in[28]; float* out; unsigned char* ws; int ph_lo, ph_hi, probe, pad; };

typedef float f32x2_t __attribute__((ext_vector_type(2)));
typedef __bf16 bf16x2_t __attribute__((ext_vector_type(2)));
__device__ __forceinline__ unsigned pk2(float lo, float hi) { f32x2_t v = {lo, hi}; bf16x2_t b = __builtin_convertvector(v, bf16x2_t); return __builtin_bit_cast(unsigned, b); }
__device__ __forceinline__ unsigned f2bf(float f) { return pk2(f, 0.f) & 0xffffu; }
__device__ __forceinline__ float bf2f(unsigned b) { return __uint_as_float(b << 16); }
__device__ __forceinline__ float bflo(unsigned w) { return __uint_as_float(w << 16); }
__device__ __forceinline__ float bfhi(unsigned w) { return __uint_as_float(w & 0xffff0000u); }
__device__ __forceinline__ float sigm(float x) { return __builtin_amdgcn_rcpf(1.0f + __expf(-x)); }
__device__ __forceinline__ float wave_sum_bperm(float v) {
#pragma unroll
    for (int o = 1; o < 64; o <<= 1) v += __shfl_xor(v, o);
    return v;
}

template <int CTRL, int ROWMASK> __device__ __forceinline__ float dpp_f(float oldv, float src) {
    return __builtin_bit_cast(float, __builtin_amdgcn_update_dpp(__builtin_bit_cast(int, oldv), __builtin_bit_cast(int, src), CTRL, ROWMASK, 0xf, false)); }
__device__ __forceinline__ float row16_sum(float v) {
    v += dpp_f<0xB1, 0xf>(0.f, v); v += dpp_f<0x4E, 0xf>(0.f, v); v += dpp_f<0x124, 0xf>(0.f, v); v += dpp_f<0x128, 0xf>(0.f, v); return v; }
__device__ __forceinline__ float wave_sum(float v) {
    v = row16_sum(v);
    const int iv = __builtin_bit_cast(int, v);
    const float r0 = __builtin_bit_cast(float, __builtin_amdgcn_readlane(iv, 0)), r1 = __builtin_bit_cast(float, __builtin_amdgcn_readlane(iv, 16));
    const float r2 = __builtin_bit_cast(float, __builtin_amdgcn_readlane(iv, 32)), r3 = __builtin_bit_cast(float, __builtin_amdgcn_readlane(iv, 48));
    return (r0 + r1) + (r2 + r3);
}
__device__ __forceinline__ float wave_scan_add(float v) {
    v += dpp_f<0x111, 0xf>(0.f, v); v += dpp_f<0x112, 0xf>(0.f, v); v += dpp_f<0x114, 0xf>(0.f, v); v += dpp_f<0x118, 0xf>(0.f, v);
    v += dpp_f<0x142, 0xa>(0.f, v); v += dpp_f<0x143, 0xc>(0.f, v); return v; }
__device__ __forceinline__ float wave_scan_max(float v) {
    const float ninf = -INFINITY;
    v = fmaxf(v, dpp_f<0x111, 0xf>(ninf, v)); v = fmaxf(v, dpp_f<0x112, 0xf>(ninf, v)); v = fmaxf(v, dpp_f<0x114, 0xf>(ninf, v)); v = fmaxf(v, dpp_f<0x118, 0xf>(ninf, v));
    v = fmaxf(v, dpp_f<0x142, 0xa>(ninf, v)); v = fmaxf(v, dpp_f<0x143, 0xc>(ninf, v)); return v; }
#define LDS_WAIT() asm volatile("s_waitcnt lgkmcnt(0)" ::: "memory")
#define BAR_LDS() do { asm volatile("s_waitcnt lgkmcnt(0)" ::: "memory"); __builtin_amdgcn_s_barrier(); asm volatile("" ::: "memory"); } while (0)

namespace pg8 {
constexpr int BM = 256, BK = 64, HALF = 128, HTB = HALF * BK * 2, STAGE_BYTES = 8 * HTB, NXCD = 8, WGM = 8;
__host__ __device__ __forceinline__ int lds_byte(int r, int c) { const int st = (r >> 4) * 2 + (c >> 5), rr = r & 15, cc = c & 31, ob = rr * 64 + cc * 2; return st * 1024 + (ob ^ (((ob >> 9) & 1) << 5)); }
__host__ __device__ __forceinline__ void stage_rc(int b, int& R, int& C) { const int st = b / 1024, sb = b % 1024, swz = sb ^ (((sb >> 9) & 1) << 5); R = (st >> 1) * 16 + swz / 64; C = (st & 1) * 32 + (swz % 64) / 2; }
__host__ __device__ __forceinline__ int perm32(int rho) { const int n = rho >> 4, i = rho & 15; return 8 * (i >> 2) + 4 * n + (i & 3); }

struct Unit { int pm, pn, sub, slot; };
struct StaticOrder {
    int nM, nN, nwg, G, c;
    __device__ void init(int nM_, int nN_, int G_, int c_) { nM = nM_; nN = nN_; nwg = nM * nN; G = G_; c = c_; }
    __device__ bool tile(int i, Unit& u) const {
        const long L = (long)i * G + c; if (L >= nwg) return false;
        int wgid = (int)L; { const int q = nwg / NXCD, r = nwg % NXCD, xcd = wgid % NXCD, off = wgid / NXCD; wgid = (xcd < r ? xcd * (q + 1) : r * (q + 1) + (xcd - r) * q) + off; }
        const int nig = WGM * nN, gid = wgid / nig, fm = gid * WGM, gsz = (nM - fm) < WGM ? (nM - fm) : WGM;
        u.pm = fm + ((wgid % nig) % gsz); u.pn = (wgid % nig) / gsz; u.sub = 0; u.slot = 0; return true;
    }
    __device__ bool next(int i, Unit& u) const { return tile(i, u); }
};
struct PairOrder : StaticOrder {
    __device__ bool next(int i, Unit& u) const { if (!tile(i >> 1, u)) return false; u.sub = i & 1; u.slot = (i >> 1) & 1; return true; }
};
__device__ __forceinline__ unsigned cvt_pk_bf16(float lo, float hi) { return pk2(lo, hi); }

template <class Epi, class Sched, class Prob>
__device__ __forceinline__ void gemm_phase(LAS unsigned char* lds, const int K, const Sched& S, const Epi& E, const Prob& P) {
    const int tid = threadIdx.x, wid = __builtin_amdgcn_readfirstlane(tid >> 6), lane = tid & 63, wr = wid >> 2, wc = wid & 3, fr = lane & 15, fq = lane >> 4;
    const int nt = K / BK;
    unsigned voffA[2], voffB[2];
#pragma unroll
    for (int i = 0; i < 2; ++i) { int R, C; stage_rc(tid * 16 + i * 8192, R, C); const int Rb = Epi::PERM ? ((R & ~31) + perm32(R & 31)) : R;
        voffA[i] = (unsigned)(R * K + C) * 2u; voffB[i] = (unsigned)(Rb * K + C) * 2u; }
    const size_t kstep = (size_t)(BK * 2);
    const size_t hstep = (size_t)HALF * K * 2;
    const unsigned ldsw = (unsigned)wid * 1024u;
    const int aoff = lds_byte(wr * 64 + fr, fq * 8), boff = lds_byte(wc * 32 + fr, fq * 8);
#define PG8_SA(b, h) (((b) * 2 + (h)) * HTB)
#define PG8_SB(b, h) ((4 + (b) * 2 + (h)) * HTB)
#define PG8_STAGE(bufoff, gbase, voff) do { _Pragma("unroll") for (int _i = 0; _i < 2; ++_i) \
        __builtin_amdgcn_global_load_lds((const unsigned*)((const char*)(gbase) + (voff)[_i]), (LAS unsigned*)(lds + (bufoff) + ldsw + _i * 8192), 16, 0, 0); } while (0)
#define PG8_LDA(dst, b, h) do { _Pragma("unroll") for (int m = 0; m < 4; ++m) _Pragma("unroll") for (int k = 0; k < 2; ++k) dst[m][k] = *(const LAS bf16x8*)(lds + PG8_SA(b, h) + aoff + m * 2048 + k * 1024); } while (0)
#define PG8_LDB(dst, b, h) do { _Pragma("unroll") for (int n = 0; n < 2; ++n) _Pragma("unroll") for (int k = 0; k < 2; ++k) dst[n][k] = *(const LAS bf16x8*)(lds + PG8_SB(b, h) + boff + n * 2048 + k * 1024); } while (0)
#define PG8_MMA(ai, bj, At, Bt) do { __builtin_amdgcn_sched_barrier(0); _Pragma("unroll") for (int m = 0; m < 4; ++m) _Pragma("unroll") for (int n = 0; n < 2; ++n) _Pragma("unroll") for (int k = 0; k < 2; ++k) \
        acc[ai][bj][m][n] = __builtin_amdgcn_mfma_f32_16x16x32_bf16(Bt[n][k], At[m][k], acc[ai][bj][m][n], 0, 0, 0); __builtin_amdgcn_sched_barrier(0); } while (0)
#define PG8_WAIT_V(n) asm volatile("s_waitcnt vmcnt(" #n ")" ::: "memory")
#define PG8_WAIT_L(n) asm volatile("s_waitcnt lgkmcnt(" #n ")" ::: "memory")
#define PG8_BAR __builtin_amdgcn_s_barrier()
#define PG8_SCHED __builtin_amdgcn_sched_barrier(0)
    Unit cur, nxt; int ui = 0;
    if (!S.next(0, cur)) return;
    f32x4 acc[2][2][4][2];
#pragma unroll
    for (int a = 0; a < 2; ++a)
#pragma unroll
        for (int b = 0; b < 2; ++b)
#pragma unroll
            for (int m = 0; m < 4; ++m)
#pragma unroll
                for (int n = 0; n < 2; ++n) acc[a][b][m][n] = (f32x4){0.f, 0.f, 0.f, 0.f};
    bf16x8 At[4][2], B0[2][2], B1[2][2];
    const char* cA = P.a(cur); const char* cB = P.b(cur);
    PG8_STAGE(PG8_SB(0, 0), cB, voffB); PG8_STAGE(PG8_SA(0, 0), cA, voffA); PG8_STAGE(PG8_SB(0, 1), cB + hstep, voffB); PG8_STAGE(PG8_SA(0, 1), cA + hstep, voffA);
    if (wr == 1) PG8_BAR;
    PG8_WAIT_V(4); PG8_BAR;
    PG8_STAGE(PG8_SB(1, 0), cB + kstep, voffB); PG8_STAGE(PG8_SA(1, 0), cA + kstep, voffA); PG8_STAGE(PG8_SB(1, 1), cB + hstep + kstep, voffB);
    PG8_WAIT_V(6); PG8_BAR;
    for (;;) {
        const bool has_next = S.next(ui + 1, nxt);
        const char* nA = has_next ? P.a(nxt) : cA; const char* nB = has_next ? P.b(nxt) : cB;
        for (int t = 0; t < nt; t += 2) {
            const bool last = (t == nt - 2);
#if GEMM_DRAIN
            PG8_WAIT_V(0);
#endif
            E.mid(acc, cur, t, wr, fr, lds);
            const char* a1 = cA + (size_t)(t + 1) * kstep;
            const char* a2 = last ? nA : cA + (size_t)(t + 2) * kstep; const char* b2 = last ? nB : cB + (size_t)(t + 2) * kstep;
            const char* a3 = a2 + kstep; const char* b3 = b2 + kstep;
            PG8_LDB(B0, 0, 0); PG8_SCHED; PG8_LDA(At, 0, 0); PG8_STAGE(PG8_SA(1, 1), a1 + hstep, voffA);
            PG8_WAIT_L(8); PG8_BAR; PG8_WAIT_L(0); PG8_MMA(0, 0, At, B0); PG8_BAR; PG8_SCHED;
            PG8_LDB(B1, 0, 1); PG8_STAGE(PG8_SB(0, 0), b2, voffB);
            PG8_BAR; PG8_WAIT_L(0); PG8_MMA(0, 1, At, B1); PG8_BAR;
            PG8_LDA(At, 0, 1); PG8_STAGE(PG8_SA(0, 0), a2, voffA);
            PG8_BAR; PG8_WAIT_L(0); PG8_MMA(1, 0, At, B0); PG8_BAR; PG8_SCHED;
            PG8_STAGE(PG8_SB(0, 1), b2 + hstep, voffB);
            PG8_WAIT_V(6); PG8_BAR; PG8_MMA(1, 1, At, B1); PG8_BAR;
            PG8_LDB(B0, 1, 0); PG8_SCHED; PG8_LDA(At, 1, 0); PG8_STAGE(PG8_SA(0, 1), a2 + hstep, voffA);
            PG8_WAIT_L(8); PG8_BAR; PG8_WAIT_L(0); PG8_MMA(0, 0, At, B0); PG8_BAR; PG8_SCHED;
            PG8_LDB(B1, 1, 1); PG8_STAGE(PG8_SB(1, 0), b3, voffB);
            PG8_BAR; PG8_WAIT_L(0); PG8_MMA(0, 1, At, B1); PG8_BAR;
            PG8_LDA(At, 1, 1); PG8_STAGE(PG8_SA(1, 0), a3, voffA);
            PG8_BAR; PG8_WAIT_L(0); PG8_MMA(1, 0, At, B0); PG8_BAR; PG8_SCHED;
            PG8_STAGE(PG8_SB(1, 1), b3 + hstep, voffB);
            PG8_WAIT_V(6); PG8_BAR; PG8_MMA(1, 1, At, B1); PG8_BAR;
        }
        E(acc, cur, wr, wc, fr, fq, lds);
        if (!has_next) break;
        cur = nxt; cA = nA; cB = nB; ++ui;
    }
    PG8_WAIT_V(0);
    if (wr == 0) PG8_BAR;
    PG8_BAR;
#undef PG8_SA
#undef PG8_SB
#undef PG8_STAGE
#undef PG8_LDA
#undef PG8_LDB
#undef PG8_MMA
#undef PG8_WAIT_V
#undef PG8_WAIT_L
#undef PG8_BAR
#undef PG8_SCHED
}
#define ACC_ZERO(acc) do { _Pragma("unroll") for (int a_ = 0; a_ < 2; ++a_) _Pragma("unroll") for (int b_ = 0; b_ < 2; ++b_) _Pragma("unroll") for (int m_ = 0; m_ < 4; ++m_) _Pragma("unroll") for (int n_ = 0; n_ < 2; ++n_) acc[a_][b_][m_][n_] = (f32x4){0.f, 0.f, 0.f, 0.f}; } while (0)
}


#define XB_TMO      128
#define XB_XCNT(j)  (256  + 64 * (j))
#define XB_XSUB(j)  (1280 + 64 * (j))
#define XB_XGEN(j)  (2304 + 64 * (j))
#define XB_TOP      3328
#define XB_TOPGEN   3392
#define XCD_BAR_WORDS 3456
#define XB_SPIN_CAP (1u << 18)

__device__ __forceinline__ unsigned xb_ld(unsigned* p)              { return __hip_atomic_load(p, __ATOMIC_RELAXED, __HIP_MEMORY_SCOPE_AGENT); }
__device__ __forceinline__ unsigned xb_add(unsigned* p, unsigned v) { return __hip_atomic_fetch_add(p, v, __ATOMIC_RELAXED, __HIP_MEMORY_SCOPE_AGENT); }
__device__ __forceinline__ unsigned xb_xcc_id() { return (unsigned)__builtin_amdgcn_s_getreg((3 << 11) | 20) & 0xFu; }
#define XB_SPIN(cond, bar) do { unsigned _sp = 0; while (cond) { __builtin_amdgcn_s_sleep(1); \
    if ((++_sp & 255u) == 0u) { if (xb_ld(&(bar)[XB_TMO])) break; if (_sp > XB_SPIN_CAP) { atomicAdd(&(bar)[XB_TMO], 1u); break; } } } } while (0)

struct XcdBarrier {
    unsigned* bar; unsigned x;
    volatile LAS unsigned* st;
};

__device__ __forceinline__ XcdBarrier xcd_barrier_post(unsigned* bar, volatile LAS unsigned* st) {
    XcdBarrier b; b.bar = bar; b.x = xb_xcc_id(); b.st = st;
    if (threadIdx.x == 0) (void)xb_add(&bar[XB_XCNT(b.x)], 1u);
    return b;
}
__device__ __forceinline__ void xcd_barrier_complete(unsigned* bar, unsigned x, unsigned& nloc, unsigned& nx) {
    const unsigned G = gridDim.x * gridDim.y * gridDim.z;
    unsigned sum, cnt, mine, sp = 0u;
    for (;;) {
        sum = 0u; cnt = 0u; mine = 0u;
#pragma unroll
        for (unsigned j = 0; j < 16; ++j) { const unsigned c = xb_ld(&bar[XB_XCNT(j)]); sum += c; cnt += (c > 0u) ? 1u : 0u; mine = (j == x) ? c : mine; }
        if (sum == G) break;
        __builtin_amdgcn_s_sleep(1);
        if ((++sp & 255u) == 0u) { if (xb_ld(&bar[XB_TMO])) break; if (sp > XB_SPIN_CAP) { atomicAdd(&bar[XB_TMO], 1u); break; } }
    }
    nloc = mine > 0u ? mine : 1u; nx = cnt > 0u ? cnt : 1u;
}

__device__ __forceinline__ void xcd_barrier(const XcdBarrier& b) {
    asm volatile("s_waitcnt vmcnt(0)" ::: "memory");
    __syncthreads();
    if (threadIdx.x == 0) {
        unsigned* bar = b.bar;
        __builtin_amdgcn_s_waitcnt(0);
        unsigned nloc = b.st[0], nx = b.st[1];
        if (nloc == 0u) { xcd_barrier_complete(bar, b.x, nloc, nx); b.st[0] = nloc; b.st[1] = nx; }
        const unsigned old = xb_add(&bar[XB_XSUB(b.x)], 1u);
        const unsigned gen = old / nloc;
        if (old + 1u == (gen + 1u) * nloc) {
            __builtin_amdgcn_fence(__ATOMIC_RELEASE, "agent");
            asm volatile("s_waitcnt vmcnt(0)" ::: "memory");
            const unsigned og = xb_add(&bar[XB_TOP], 1u);
            const unsigned tg = og / nx;
            if (og + 1u == (tg + 1u) * nx) xb_add(&bar[XB_TOPGEN], 1u);
            else XB_SPIN(xb_ld(&bar[XB_TOPGEN]) == tg, bar);
            __builtin_amdgcn_fence(__ATOMIC_ACQUIRE, "agent");
            xb_add(&bar[XB_XGEN(b.x)], 1u);
            asm volatile("s_waitcnt vmcnt(0)" ::: "memory");
        } else {
            XB_SPIN(xb_ld(&bar[XB_XGEN(b.x)]) == gen, bar);
            __builtin_amdgcn_fence(__ATOMIC_ACQUIRE, "agent");
            asm volatile("s_waitcnt vmcnt(0)" ::: "memory");
        }
    }
    __syncthreads();
}


struct TV { bf16_t* big; bf16_t* sm; };
__device__ __forceinline__ bf16_t* tv_tile(const TV& t, int pm) { return pm < 128 ? t.big + (size_t)pm * 256 * DM : t.sm; }
__device__ __forceinline__ bf16_t* tv_row(const TV& t, int row) { return row < NTP ? t.big + (size_t)row * DM : t.sm + (size_t)(row - NTP) * DM; }

struct Epi1 {
    static constexpr bool PERM = true;
    __device__ __forceinline__ void mid(f32x4 (&)[2][2][4][2], const pg8::Unit&, int, int, int, LAS unsigned char*) const {}
    TV Q, K, V, OG, XB, SZB, GA, GB; const float* b_gate;
    __device__ __forceinline__ void operator()(f32x4 (&acc)[2][2][4][2], const pg8::Unit& u, int wr, int wc, int fr, int fq, LAS unsigned char* lds) const {
        const int pn = u.pn; int type, colt; TV tv; const float* bias = nullptr;
        if (pn < 4) { type = 0; tv = Q; colt = pn * 256; }
        else if (pn < 8) { type = 1; tv = K; colt = (pn - 4) * 256; }
        else if (pn < 12) { type = 0; tv = V; colt = (pn - 8) * 256; }
        else if (pn < 20) { type = 2; tv = OG; colt = (pn - 12) * 128; }
        else if (pn < 24) { type = 0; tv = XB; colt = (pn - 20) * 256; }
        else if (pn < 28) { type = 3; tv = SZB; colt = (pn - 24) * 256; }
        else { type = 4; tv = GA; colt = (pn - 28) * 128; bias = b_gate + colt; }
        bf16_t* base = tv_tile(tv, u.pm);
        const int nai = (u.pm < 128) ? 2 : 1;
        const int cl = wc * 32 + 8 * fq;
        if (type == 2) {
#pragma unroll
            for (int ai = 0; ai < 2; ++ai) if (ai < nai)
#pragma unroll
                for (int m = 0; m < 4; ++m) {
                    bf16_t* rowp = base + (size_t)(ai * 128 + wr * 64 + m * 16 + fr) * DM + colt + cl;
                    float v[8];
#pragma unroll
                    for (int n = 0; n < 2; ++n)
#pragma unroll
                        for (int j = 0; j < 4; ++j) { const float o = acc[ai][0][m][n][j], z = acc[ai][1][m][n][j]; v[n * 4 + j] = sigm(o) * z * sigm(z); }
                    u32x4 w; w.x = pg8::cvt_pk_bf16(v[0], v[1]); w.y = pg8::cvt_pk_bf16(v[2], v[3]); w.z = pg8::cvt_pk_bf16(v[4], v[5]); w.w = pg8::cvt_pk_bf16(v[6], v[7]);
                    *(u32x4*)rowp = w;
                }
        } else if (type == 4) {
            f32x4 bv[2][2];
#pragma unroll
            for (int bj = 0; bj < 2; ++bj)
#pragma unroll
                for (int n = 0; n < 2; ++n) bv[bj][n] = *(const f32x4*)(bias + bj * 1024 + cl + 4 * n);
            bf16_t* baseb = tv_tile(GB, u.pm);
#pragma unroll
            for (int ai = 0; ai < 2; ++ai) if (ai < nai)
#pragma unroll
                for (int m = 0; m < 4; ++m) {
                    const size_t ro = (size_t)(ai * 128 + wr * 64 + m * 16 + fr) * DM + colt + cl;
                    float vr[8], vg[8];
#pragma unroll
                    for (int n = 0; n < 2; ++n)
#pragma unroll
                        for (int j = 0; j < 4; ++j) { const float ea = __expf(-(acc[ai][0][m][n][j] + bv[0][n][j])), eb = __expf(-fmaxf(acc[ai][1][m][n][j] + bv[1][n][j], -30.f));
                            vg[n * 4 + j] = __builtin_amdgcn_rcpf(1.0f + eb); vr[n * 4 + j] = (1.0f + eb) * __builtin_amdgcn_rcpf(1.0f + ea); }
                    u32x4 w; w.x = pg8::cvt_pk_bf16(vr[0], vr[1]); w.y = pg8::cvt_pk_bf16(vr[2], vr[3]); w.z = pg8::cvt_pk_bf16(vr[4], vr[5]); w.w = pg8::cvt_pk_bf16(vr[6], vr[7]);
                    *(u32x4*)(base + ro) = w;
                    w.x = pg8::cvt_pk_bf16(vg[0], vg[1]); w.y = pg8::cvt_pk_bf16(vg[2], vg[3]); w.z = pg8::cvt_pk_bf16(vg[4], vg[5]); w.w = pg8::cvt_pk_bf16(vg[6], vg[7]);
                    *(u32x4*)(baseb + ro) = w;
                }
        } else {
            const float sc = (type == 1) ? 0.0625f : 1.0f; const bool silu = (type == 3);
#pragma unroll
            for (int ai = 0; ai < 2; ++ai) if (ai < nai)
#pragma unroll
                for (int m = 0; m < 4; ++m) {
                    bf16_t* rowp = base + (size_t)(ai * 128 + wr * 64 + m * 16 + fr) * DM + colt + cl;
#pragma unroll
                    for (int bj = 0; bj < 2; ++bj) {
                        float v[8];
#pragma unroll
                        for (int n = 0; n < 2; ++n)
#pragma unroll
                            for (int j = 0; j < 4; ++j) { float x = acc[ai][bj][m][n][j] * sc; if (silu) x = x * sigm(x); v[n * 4 + j] = x; }
                        u32x4 w; w.x = pg8::cvt_pk_bf16(v[0], v[1]); w.y = pg8::cvt_pk_bf16(v[2], v[3]); w.z = pg8::cvt_pk_bf16(v[4], v[5]); w.w = pg8::cvt_pk_bf16(v[6], v[7]);
                        *(u32x4*)(rowp + bj * 128) = w;
                    }
                }
        }
        ACC_ZERO(acc);
    }
};
struct Prob1 { TV U; const bf16_t* W;
    __device__ __forceinline__ const char* a(const pg8::Unit& u) const { return (const char*)tv_tile(U, u.pm); }
    __device__ __forceinline__ const char* b(const pg8::Unit& u) const { return (const char*)(W + (size_t)u.pn * 256 * DM); } };

struct Epi2 {
    static constexpr bool PERM = true;
    __device__ __forceinline__ void mid(f32x4 (&acc)[2][2][4][2], const pg8::Unit& u, int t, int wr, int fr, LAS unsigned char* lds) const {
        if (u.sub != 0 || t == 0 || (t & 3) != 0) return;
        const int hd = t >> 2;
        const LAS float* RS = (const LAS float*)(lds + RS_OFF) + u.slot * 1024;
#pragma unroll
        for (int ai = 0; ai < 2; ++ai)
#pragma unroll
            for (int m = 0; m < 4; ++m) { const int rl = ai * 128 + wr * 64 + m * 16 + fr;
                const float ratio = RS[rl * 4 + hd - 1] * __builtin_amdgcn_rcpf(RS[rl * 4 + hd]);
#pragma unroll
                for (int bj = 0; bj < 2; ++bj)
#pragma unroll
                    for (int n = 0; n < 2; ++n) acc[ai][bj][m][n] = acc[ai][bj][m][n] * ratio; }
    }
    TV GA, GB, MG;
    __device__ __forceinline__ void operator()(f32x4 (&acc)[2][2][4][2], const pg8::Unit& u, int wr, int wc, int fr, int fq, LAS unsigned char* lds) const {
        const bf16_t* ga = tv_tile(GA, u.pm); const bf16_t* gb = tv_tile(GB, u.pm); bf16_t* mg = tv_tile(MG, u.pm);
        {
            int t_ = threadIdx.x; asm volatile("" : "+v"(t_));
            const unsigned off0 = (unsigned)(((t_ >> 6) * 32 + (t_ & 63) / 4) << 11) + (unsigned)((t_ & 3) << 7);
            const char* gbt = (const char*)(gb + u.pn * 256); const char* gat = (const char*)(ga + u.pn * 256);
#pragma unroll
            for (int q = 0; q < 2; ++q) __builtin_amdgcn_global_load_lds((const unsigned*)((u.sub == 0 ? gat : gbt) + off0 + q * 32768u), (LAS unsigned*)(lds + PF_OFF), 16, 0, 0);
        }
        const int nai = (u.pm < 128) ? 2 : 1;
        const int col0 = u.pn * 256 + wc * 32 + 8 * fq;
#pragma unroll
        for (int ai = 0; ai < 2; ++ai) if (ai < nai)
#pragma unroll
            for (int m = 0; m < 4; ++m) {
                const size_t ro = (size_t)(ai * 128 + wr * 64 + m * 16 + fr) * DM + col0;
                const float rs3 = ((const LAS float*)(lds + RS_OFF))[u.slot * 1024 + (ai * 128 + wr * 64 + m * 16 + fr) * 4 + 3];
#pragma unroll
                for (int bj = 0; bj < 2; ++bj) {
                    const u32x4 gbw = *(const u32x4*)((u.sub == 0 ? ga : gb) + ro + bj * 128);
                    float gbv[8] = {bflo(gbw.x), bfhi(gbw.x), bflo(gbw.y), bfhi(gbw.y), bflo(gbw.z), bfhi(gbw.z), bflo(gbw.w), bfhi(gbw.w)};
                    if (u.sub == 0) {
#pragma unroll
                        for (int n = 0; n < 2; ++n)
#pragma unroll
                            for (int j = 0; j < 4; ++j) acc[ai][bj][m][n][j] *= rs3 * gbv[n * 4 + j];
                    } else {
                        float v[8];
#pragma unroll
                        for (int n = 0; n < 2; ++n)
#pragma unroll
                            for (int j = 0; j < 4; ++j) v[n * 4 + j] = acc[ai][bj][m][n][j] * gbv[n * 4 + j];
                        u32x4 w; w.x = pg8::cvt_pk_bf16(v[0], v[1]); w.y = pg8::cvt_pk_bf16(v[2], v[3]); w.z = pg8::cvt_pk_bf16(v[4], v[5]); w.w = pg8::cvt_pk_bf16(v[6], v[7]);
                        *(u32x4*)(mg + ro + bj * 128) = w;
                    }
                }
            }
        if (u.sub == 1) ACC_ZERO(acc);
    }
};
struct Prob2 { TV YA, YB; const bf16_t* WA; const bf16_t* WB;
    __device__ __forceinline__ const char* a(const pg8::Unit& u) const { return (const char*)tv_tile(u.sub ? YB : YA, u.pm); }
    __device__ __forceinline__ const char* b(const pg8::Unit& u) const { return (const char*)((u.sub ? WB : WA) + (size_t)u.pn * 256 * DM); } };

struct Epi3 {
    static constexpr bool PERM = true;
    __device__ __forceinline__ void mid(f32x4 (&)[2][2][4][2], const pg8::Unit&, int, int, int, LAS unsigned char*) const {}
    const float* xp; bf16_t* yb; const float* modg; float* rowss;
    __device__ __forceinline__ void operator()(f32x4 (&acc)[2][2][4][2], const pg8::Unit& u, int wr, int wc, int fr, int fq, LAS unsigned char* lds) const {
        const int col0 = u.pn * 256 + wc * 32 + 8 * fq;
        const float* xb = xp + (size_t)u.pm * 256 * DM;
        int t_ = threadIdx.x; asm volatile("" : "+v"(t_));
        const int rl_ = (t_ >> 8) * 64 + (t_ & 15);
        {
            const char* xt = (const char*)(xb + u.pn * 256);
            const unsigned off0 = (unsigned)(((t_ >> 6) * 32 + (t_ & 63) / 8) << 12) + (unsigned)((t_ & 7) << 7);
#pragma unroll
            for (int q = 0; q < 4; ++q) __builtin_amdgcn_global_load_lds((const unsigned*)(xt + off0 + q * 32768u), (LAS unsigned*)(lds + PF_OFF), 16, 0, 0);
        }
        bf16_t* ob = yb + (size_t)u.pm * 256 * DM;
        const float* gp = modg + (u.pm >> 3) * DM + col0;
#pragma unroll
        for (int ai = 0; ai < 2; ++ai)
#pragma unroll
            for (int m = 0; m < 4; ++m) {
                const int rl = ai * 128 + wr * 64 + m * 16 + fr;
                const size_t ro = (size_t)rl * DM + col0;
                float ss = 0.f;
#pragma unroll
                for (int bj = 0; bj < 2; ++bj) {
                    const f32x4 y0 = *(const f32x4*)(xb + ro + bj * 128) + *(const f32x4*)(gp + bj * 128) * acc[ai][bj][m][0];
                    const f32x4 y1 = *(const f32x4*)(xb + ro + bj * 128 + 4) + *(const f32x4*)(gp + bj * 128 + 4) * acc[ai][bj][m][1];
                    ss += ((y0[0] * y0[0] + y0[1] * y0[1]) + (y0[2] * y0[2] + y0[3] * y0[3])) + ((y1[0] * y1[0] + y1[1] * y1[1]) + (y1[2] * y1[2] + y1[3] * y1[3]));
                    u32x4 w; w.x = pk2(y0[0], y0[1]); w.y = pk2(y0[2], y0[3]); w.z = pk2(y1[0], y1[1]); w.w = pk2(y1[2], y1[3]);
                    *(u32x4*)(ob + ro + bj * 128) = w;
                }
                ss += __shfl_xor(ss, 16); ss += __shfl_xor(ss, 32);
                if (fq == 0) rowss[((size_t)u.pm * 256 + ai * 128 + m * 16 + rl_) * 16 + u.pn * 4 + (t_ >> 6 & 3)] = ss;
            }
        ACC_ZERO(acc);
    }
};
struct Prob3 { TV MG; const bf16_t* WO;
    __device__ __forceinline__ const char* a(const pg8::Unit& u) const { return (const char*)tv_tile(MG, u.pm); }
    __device__ __forceinline__ const char* b(const pg8::Unit& u) const { return (const char*)(WO + (size_t)u.pn * 256 * DM); } };


__device__ __forceinline__ void mini_gemm2(const Params& p, LAS unsigned char* lds) {
    const int lane = threadIdx.x & 63, wave = threadIdx.x >> 6, g = lane >> 4, li = lane & 15, tsel = wave >> 2, ksl = wave & 3;
    unsigned char* ws = p.ws;
    const bf16_t* ya = (const bf16_t*)(ws + WS_SMALL + SM_V * SMALL_B); const bf16_t* yb = (const bf16_t*)(ws + WS_SMALL + SM_SZB * SMALL_B);
    const bf16_t* ga = (const bf16_t*)(ws + WS_SMALL + SM_GA * SMALL_B); const bf16_t* gb = (const bf16_t*)(ws + WS_SMALL + SM_GB * SMALL_B);
    bf16_t* mg = (bf16_t*)(ws + WS_SMALL + SM_U * SMALL_B);
    const bf16_t* wa = (const bf16_t*)(ws + WS_WAT); const bf16_t* wb = (const bf16_t*)(ws + WS_WBT);
    LAS float* red = (LAS float*)lds;
    for (int t0 = blockIdx.x * 2; t0 < 512; t0 += gridDim.x * 2) {
        const int wt = t0 + tsel, r0 = (wt >> 6) * 16, c0 = (wt & 63) * 16;
        const bf16_t* pa = ya + (size_t)(r0 + li) * DM + ksl * 256 + 8 * g; const bf16_t* pb = yb + (size_t)(r0 + li) * DM + ksl * 256 + 8 * g;
        const bf16_t* qa = wa + (size_t)(c0 + li) * DM + ksl * 256 + 8 * g; const bf16_t* qb = wb + (size_t)(c0 + li) * DM + ksl * 256 + 8 * g;
        f32x4 a1 = (f32x4){0.f, 0.f, 0.f, 0.f}, a2 = (f32x4){0.f, 0.f, 0.f, 0.f};
#pragma unroll
        for (int k0 = 0; k0 < 256; k0 += 32) {
            a1 = __builtin_amdgcn_mfma_f32_16x16x32_bf16(*(const bf16x8*)(pa + k0), *(const bf16x8*)(qa + k0), a1, 0, 0, 0);
            a2 = __builtin_amdgcn_mfma_f32_16x16x32_bf16(*(const bf16x8*)(pb + k0), *(const bf16x8*)(qb + k0), a2, 0, 0, 0);
        }
        { const float* hss = (const float*)(ws + WS_HSS);
#pragma unroll
          for (int r = 0; r < 4; ++r) { const f32x4 hs = *(const f32x4*)(hss + (size_t)(NTP + r0 + 4 * g + r) * 16 + ksl * 4);
              a1[r] *= rsqrtf(((hs[0] + hs[1]) + (hs[2] + hs[3])) * (1.0f / 256.0f) + EPS); } }
        *(LAS f32x4*)(red + (wave * 64 + lane) * 8) = a1; *(LAS f32x4*)(red + (wave * 64 + lane) * 8 + 4) = a2;
        __syncthreads();
        if (ksl == 0) {
#pragma unroll
            for (int q = 1; q < 4; ++q) { a1 += *(const LAS f32x4*)(red + ((wave + q) * 64 + lane) * 8); a2 += *(const LAS f32x4*)(red + ((wave + q) * 64 + lane) * 8 + 4); }
#pragma unroll
            for (int r = 0; r < 4; ++r) { const size_t o = (size_t)(r0 + 4 * g + r) * DM + c0 + li;
                mg[o] = (bf16_t)f2bf(bf2f(gb[o]) * (bf2f(ga[o]) * a1[r] + a2[r])); }
        }
        __syncthreads();
    }
}
__device__ __forceinline__ void mini_gemm3(const Params& p, LAS unsigned char* lds) {
    const int lane = threadIdx.x & 63, wave = threadIdx.x >> 6, g = lane >> 4, li = lane & 15, tsel = wave >> 2, ksl = wave & 3;
    unsigned char* ws = p.ws;
    const bf16_t* mg = (const bf16_t*)(ws + WS_SMALL + SM_U * SMALL_B); const bf16_t* wo = (const bf16_t*)(ws + WS_WOT);
    const float* modg = (const float*)(ws + WS_MODG);
    LAS float* red = (LAS float*)lds;
    for (int t0 = blockIdx.x * 2; t0 < 512; t0 += gridDim.x * 2) {
        const int wt = t0 + tsel, r0 = (wt >> 6) * 16, c0 = (wt & 63) * 16;
        const bf16_t* pa = mg + (size_t)(r0 + li) * DM + ksl * 256 + 8 * g; const bf16_t* qa = wo + (size_t)(c0 + li) * DM + ksl * 256 + 8 * g;
        f32x4 a1 = (f32x4){0.f, 0.f, 0.f, 0.f};
#pragma unroll
        for (int k0 = 0; k0 < 256; k0 += 32) a1 = __builtin_amdgcn_mfma_f32_16x16x32_bf16(*(const bf16x8*)(pa + k0), *(const bf16x8*)(qa + k0), a1, 0, 0, 0);
        *(LAS f32x4*)(red + (wave * 64 + lane) * 4) = a1;
        __syncthreads();
        if (ksl == 0) {
#pragma unroll
            for (int q = 1; q < 4; ++q) a1 += *(const LAS f32x4*)(red + ((wave + q) * 64 + lane) * 4);
#pragma unroll
            for (int r = 0; r < 4; ++r) { const int row = r0 + 4 * g + r, col = c0 + li;
                p.out[O_YS + (size_t)row * DM + col] = p.in[1][(size_t)row * DM + col] + modg[(16 + (row >> 4)) * DM + col] * a1[r]; }
        }
        __syncthreads();
    }
}

__device__ __forceinline__ void transpose_item(const float* W, int ldw, int col0, int k0, bf16_t* WT, int ldt, int row0, LAS float* scr, int lane, const float* kscale = nullptr) {
#pragma unroll
    for (int i = 0; i < 32; ++i) { const int kk = 2 * i + (lane >> 5); float v = W[(size_t)(k0 + kk) * ldw + col0 + (lane & 31)]; if (kscale) v *= kscale[k0 + kk]; scr[kk * 33 + (lane & 31)] = v; }
    LDS_WAIT(); asm volatile("" ::: "memory");
    const int c = lane & 7;
#pragma unroll
    for (int j = 0; j < 4; ++j) { const int n = (lane >> 3) + 8 * j; const LAS float* s = scr + (8 * c) * 33 + n;
        u32x4 o; o.x = pk2(s[0 * 33], s[1 * 33]); o.y = pk2(s[2 * 33], s[3 * 33]); o.z = pk2(s[4 * 33], s[5 * 33]); o.w = pk2(s[6 * 33], s[7 * 33]);
        *(u32x4*)(WT + (size_t)(row0 + n) * ldt + k0 + 8 * c) = o; }
    LDS_WAIT(); asm volatile("" ::: "memory");
}

__device__ __forceinline__ void phase0(const Params& p, LAS unsigned char* lds) {
    const int tid = threadIdx.x, lane = tid & 63, wave = tid >> 6, G = gridDim.x;
    unsigned char* ws = p.ws;
    for (int it = blockIdx.x; it < 192; it += G) {
        const int cgp = it % 48, ks = it / 48;
        LAS float* cs = (LAS float*)lds;
        LAS float* red = (LAS float*)(lds + 24576);
        for (int i = tid; i < 24 * 256; i += 512) { const int b = i >> 8, k = i & 255; cs[k * 24 + b] = (b < 16) ? p.in[2][b * DM + ks * 256 + k] : p.in[3][(b - 16) * DM + ks * 256 + k]; }
        __syncthreads();
        const int col = tid & 63, kq = tid >> 6;
        float a[24];
#pragma unroll
        for (int b = 0; b < 24; ++b) a[b] = 0.f;
        const float* wm = p.in[9] + (size_t)(ks * 256 + kq * 32) * 3072 + cgp * 64 + col;
        for (int kb = 0; kb < 32; kb += 8) {
            float wv[8];
#pragma unroll
            for (int i = 0; i < 8; ++i) wv[i] = wm[(size_t)(kb + i) * 3072];
#pragma unroll
            for (int i = 0; i < 8; ++i) {
#pragma unroll
                for (int b = 0; b < 24; ++b) a[b] += cs[(kq * 32 + kb + i) * 24 + b] * wv[i];
                asm volatile("" ::: "memory"); }
        }
#pragma unroll
        for (int b = 0; b < 24; ++b) red[(kq * 24 + b) * 64 + col] = a[b];
        __syncthreads();
        float* modp = (float*)(ws + WS_MODP);
        for (int i = tid; i < 24 * 64; i += 512) { const int b = i >> 6, c = i & 63; float s = 0.f;
#pragma unroll
            for (int q = 0; q < 8; ++q) s += red[(q * 24 + b) * 64 + c];
            modp[((size_t)ks * 24 + b) * 3072 + cgp * 64 + c] = s; }
        __syncthreads();
    }
    { float* wif = (float*)(ws + WS_WIF);
      for (int i = blockIdx.x * 512 + tid; i < 8 * DM; i += G * 512) { const int g = i >> 10, k = i & 1023; wif[i] = p.in[12][(size_t)k * DIN + 5120 + g]; } }
    LAS float* scr = (LAS float*)(lds + wave * 16384);
    const int gw = blockIdx.x * 8 + wave, NGW = G * 8;
    constexpr int I_W1 = 288 * 16, I_SQ = 32 * 16, I_R = 64, NIT = I_W1 + 3 * I_SQ + 2 * I_R;
    for (int it = gw; it < NIT; it += NGW) {
        int r = it;
        if (r < I_W1) {
            const int rg = r >> 4, kb = r & 15, pn = rg >> 3, c0 = (rg & 7) * 32; const float* W; int ldw, col;
            if (pn < 12) { W = p.in[12]; ldw = DIN; col = rg * 32; }
            else if (pn < 20) { W = p.in[12]; ldw = DIN; const int j = pn - 12; col = (c0 < 128) ? 3072 + 128 * j + c0 : 4096 + 128 * j + (c0 - 128); }
            else if (pn < 24) { W = p.in[12]; ldw = DIN; col = 5128 + (rg * 32 - 5120); }
            else if (pn < 28) { W = p.in[12]; ldw = DIN; col = 6152 + (rg * 32 - 6144); }
            else { W = p.in[22]; ldw = 2048; const int j = pn - 28; col = (c0 < 128) ? 128 * j + c0 : 1024 + 128 * j + (c0 - 128); }
            transpose_item(W, ldw, col, kb * 64, (bf16_t*)(ws + WS_W1T), DM, rg * 32, scr, lane); continue; }
        r -= I_W1;
        if (r < 3 * I_SQ) { const int w = r / I_SQ, q = r % I_SQ, rg = q >> 4, kb = q & 15;
            transpose_item(p.in[24 + w], DM, rg * 32, kb * 64, (bf16_t*)(ws + (w == 0 ? WS_WAT : (w == 1 ? WS_WBT : WS_WOT))), DM, rg * 32, scr, lane, w == 0 ? p.in[14] : nullptr); continue; }
        r -= 3 * I_SQ;
        { const int w = r / I_R, q = r % I_R, n = q >> 3, rg = (q >> 1) & 3, kb = q & 1;
          transpose_item(p.in[w ? 19 : 17] + (size_t)n * 16384, 128, rg * 32, kb * 64, (bf16_t*)(ws + (w ? WS_WRXT : WS_WRAT)) + (size_t)n * 16384, 128, rg * 32, scr, lane); }
    }
}

__device__ __forceinline__ void phase1(const Params& p, LAS unsigned char* lds) {
    const int tid = threadIdx.x, lane = tid & 63, wave = tid >> 6, G = gridDim.x;
    unsigned char* ws = p.ws;
    LAS float* wif = (LAS float*)lds;
    { const float* src = (const float*)(ws + WS_WIF); for (int i = tid; i < 8 * DM; i += 512) wif[i] = src[i]; }
    __syncthreads();
    const float* modp = (const float*)(ws + WS_MODP); const float* b_mod = p.in[10]; const float* g_norm = p.in[11]; const float* b_if = p.in[13];
    float* IF = (float*)(ws + WS_IF);
    TV U{(bf16_t*)(ws + WS_U), (bf16_t*)(ws + WS_SMALL + SM_U * SMALL_B)};
    { float* modg = (float*)(ws + WS_MODG);
      for (int i = blockIdx.x * 512 + tid; i < 24 * DM; i += G * 512) { const int b = i >> 10, c = i & 1023; float s = b_mod[2048 + c];
#pragma unroll
          for (int ks = 0; ks < 4; ++ks) s += modp[((size_t)ks * 24 + b) * 3072 + 2048 + c];
          modg[i] = s; } }
    const bool h32 = (lane & 32) != 0, h16 = (lane & 16) != 0, h8 = (lane & 8) != 0;
    const int gi = (h32 ? 4 : 0) + (h16 ? 2 : 0) + (h8 ? 1 : 0);
    const float bif = b_if[gi];
    for (int wi = blockIdx.x * 8 + wave; wi < NTP / 16 + NTS; wi += G * 8) {
        const int row0 = wi < NTP / 16 ? wi * 16 : NTP + (wi - NTP / 16), nrow = wi < NTP / 16 ? 16 : 1;
        const int bidx = row0 < NTP ? (row0 >> 11) : 16 + ((row0 - NTP) >> 4);
        f32x4 sc[4], sh[4];
#pragma unroll
        for (int j = 0; j < 4; ++j) { const int idx = 4 * lane + 256 * j;
            f32x4 s = *(const f32x4*)(b_mod + idx), c = *(const f32x4*)(b_mod + 1024 + idx);
#pragma unroll
            for (int ks = 0; ks < 4; ++ks) { const float* mp = modp + ((size_t)ks * 24 + bidx) * 3072; s += *(const f32x4*)(mp + idx); c += *(const f32x4*)(mp + 1024 + idx); }
            sh[j] = s; sc[j] = *(const f32x4*)(g_norm + idx) * (c + 1.0f); }
        const float* xbase = row0 < NTP ? p.in[0] + (size_t)row0 * DM : p.in[1] + (size_t)(row0 - NTP) * DM;
        f32x4 nv[4];
#pragma unroll
        for (int j = 0; j < 4; ++j) nv[j] = *(const f32x4*)(xbase + 4 * lane + 256 * j);
        for (int r = 0; r < nrow; ++r) {
            const int row = row0 + r;
            f32x4 v[4]; float ss = 0.f;
#pragma unroll
            for (int j = 0; j < 4; ++j) { v[j] = nv[j]; ss += (v[j][0] * v[j][0] + v[j][1] * v[j][1]) + (v[j][2] * v[j][2] + v[j][3] * v[j][3]); }
            if (r + 1 < nrow) {
#pragma unroll
                for (int j = 0; j < 4; ++j) nv[j] = *(const f32x4*)(xbase + (size_t)(r + 1) * DM + 4 * lane + 256 * j); }
            const float rs = rsqrtf(wave_sum(ss) * (1.0f / DM) + EPS);
            bf16_t* ur = tv_row(U, row);
            float d[8];
#pragma unroll
            for (int g = 0; g < 8; ++g) d[g] = 0.f;
#pragma unroll
            for (int j = 0; j < 4; ++j) { v[j] = v[j] * rs * sc[j] + sh[j];
                u32x2 w; w.x = pk2(v[j][0], v[j][1]); w.y = pk2(v[j][2], v[j][3]); *(u32x2*)(ur + 4 * lane + 256 * j) = w;
#pragma unroll
                for (int g = 0; g < 8; ++g) { const f32x4 wv = *(const LAS f32x4*)(wif + g * DM + 4 * lane + 256 * j); d[g] += (v[j][0] * wv[0] + v[j][1] * wv[1]) + (v[j][2] * wv[2] + v[j][3] * wv[3]); } }
            float e[4], f[2], gs;
#pragma unroll
            for (int i = 0; i < 4; ++i) { const float send = h32 ? d[i] : d[i + 4], keep = h32 ? d[i + 4] : d[i]; e[i] = keep + __shfl_xor(send, 32); }
#pragma unroll
            for (int i = 0; i < 2; ++i) { const float send = h16 ? e[i] : e[i + 2], keep = h16 ? e[i + 2] : e[i]; f[i] = keep + __shfl_xor(send, 16); }
            { const float send = h8 ? f[0] : f[1], keep = h8 ? f[1] : f[0]; gs = keep + __shfl_xor(send, 8); }
            gs += __shfl_xor(gs, 4); gs += __shfl_xor(gs, 2); gs += __shfl_xor(gs, 1);
            if ((lane & 7) == 0) { float x = gs + bif;
                if (gi >= 4) x = fminf(x, 0.f) - __logf(1.0f + __expf(-fabsf(x)));
                IF[(size_t)row * 8 + gi] = x; }
        }
    }
}

constexpr int ML_QS = 0, ML_KS = 33792, ML_CB = 67584, ML_VS = 109824, ML_VW = 119040, ML_HS = 128256, ML_F = 137472;
__device__ __forceinline__ void mlstm_item(const Params& p, LAS unsigned char* lds, int b, int h, int vs, bool smp, bool dry) {
    int tid_ = threadIdx.x; asm volatile("" : "+v"(tid_));
    const int tid = tid_, lane = tid & 63, w = __builtin_amdgcn_readfirstlane(tid >> 6), g = lane >> 4, li = lane & 15, q4 = li >> 2, p4 = li & 3;
    unsigned char* ws = p.ws;
    const int L = smp ? DSEQ : 64, nch = smp ? 1 : SEQ / 64;
    const int row0 = smp ? NTP + b * DSEQ : b * SEQ;
    const bf16_t* qb = (smp ? (const bf16_t*)(ws + WS_SMALL + SM_Q * SMALL_B) + (size_t)(b * DSEQ) * DM : (const bf16_t*)(p.out) + (size_t)row0 * DM) + h * 256;
    const bf16_t* kb = (smp ? (const bf16_t*)(ws + WS_SMALL + SM_K * SMALL_B) + (size_t)(b * DSEQ) * DM : (const bf16_t*)((unsigned char*)p.out + 64 * MiB) + (size_t)row0 * DM) + h * 256;
    bf16_t* vb = (smp ? (bf16_t*)(ws + WS_SMALL + SM_V * SMALL_B) + (size_t)(b * DSEQ) * DM : (bf16_t*)(ws + WS_V) + (size_t)row0 * DM) + h * 256 + vs * 64;
    const float* IFb = (const float*)(ws + WS_IF) + (size_t)row0 * 8;
    float* HSSb = (float*)(ws + WS_HSS) + (size_t)row0 * 16 + h * 4 + vs;
    const bf16_t* ogb = (smp ? (const bf16_t*)(ws + WS_SMALL + SM_OG * SMALL_B) + (size_t)(b * DSEQ) * DM : (const bf16_t*)(ws + WS_OG) + (size_t)row0 * DM) + h * 256 + vs * 64;
    LAS float* F = (LAS float*)(lds + ML_F);
    LAS float *IG = F, *LF = F + 64, *HSQ = F + 128;
    LAS float *GGw = F + 264 + 320 * w, *MMw = GGw + 64, *SIw = GGw + 128, *EMw = GGw + 192, *WSw = GGw + 256;
    const int bh = b * 4 + h;
    const int vt = w & 3, ktb = (w >> 2) * 8, i0 = 2 * (w & 3);
    f32x4 cst[8], nst[2];
    float m_state;
    if (smp) {
        const float* C0 = p.in[4] + (size_t)bh * 65536 + (size_t)(vs * 64 + vt * 16 + li) * 256;
#pragma unroll
        for (int i = 0; i < 8; ++i) cst[i] = *(const f32x4*)(C0 + (ktb + i) * 16 + 4 * g);
#pragma unroll
        for (int q = 0; q < 2; ++q) nst[q] = (li == 0) ? *(const f32x4*)(p.in[5] + bh * 256 + (ktb + i0 + q) * 16 + 4 * g) : (f32x4){0.f, 0.f, 0.f, 0.f};
        m_state = p.in[6][bh];
    } else {
#pragma unroll
        for (int i = 0; i < 8; ++i) cst[i] = (f32x4){0.f, 0.f, 0.f, 0.f};
        nst[0] = (f32x4){0.f, 0.f, 0.f, 0.f}; nst[1] = nst[0];
        m_state = 0.f;
    }
#pragma unroll
    for (int i = 0; i < 8; ++i) { u32x2 wv; wv.x = pk2(cst[i][0], cst[i][1]); wv.y = pk2(cst[i][2], cst[i][3]);
        *(LAS u32x2*)(lds + ML_CB + (vt * 16 + li) * 528 + ((ktb + i) * 16 + 4 * g) * 2) = wv; }
    if (li == 0) {
#pragma unroll
        for (int q = 0; q < 2; ++q) { u32x2 wv; wv.x = pk2(nst[q][0], nst[q][1]); wv.y = pk2(nst[q][2], nst[q][3]);
            *(LAS u32x2*)(lds + ML_CB + 64 * 528 + ((ktb + i0 + q) * 16 + 4 * g) * 2) = wv; } }
    u32x4 rq[4], rk[4], rv; float rig = 0.f, rlf = 0.f;
    const u32x4 z4 = (u32x4){0u, 0u, 0u, 0u};
#define ML_PREFETCH(c) do { const int t0_ = (c) * 64; \
        _Pragma("unroll") for (int i_ = 0; i_ < 4; ++i_) { const int id_ = tid + 512 * i_, r_ = id_ >> 5, ch_ = id_ & 31; \
            if (!smp || r_ < L) { rq[i_] = *(const u32x4*)(qb + (size_t)(t0_ + r_) * DM + ch_ * 8); rk[i_] = *(const u32x4*)(kb + (size_t)(t0_ + r_) * DM + ch_ * 8); } else { rq[i_] = z4; rk[i_] = z4; } } \
        { const int r_ = tid >> 3, ch_ = tid & 7; rv = (!smp || r_ < L) ? *(const u32x4*)(vb + (size_t)(t0_ + r_) * DM + ch_ * 8) : z4; } \
        if (tid < 64) { if (!smp || tid < L) { rig = IFb[(size_t)(t0_ + tid) * 8 + h]; rlf = IFb[(size_t)(t0_ + tid) * 8 + 4 + h]; } else { rig = -INFINITY; rlf = 0.f; } } } while (0)
    ML_PREFETCH(0);
    bf16x8 ones; { const short o1 = (short)0x3F80;
#pragma unroll
        for (int j = 0; j < 8; ++j) ones[j] = o1; }
    const int tt = w >> 1, hb = (w & 1) * 2;
    for (int c = 0; c < nch; ++c) {
        const int t0 = c * 64;
#pragma unroll
        for (int i = 0; i < 4; ++i) { const int id = tid + 512 * i, r = id >> 5, ch = id & 31;
            *(LAS u32x4*)(lds + ML_QS + r * 528 + ch * 16) = rq[i]; *(LAS u32x4*)(lds + ML_KS + r * 528 + ch * 16) = rk[i]; }
        const u32x4 vcur = rv;
        { const int r = tid >> 3, ch = tid & 7; *(LAS u32x4*)(lds + ML_VS + r * 144 + ch * 16) = vcur; }
        if (tid < 64) { IG[tid] = rig; LF[tid] = rlf; }
        BAR_LDS();
        if (tt >= 2) __builtin_amdgcn_s_setprio(1);
        if (c + 1 < nch) ML_PREFETCH(c + 1);
        float decay, m_next;
        {
            const float bc = wave_scan_add(LF[lane]);
            const float gs = IG[lane] - bc;
            const float cm = wave_scan_max(gs);
            const float Mt = fmaxf(m_state, cm);
            const float ML_ = __builtin_bit_cast(float, __builtin_amdgcn_readlane(__builtin_bit_cast(int, Mt), 63));
            const float bL = __builtin_bit_cast(float, __builtin_amdgcn_readlane(__builtin_bit_cast(int, bc), 63));
            GGw[lane] = gs; MMw[lane] = Mt; SIw[lane] = __expf(m_state - Mt); EMw[lane] = __expf(-(bc + Mt)); WSw[lane] = __expf(gs - ML_);
            decay = __expf(m_state - ML_); m_next = bL + ML_;
        }
        { const int r = tid >> 3, ch = tid & 7; const float wsr = WSw[r];
          u32x4 o; o.x = pk2(bflo(vcur.x) * wsr, bfhi(vcur.x) * wsr); o.y = pk2(bflo(vcur.y) * wsr, bfhi(vcur.y) * wsr); o.z = pk2(bflo(vcur.z) * wsr, bfhi(vcur.z) * wsr); o.w = pk2(bflo(vcur.w) * wsr, bfhi(vcur.w) * wsr);
          *(LAS u32x4*)(lds + ML_VW + r * 144 + ch * 16) = o; }
        {
            bf16x8 qf[8];
#pragma unroll
            for (int kk = 0; kk < 8; ++kk) qf[kk] = *(const LAS bf16x8*)(lds + ML_QS + (tt * 16 + li) * 528 + (kk * 32 + g * 8) * 2);
            const float mt = MMw[tt * 16 + li];
            const int tq = tt * 16 + li;
            bf16x8 ap[2];
#pragma unroll
            for (int ks = 0; ks < 2; ++ks) {
                float pv[8];
#pragma unroll
                for (int hh = 0; hh < 2; ++hh) { const int st = 2 * ks + hh;
                    if (st <= tt) { f32x4 sa = (f32x4){0.f, 0.f, 0.f, 0.f};
#pragma unroll
                        for (int kk = 0; kk < 8; ++kk) { const bf16x8 kf = *(const LAS bf16x8*)(lds + ML_KS + (st * 16 + li) * 528 + (kk * 32 + g * 8) * 2); sa = __builtin_amdgcn_mfma_f32_16x16x32_bf16(kf, qf[kk], sa, 0, 0, 0); }
                        const f32x4 gv = *(const LAS f32x4*)(GGw + st * 16 + 4 * g);
#pragma unroll
                        for (int r = 0; r < 4; ++r) { const int sidx = st * 16 + 4 * g + r; pv[hh * 4 + r] = (sidx <= tq) ? sa[r] * __expf(gv[r] - mt) : 0.f; }
                    } else {
#pragma unroll
                        for (int r = 0; r < 4; ++r) pv[hh * 4 + r] = 0.f; } }
                union { u32x4 u; bf16x8 v; } cvt; cvt.u.x = pk2(pv[0], pv[1]); cvt.u.y = pk2(pv[2], pv[3]); cvt.u.z = pk2(pv[4], pv[5]); cvt.u.w = pk2(pv[6], pv[7]);
                ap[ks] = cvt.v;
            }
            f32x4 na[2], nq = (f32x4){0.f, 0.f, 0.f, 0.f}, ra = (f32x4){0.f, 0.f, 0.f, 0.f};
            na[0] = (f32x4){0.f, 0.f, 0.f, 0.f}; na[1] = na[0];
#pragma unroll
            for (int kk = 0; kk < 8; ++kk) {
                const bf16x8 c0 = *(const LAS bf16x8*)(lds + ML_CB + ((hb + 0) * 16 + li) * 528 + (kk * 32 + g * 8) * 2);
                const bf16x8 c1 = *(const LAS bf16x8*)(lds + ML_CB + ((hb + 1) * 16 + li) * 528 + (kk * 32 + g * 8) * 2);
                const bf16x8 cn = *(const LAS bf16x8*)(lds + ML_CB + 64 * 528 + (kk * 32 + g * 8) * 2);
                na[0] = __builtin_amdgcn_mfma_f32_16x16x32_bf16(qf[kk], c0, na[0], 0, 0, 0);
                na[1] = __builtin_amdgcn_mfma_f32_16x16x32_bf16(qf[kk], c1, na[1], 0, 0, 0);
                nq = __builtin_amdgcn_mfma_f32_16x16x32_bf16(qf[kk], cn, nq, 0, 0, 0);
            }
            const f32x4 si = *(const LAS f32x4*)(SIw + tt * 16 + 4 * g), em = *(const LAS f32x4*)(EMw + tt * 16 + 4 * g);
            na[0] = na[0] * si; na[1] = na[1] * si;
#pragma unroll
            for (int ks = 0; ks < 2; ++ks) if (2 * ks <= tt) {
                ra = __builtin_amdgcn_mfma_f32_16x16x32_bf16(ap[ks], ones, ra, 0, 0, 0);
#pragma unroll
                for (int j = 0; j < 2; ++j) {
                    const s16x4 v0 = __builtin_amdgcn_ds_read_tr16_b64_v4i16((LAS s16x4*)(lds + ML_VS + (ks * 32 + g * 4 + q4) * 144 + ((hb + j) * 16 + 4 * p4) * 2));
                    const s16x4 v1 = __builtin_amdgcn_ds_read_tr16_b64_v4i16((LAS s16x4*)(lds + ML_VS + (ks * 32 + 16 + g * 4 + q4) * 144 + ((hb + j) * 16 + 4 * p4) * 2));
                    bf16x8 bv; bv[0] = v0[0]; bv[1] = v0[1]; bv[2] = v0[2]; bv[3] = v0[3]; bv[4] = v1[0]; bv[5] = v1[1]; bv[6] = v1[2]; bv[7] = v1[3];
                    na[j] = __builtin_amdgcn_mfma_f32_16x16x32_bf16(ap[ks], bv, na[j], 0, 0, 0);
                }
            }
#pragma unroll
            for (int r = 0; r < 4; ++r) { const int t = tt * 16 + 4 * g + r;
                const float den = si[r] * nq[r] + ra[r]; const float inv = __builtin_amdgcn_rcpf(fmaxf(fabsf(den), em[r]));
                const float h0 = na[0][r] * inv, h1 = na[1][r] * inv;
                *(LAS bf16_t*)(lds + ML_HS + t * 144 + ((hb + 0) * 16 + li) * 2) = (bf16_t)f2bf(h0);
                *(LAS bf16_t*)(lds + ML_HS + t * 144 + ((hb + 1) * 16 + li) * 2) = (bf16_t)f2bf(h1);
                float sq = h0 * h0 + h1 * h1;
                sq = row16_sum(sq);
                HSQ[t * 2 + (w & 1)] = sq; }
        }
        __builtin_amdgcn_s_setprio(0);
        BAR_LDS();
        u32x4 ogv = (u32x4){0u, 0u, 0u, 0u};
        { const int r = tid >> 3, ch = tid & 7; if (!smp || r < L) ogv = *(const u32x4*)(ogb + (size_t)(t0 + r) * DM + ch * 8); }
        if (tid < L && !dry) HSSb[(size_t)(t0 + tid) * 16] = HSQ[tid * 2] + HSQ[tid * 2 + 1];
        {
            bf16x8 bvw[2], bws[2];
#pragma unroll
            for (int ks = 0; ks < 2; ++ks) {
                const s16x4 v0 = __builtin_amdgcn_ds_read_tr16_b64_v4i16((LAS s16x4*)(lds + ML_VW + (ks * 32 + g * 8 + 0 + q4) * 144 + (vt * 16 + 4 * p4) * 2));
                const s16x4 v1 = __builtin_amdgcn_ds_read_tr16_b64_v4i16((LAS s16x4*)(lds + ML_VW + (ks * 32 + g * 8 + 4 + q4) * 144 + (vt * 16 + 4 * p4) * 2));
                bvw[ks][0] = v0[0]; bvw[ks][1] = v0[1]; bvw[ks][2] = v0[2]; bvw[ks][3] = v0[3]; bvw[ks][4] = v1[0]; bvw[ks][5] = v1[1]; bvw[ks][6] = v1[2]; bvw[ks][7] = v1[3];
                const f32x4 w0 = *(const LAS f32x4*)(WSw + ks * 32 + g * 8), w1 = *(const LAS f32x4*)(WSw + ks * 32 + g * 8 + 4);
                union { u32x4 u; bf16x8 v; } cvt; cvt.u.x = pk2(w0[0], w0[1]); cvt.u.y = pk2(w0[2], w0[3]); cvt.u.z = pk2(w1[0], w1[1]); cvt.u.w = pk2(w1[2], w1[3]);
                if (li != 0) cvt.u = (u32x4){0u, 0u, 0u, 0u};
                bws[ks] = cvt.v; }
            nst[0] = nst[0] * decay; nst[1] = nst[1] * decay;
#pragma unroll
            for (int i = 0; i < 8; ++i) { const int kt = ktb + i; cst[i] = cst[i] * decay;
                const bool mine = ((i >> 1) == (w & 3));
#pragma unroll
                for (int ks = 0; ks < 2; ++ks) {
                    const s16x4 k0 = __builtin_amdgcn_ds_read_tr16_b64_v4i16((LAS s16x4*)(lds + ML_KS + (ks * 32 + g * 8 + 0 + q4) * 528 + (kt * 16 + 4 * p4) * 2));
                    const s16x4 k1 = __builtin_amdgcn_ds_read_tr16_b64_v4i16((LAS s16x4*)(lds + ML_KS + (ks * 32 + g * 8 + 4 + q4) * 528 + (kt * 16 + 4 * p4) * 2));
                    bf16x8 ak; ak[0] = k0[0]; ak[1] = k0[1]; ak[2] = k0[2]; ak[3] = k0[3]; ak[4] = k1[0]; ak[5] = k1[1]; ak[6] = k1[2]; ak[7] = k1[3];
                    cst[i] = __builtin_amdgcn_mfma_f32_16x16x32_bf16(ak, bvw[ks], cst[i], 0, 0, 0);
                    if (mine) nst[i & 1] = __builtin_amdgcn_mfma_f32_16x16x32_bf16(ak, bws[ks], nst[i & 1], 0, 0, 0); }
                u32x2 wv; wv.x = pk2(cst[i][0], cst[i][1]); wv.y = pk2(cst[i][2], cst[i][3]);
                *(LAS u32x2*)(lds + ML_CB + (vt * 16 + li) * 528 + (kt * 16 + 4 * g) * 2) = wv; }
            if (li == 0) {
#pragma unroll
                for (int q = 0; q < 2; ++q) { u32x2 wv; wv.x = pk2(nst[q][0], nst[q][1]); wv.y = pk2(nst[q][2], nst[q][3]);
                    *(LAS u32x2*)(lds + ML_CB + 64 * 528 + ((ktb + i0 + q) * 16 + 4 * g) * 2) = wv; } }
        }
        { const int r = tid >> 3, ch = tid & 7; if ((!smp || r < L) && !dry) { const u32x4 hv = *(const LAS u32x4*)(lds + ML_HS + r * 144 + ch * 16); u32x4 o;
            o.x = pk2(bflo(hv.x) * bflo(ogv.x), bfhi(hv.x) * bfhi(ogv.x)); o.y = pk2(bflo(hv.y) * bflo(ogv.y), bfhi(hv.y) * bfhi(ogv.y));
            o.z = pk2(bflo(hv.z) * bflo(ogv.z), bfhi(hv.z) * bfhi(ogv.z)); o.w = pk2(bflo(hv.w) * bflo(ogv.w), bfhi(hv.w) * bfhi(ogv.w));
            *(u32x4*)(vb + (size_t)(t0 + r) * DM + ch * 8) = o; } }
        BAR_LDS();
        m_state = m_next;
    }
    if (!dry) {
        float* Co = p.out + (smp ? O_CS : O_CP) + (size_t)bh * 65536 + (size_t)(vs * 64 + vt * 16 + li) * 256;
#pragma unroll
        for (int i = 0; i < 8; ++i) *(f32x4*)(Co + (ktb + i) * 16 + 4 * g) = cst[i];
        if (vs == 0) {
            if (li == 0) {
#pragma unroll
                for (int q = 0; q < 2; ++q) *(f32x4*)(p.out + (smp ? O_NS : O_NP) + bh * 256 + (ktb + i0 + q) * 16 + 4 * g) = nst[q]; }
            if (tid == 0) p.out[(smp ? O_MS : O_MP) + bh] = m_state; }
    }
    __syncthreads();
#undef ML_PREFETCH
}

constexpr int RG_XR = 0, RG_XC = 18432, RG_W = 36864, RG_EX = 71680, RG_HC = 72704, RG_ZS = 73216;
__device__ __forceinline__ void rglru_item(const Params& p, LAS unsigned char* lds, int b, int n, int hf, bool smp, bool dry) {
    int tid_ = threadIdx.x; asm volatile("" : "+v"(tid_));
    const int tid = tid_, lane = tid & 63, w = __builtin_amdgcn_readfirstlane(tid >> 6), g = lane >> 4, li = lane & 15;
    unsigned char* ws = p.ws;
    const int L = smp ? DSEQ : SEQ, ntile = smp ? 1 : SEQ / 64;
    const int row0 = smp ? NTP + b * DSEQ : b * SEQ;
    const bf16_t* xbp = (smp ? (const bf16_t*)(ws + WS_SMALL + SM_XB * SMALL_B) + (size_t)(b * DSEQ) * DM : (const bf16_t*)(ws + WS_XB) + (size_t)row0 * DM) + n * 128;
    bf16_t* zbp = (smp ? (bf16_t*)(ws + WS_SMALL + SM_SZB * SMALL_B) + (size_t)(b * DSEQ) * DM : (bf16_t*)(ws + WS_SZB) + (size_t)row0 * DM) + n * 128 + hf * 64;
    const float* cvs = p.in[8] + (size_t)b * 3 * DM + n * 128;
    LAS float* EX = (LAS float*)(lds + RG_EX); LAS float* HC = (LAS float*)(lds + RG_HC);
    for (int id = tid; id < 2 * 64 * 16; id += 512) { const int gt = id >> 10, j = (id >> 4) & 63, ch = id & 15;
        *(LAS u32x4*)(lds + RG_W + (gt * 64 + j) * 272 + ch * 16) = *(const u32x4*)((const bf16_t*)(ws + (gt ? WS_WRXT : WS_WRAT)) + (size_t)n * 16384 + (size_t)(hf * 64 + j) * 128 + ch * 8); }
    const int jt = w & 3, th = w >> 2, jc = jt * 16 + li, chn = n * 128 + hf * 64 + jc;
    const float bra = p.in[18][chn], brx = p.in[20][chn];
    float spl; { const float lm = p.in[21][chn]; spl = fmaxf(-lm, 0.f) + log1pf(__expf(-fabsf(lm))); }
    float gw_[4]; const float gb_ = p.in[16][chn];
#pragma unroll
    for (int j = 0; j < 4; ++j) gw_[j] = p.in[15][j * DM + chn];
    const int c2 = tid & 63, tq = tid >> 6;
    float cw[4][2], cb[2];
#pragma unroll
    for (int j = 0; j < 4; ++j) { cw[j][0] = p.in[15][j * DM + n * 128 + 2 * c2]; cw[j][1] = p.in[15][j * DM + n * 128 + 2 * c2 + 1]; }
    cb[0] = p.in[16][n * 128 + 2 * c2]; cb[1] = p.in[16][n * 128 + 2 * c2 + 1];
    if (tid < 64) { HC[tid] = smp ? p.in[7][b * DM + n * 128 + hf * 64 + tid] : 0.f; }
    u32x4 rx[3], rzv;
    const u32x4 z4 = (u32x4){0u, 0u, 0u, 0u};
#define RG_PREFETCH(tl) do { const int t0_ = (tl) * 64; \
        _Pragma("unroll") for (int i_ = 0; i_ < 3; ++i_) { const int id_ = tid + 512 * i_, r_ = id_ >> 4, ch_ = id_ & 15, tok_ = t0_ - 3 + r_; rx[i_] = z4; \
            if (id_ < 67 * 16) { if (tok_ >= 0 && (!smp || tok_ < L)) rx[i_] = *(const u32x4*)(xbp + (size_t)tok_ * DM + ch_ * 8); \
                else if (tok_ < 0 && smp) { const float* s_ = cvs + (size_t)(tok_ + 3) * DM + ch_ * 8; const f32x4 a_ = *(const f32x4*)s_, b_ = *(const f32x4*)(s_ + 4); \
                    rx[i_].x = pk2(a_[0], a_[1]); rx[i_].y = pk2(a_[2], a_[3]); rx[i_].z = pk2(b_[0], b_[1]); rx[i_].w = pk2(b_[2], b_[3]); } } } \
        { const int r_ = tid >> 3, ch_ = tid & 7; rzv = (!smp || t0_ + r_ < L) ? *(const u32x4*)(zbp + (size_t)(t0_ + r_) * DM + ch_ * 8) : z4; } } while (0)
    RG_PREFETCH(0);
    for (int tl = 0; tl < ntile; ++tl) {
        const int t0 = tl * 64;
#pragma unroll
        for (int i = 0; i < 3; ++i) { const int id = tid + 512 * i, r = id >> 4, ch = id & 15; if (id < 67 * 16) *(LAS u32x4*)(lds + RG_XR + r * 272 + ch * 16) = rx[i]; }
        { const int r = tid >> 3, ch = tid & 7; *(LAS u32x4*)(lds + RG_ZS + (tl & 1) * 9216 + r * 144 + ch * 16) = rzv; }
        BAR_LDS();
        if (tl > 0 && !dry) { const int r = tid >> 3, ch = tid & 7;
            *(u32x4*)(zbp + (size_t)(t0 - 64 + r) * DM + ch * 8) = *(const LAS u32x4*)(lds + RG_ZS + ((tl - 1) & 1) * 9216 + r * 144 + ch * 16); }
        if (tl == ntile - 1 && tid < 192 && !dry) {
            const int j = tid >> 6, c = tid & 63, rr = (L - t0) + j;
            p.out[(smp ? O_CVS : O_CVP) + ((size_t)b * 3 + j) * DM + n * 128 + hf * 64 + c] = bf2f(*(const LAS bf16_t*)(lds + RG_XR + rr * 272 + (hf * 64 + c) * 2));
        }
        if (tl + 1 < ntile) RG_PREFETCH(tl + 1);
        { float x0[3], x1[3];
#pragma unroll
          for (int j = 0; j < 3; ++j) { const unsigned wv = *(const LAS unsigned*)(lds + RG_XR + (tq * 8 + j) * 272 + c2 * 4); x0[j] = bflo(wv); x1[j] = bfhi(wv); }
#pragma unroll
          for (int i = 0; i < 8; ++i) { const int t = tq * 8 + i; const unsigned wv = *(const LAS unsigned*)(lds + RG_XR + (t + 3) * 272 + c2 * 4); const float n0 = bflo(wv), n1 = bfhi(wv);
              const float y0 = cb[0] + cw[0][0] * x0[0] + cw[1][0] * x0[1] + cw[2][0] * x0[2] + cw[3][0] * n0;
              const float y1 = cb[1] + cw[0][1] * x1[0] + cw[1][1] * x1[1] + cw[2][1] * x1[2] + cw[3][1] * n1;
              x0[0] = x0[1]; x0[1] = x0[2]; x0[2] = n0; x1[0] = x1[1]; x1[1] = x1[2]; x1[2] = n1;
              *(LAS unsigned*)(lds + RG_XC + t * 272 + c2 * 4) = pk2(y0, y1); } }
        BAR_LDS();
        float av[2][4], bv[2][4], TA[2], TB[2], EA[2], EB[2];
        {
            bf16x8 wr_[4], wi_[4];
#pragma unroll
            for (int kk = 0; kk < 4; ++kk) { wr_[kk] = *(const LAS bf16x8*)(lds + RG_W + jc * 272 + (kk * 32 + g * 8) * 2); wi_[kk] = *(const LAS bf16x8*)(lds + RG_W + (64 + jc) * 272 + (kk * 32 + g * 8) * 2); }
#pragma unroll
            for (int q = 0; q < 2; ++q) { const int tt = 2 * th + q;
                f32x4 ar = (f32x4){0.f, 0.f, 0.f, 0.f}, ai = (f32x4){0.f, 0.f, 0.f, 0.f};
#pragma unroll
                for (int kk = 0; kk < 4; ++kk) { const bf16x8 ax = *(const LAS bf16x8*)(lds + RG_XC + (tt * 16 + li) * 272 + (kk * 32 + g * 8) * 2);
                    ar = __builtin_amdgcn_mfma_f32_16x16x32_bf16(ax, wr_[kk], ar, 0, 0, 0); ai = __builtin_amdgcn_mfma_f32_16x16x32_bf16(ax, wi_[kk], ai, 0, 0, 0); }
                float xw[7];
#pragma unroll
                for (int k = 0; k < 7; ++k) xw[k] = bf2f(*(const LAS bf16_t*)(lds + RG_XR + (tt * 16 + 4 * g + k) * 272 + (hf * 64 + jc) * 2));
                float A4 = 1.f, B4 = 0.f;
#pragma unroll
                for (int r = 0; r < 4; ++r) { const int t = tt * 16 + 4 * g + r;
                    const float xc = gb_ + gw_[0] * xw[r] + gw_[1] * xw[r + 1] + gw_[2] * xw[r + 2] + gw_[3] * xw[r + 3];
                    const float rg = sigm(ar[r] + bra), ig = sigm(ai[r] + brx);
                    const float la = -8.0f * rg * spl; const float a = __expf(la);
                    const float x2 = 2.0f * la;
                    const float pm = x2 * (1.0f + x2 * (0.5f + x2 * (0.16666667f + x2 * (0.041666668f + x2 * (0.0083333338f + x2 * (0.0013888889f + x2 * 0.0001984127f))))));
                    const float om = (x2 > -0.5f) ? -pm : 1.0f - __expf(x2);
                    float mult = __builtin_amdgcn_sqrtf(om); if (!smp && (t0 + t) == 0) mult = 1.0f;
                    const float bt = mult * ig * xc;
                    av[q][r] = a; bv[q][r] = bt; B4 = a * B4 + bt; A4 *= a; }
                { const float pA = __shfl_up(A4, 16), pB = __shfl_up(B4, 16); if (g >= 1) { B4 = A4 * pB + B4; A4 = A4 * pA; } }
                { const float pA = __shfl_up(A4, 32), pB = __shfl_up(B4, 32); if (g >= 2) { B4 = A4 * pB + B4; A4 = A4 * pA; } }
                { const float pA = __shfl_up(A4, 16), pB = __shfl_up(B4, 16); EA[q] = (g >= 1) ? pA : 1.f; EB[q] = (g >= 1) ? pB : 0.f; }
                TA[q] = __shfl(A4, 48 + li); TB[q] = __shfl(B4, 48 + li);
            }
            { EX[(th * 64 + jc) * 2] = TA[0] * TA[1]; EX[(th * 64 + jc) * 2 + 1] = TA[1] * TB[0] + TB[1]; }
        }
        BAR_LDS();
        {
            float hin = HC[(tl & 1) * 64 + jc];
            if (th == 1) hin = EX[jc * 2] * hin + EX[jc * 2 + 1];
            if (th == 1) HC[((tl + 1) & 1) * 64 + jc] = (TA[0] * TA[1]) * hin + (TA[1] * TB[0] + TB[1]);
#pragma unroll
            for (int q = 0; q < 2; ++q) { const int tt = 2 * th + q;
                float hcur = EA[q] * hin + EB[q];
#pragma unroll
                for (int r = 0; r < 4; ++r) { const int tok = t0 + tt * 16 + 4 * g + r;
                    hcur = av[q][r] * hcur + bv[q][r];
                    { LAS bf16_t* zp = (LAS bf16_t*)(lds + RG_ZS + (tl & 1) * 9216 + (tt * 16 + 4 * g + r) * 144 + jc * 2); *zp = (bf16_t)f2bf(bf2f(*zp) * hcur); }
                    if ((!smp || tok < L) && !dry && tok == L - 1) p.out[(smp ? O_HS : O_HP) + (size_t)b * DM + chn] = hcur; }
                hin = TA[q] * hin + TB[q];
            }
        }
    }
    BAR_LDS();
    if (!dry) { const int r = tid >> 3, ch = tid & 7, tlast = (ntile - 1) * 64;
        if (tlast + r < L) *(u32x4*)(zbp + (size_t)(tlast + r) * DM + ch * 8) = *(const LAS u32x4*)(lds + RG_ZS + ((ntile - 1) & 1) * 9216 + r * 144 + ch * 16); }
    __syncthreads();
#undef RG_PREFETCH
}

__device__ __forceinline__ void phase3(const Params& p, LAS unsigned char* lds) {
    const int G = gridDim.x;
    for (int it = blockIdx.x; it < 256; it += G) { const int bh = (it & 7) * 8 + (it >> 5), vs = (it >> 3) & 3; mlstm_item(p, lds, bh >> 2, bh & 3, vs, false, false); }
    for (int it = blockIdx.x; it < 256; it += G) { const int q = (it & 7) * 16 + (it >> 4), hf = (it >> 3) & 1; rglru_item(p, lds, q >> 3, q & 7, hf, false, false); }
    for (int it = blockIdx.x; it < 128; it += G) mlstm_item(p, lds, it >> 4, (it >> 2) & 3, it & 3, true, false);
    for (int it = blockIdx.x; it < 256; it += G) if (it >= 128) { const int q = it - 128; rglru_item(p, lds, q >> 4, (q >> 1) & 7, q & 1, true, false); }
}

__device__ __forceinline__ void phase4(const Params& p) {
    unsigned char* ws = p.ws;
    TV YA{(bf16_t*)(ws + WS_V), (bf16_t*)(ws + WS_SMALL + SM_V * SMALL_B)}, OG{(bf16_t*)(ws + WS_OG), (bf16_t*)(ws + WS_SMALL + SM_OG * SMALL_B)};
    const float* HSS = (const float*)(ws + WS_HSS); const float* gh = p.in[14];
    for (int id = blockIdx.x * 512 + threadIdx.x; id < NTT * 128; id += gridDim.x * 512) {
        const int row = id >> 7, ch = id & 127, hd = ch >> 5;
        const f32x4 hs = *(const f32x4*)(HSS + (size_t)row * 16 + hd * 4);
        const float rs = rsqrtf(((hs[0] + hs[1]) + (hs[2] + hs[3])) * (1.0f / 256.0f) + EPS);
        bf16_t* yp = tv_row(YA, row) + ch * 8; const bf16_t* op = tv_row(OG, row) + ch * 8;
        const u32x4 hv = *(const u32x4*)yp, ov = *(const u32x4*)op; const f32x4 g0 = *(const f32x4*)(gh + ch * 8), g1 = *(const f32x4*)(gh + ch * 8 + 4);
        u32x4 o;
        o.x = pk2(bflo(hv.x) * bflo(ov.x) * rs * g0[0], bfhi(hv.x) * bfhi(ov.x) * rs * g0[1]);
        o.y = pk2(bflo(hv.y) * bflo(ov.y) * rs * g0[2], bfhi(hv.y) * bfhi(ov.y) * rs * g0[3]);
        o.z = pk2(bflo(hv.z) * bflo(ov.z) * rs * g1[0], bfhi(hv.z) * bfhi(ov.z) * rs * g1[1]);
        o.w = pk2(bflo(hv.w) * bflo(ov.w) * rs * g1[2], bfhi(hv.w) * bfhi(ov.w) * rs * g1[3]);
        *(u32x4*)yp = o;
    }
}

__device__ __forceinline__ void phase7(const Params& p) {
    const int lane = threadIdx.x & 63, wave = threadIdx.x >> 6;
    const float* rowss = (const float*)(p.ws + WS_ROWSS); const float* gf = p.in[27];
    f32x4 gv[4];
#pragma unroll
    for (int j = 0; j < 4; ++j) gv[j] = *(const f32x4*)(gf + 4 * lane + 256 * j);
    const bf16_t* ybf = (const bf16_t*)(p.ws + WS_V);
    const int gw = blockIdx.x * 8 + wave, NGW = gridDim.x * 8;
    for (int r0 = gw; r0 < NTP; r0 += 4 * NGW) {
        u32x2 w[4][4]; float part[4];
#pragma unroll
        for (int q = 0; q < 4; ++q) { const int row = r0 + q * NGW; const bool ok = row < NTP; const int rr = ok ? row : r0;
#pragma unroll
            for (int j = 0; j < 4; ++j) w[q][j] = *(const u32x2*)(ybf + (size_t)rr * DM + 4 * lane + 256 * j);
            part[q] = lane < 16 ? rowss[(size_t)rr * 16 + lane] : 0.f; }
#pragma unroll
        for (int q = 0; q < 4; ++q) { const int row = r0 + q * NGW; if (row < NTP) {
            const float rs = rsqrtf(wave_sum(part[q]) * (1.0f / DM) + EPS);
            float* yr = p.out + O_YP + (size_t)row * DM;
#pragma unroll
            for (int j = 0; j < 4; ++j) { const f32x4 v = (f32x4){bflo(w[q][j].x), bfhi(w[q][j].x), bflo(w[q][j].y), bfhi(w[q][j].y)}; *(f32x4*)(yr + 4 * lane + 256 * j) = v * rs * gv[j]; } } }
    }
    for (int row = gw; row < NTS; row += NGW) {
        float* yr = p.out + O_YS + (size_t)row * DM;
        f32x4 v[4]; float part = 0.f;
#pragma unroll
        for (int j = 0; j < 4; ++j) { v[j] = *(const f32x4*)(yr + 4 * lane + 256 * j); part += (v[j][0] * v[j][0] + v[j][1] * v[j][1]) + (v[j][2] * v[j][2] + v[j][3] * v[j][3]); }
        const float rs = rsqrtf(wave_sum(part) * (1.0f / DM) + EPS);
#pragma unroll
        for (int j = 0; j < 4; ++j) *(f32x4*)(yr + 4 * lane + 256 * j) = v[j] * rs * gv[j];
    }
}

__global__ void __launch_bounds__(512) fwd_kernel(Params p) {
    extern __shared__ __attribute__((aligned(16))) unsigned char lds_raw[];
    LAS unsigned char* lds = (LAS unsigned char*)lds_raw;
    unsigned char* ws = p.ws;
    const int lo = p.ph_lo, hi = p.ph_hi;
#ifndef REP2
#define REP2 1
#define REP56 1
#define REP01 1
#ifndef PROBE_MODE
#define PROBE_MODE 0
#endif
#endif
#ifndef PH_MASK
#define PH_MASK 255
#endif
#define IN(k) (((PH_MASK >> (k)) & 1) && lo <= (k) && (k) < hi)
    { volatile LAS unsigned* stw = (volatile LAS unsigned*)(lds + LDS_BARW); if (threadIdx.x < 2) stw[threadIdx.x] = 0u; }
    __syncthreads();
    XcdBarrier xbar = xcd_barrier_post((unsigned*)(ws + WS_BAR), (volatile LAS unsigned*)(lds + LDS_BARW));
#define SEAM(k) do { if (IN(k) && IN((k) + 1)) { xcd_barrier(xbar); } } while (0)
    if (p.ph_hi > 1000) cg::this_grid().sync();
    auto small = [&](int i) { return (bf16_t*)(ws + WS_SMALL + (size_t)i * SMALL_B); };
    TV tU{(bf16_t*)(ws + WS_U), small(SM_U)}, tQ{(bf16_t*)p.out, small(SM_Q)}, tK{(bf16_t*)((unsigned char*)p.out + 64 * MiB), small(SM_K)},
       tV{(bf16_t*)(ws + WS_V), small(SM_V)}, tOG{(bf16_t*)(ws + WS_OG), small(SM_OG)}, tXB{(bf16_t*)(ws + WS_XB), small(SM_XB)},
       tSZB{(bf16_t*)(ws + WS_SZB), small(SM_SZB)}, tGA{(bf16_t*)(ws + WS_GA), small(SM_GA)}, tGB{(bf16_t*)(ws + WS_GB), small(SM_GB)};
    if (IN(0)) { phase0(p, lds); } SEAM(0);
    if (IN(1)) { phase1(p, lds); } SEAM(1);
#if REP01 > 1
    phase0(p, lds); cg::this_grid().sync(); phase1(p, lds); cg::this_grid().sync();
#endif
    if (IN(2)) {
        pg8::StaticOrder S; S.init(129, 36, gridDim.x, blockIdx.x);
        Epi1 E{tQ, tK, tV, tOG, tXB, tSZB, tGA, tGB, p.in[23]};
        Prob1 P{tU, (const bf16_t*)(ws + WS_W1T)};
        pg8::gemm_phase(lds, DM, S, E, P);
    } SEAM(2);
    if (IN(3)) { phase3(p, lds); } SEAM(3);
    if (IN(5)) {
        {
            pg8::PairOrder S0; S0.init(128, 4, gridDim.x, blockIdx.x);
            const int ord = threadIdx.x >> 8, rl = threadIdx.x & 255; pg8::Unit u0;
            if (S0.next(2 * ord, u0)) { const float* hss = (const float*)(ws + WS_HSS) + (size_t)(u0.pm * 256 + rl) * 16; f32x4 o;
#pragma unroll
                for (int hd = 0; hd < 4; ++hd) { const f32x4 hs = *(const f32x4*)(hss + hd * 4); o[hd] = rsqrtf(((hs[0] + hs[1]) + (hs[2] + hs[3])) * (1.0f / 256.0f) + EPS); }
                *(LAS f32x4*)(lds + RS_OFF + (ord * 256 + rl) * 16) = o; }
            __syncthreads();
        }
        pg8::PairOrder S; S.init(128, 4, gridDim.x, blockIdx.x);
        Epi2 E{tGA, tGB, tU};
        Prob2 P{tV, tSZB, (const bf16_t*)(ws + WS_WAT), (const bf16_t*)(ws + WS_WBT)};
        pg8::gemm_phase(lds, DM, S, E, P);
        mini_gemm2(p, lds);
#if REP56 > 1
        cg::this_grid().sync();
        pg8::gemm_phase(lds, DM, S, E, P);
#endif
    } SEAM(5);
    if (IN(6)) {
        pg8::StaticOrder S; S.init(128, 4, gridDim.x, blockIdx.x);
        Epi3 E{p.in[0], (bf16_t*)(ws + WS_V), (const float*)(ws + WS_MODG), (float*)(ws + WS_ROWSS)};
        Prob3 P{tU, (const bf16_t*)(ws + WS_WOT)};
        pg8::gemm_phase(lds, DM, S, E, P);
        mini_gemm3(p, lds);
#if REP56 > 1
        cg::this_grid().sync();
        pg8::gemm_phase(lds, DM, S, E, P);
#endif
    } SEAM(6);
    if (IN(7)) { phase7(p); }
#if SYNC_PROBE
    for (int i_ = 0; i_ < 8; ++i_) cg::this_grid().sync();
#endif
#undef IN
#undef SEAM
}

extern "C" void kernel_launch(void* const* d_in, const int* in_sizes, int n_in, void* d_out, int out_size, void* d_ws, size_t ws_size, hipStream_t stream) {
    static int grid = 0;
    if (grid == 0) {
        if (n_in != 28 || out_size != (int)O_END || ws_size < WS_END) { fprintf(stderr, "kernel_launch: unexpected shapes (n_in %d out %d ws %zu)\n", n_in, out_size, ws_size); grid = -1; return; }
        int dev = 0, cus = 0, per_cu = 0;
        hipGetDevice(&dev); hipDeviceGetAttribute(&cus, hipDeviceAttributeMultiprocessorCount, dev);
        hipFuncSetAttribute((const void*)fwd_kernel, hipFuncAttributeMaxDynamicSharedMemorySize, LDS_BYTES);
        hipOccupancyMaxActiveBlocksPerMultiprocessor(&per_cu, (const void*)fwd_kernel, 512, LDS_BYTES);
        if (per_cu < 1) { fprintf(stderr, "kernel_launch: occupancy query says %d blocks per CU\n", per_cu); grid = -1; return; }
        grid = cus;
        (void)hipGetLastError();
    }
    if (grid < 0) return;
    Params p{};
    for (int i = 0; i < 28; ++i) p.in[i] = (const float*)d_in[i];
    p.out = (float*)d_out; p.ws = (unsigned char*)d_ws; p.probe = PROBE_MODE;
#if MK_ONE_LAUNCH
    if (hipMemsetAsync((char*)d_ws + WS_BAR, 0, 16384, stream) != hipSuccess) { fprintf(stderr, "kernel_launch: memset of the barrier words failed\n"); return; }
    p.ph_lo = 0; p.ph_hi = 8;
    void* args[] = {&p};
    hipError_t e = hipLaunchCooperativeKernel((const void*)fwd_kernel, dim3(grid), dim3(512), args, LDS_BYTES, stream);
    if (e != hipSuccess) fprintf(stderr, "cooperative launch failed: %s (grid %d)\n", hipGetErrorString(e), grid);
#else
    for (int k = 0; k < 8; ++k) { p.ph_lo = k; p.ph_hi = k + 1; hipLaunchKernelGGL(fwd_kernel, dim3(grid), dim3(512), LDS_BYTES, stream, p); }
#endif
}
```

```cpp
#include <hip/hip_runtime.h>
#include <hip/hip_cooperative_groups.h>
#include <cstdio>
#include <cstdint>
namespace cg = cooperative_groups;

#ifndef GEMM_DRAIN
#define GEMM_DRAIN 0
#endif
#ifndef SYNC_PROBE
#define SYNC_PROBE 0
#endif
#ifndef MK_ONE_LAUNCH
#define MK_ONE_LAUNCH 1
#endif

#define LAS __attribute__((address_space(3)))
typedef unsigned short bf16_t;
typedef short bf16x8 __attribute__((ext_vector_type(8)));
typedef short s16x4 __attribute__((ext_vector_type(4)));
typedef float f32x4 __attribute__((ext_vector_type(4)));
typedef unsigned u32x4 __attribute__((ext_vector_type(4)));
typedef unsigned u32x2 __attribute__((ext_vector_type(2)));

constexpr int DM = 1024, NTP = 32768, NTS = 128, NTT = NTP + NTS, SEQ = 2048, DSEQ = 16;
constexpr int DIN = 7176;
constexpr float EPS = 1e-6f;
constexpr size_t MiB = 1u << 20;
constexpr size_t WS_U = 0 * MiB, WS_V = 64 * MiB, WS_OG = 128 * MiB, WS_XB = 192 * MiB, WS_SZB = 256 * MiB, WS_GA = 320 * MiB, WS_GB = 384 * MiB;
constexpr size_t WS_W1T = 448 * MiB, WS_WAT = 466 * MiB, WS_WBT = 468 * MiB, WS_WOT = 470 * MiB, WS_WRAT = 472 * MiB, WS_WRXT = 472 * MiB + 256 * 1024;
constexpr size_t WS_SMALL = 473 * MiB, SMALL_B = 512 * 1024;
enum { SM_U = 0, SM_Q, SM_K, SM_V, SM_OG, SM_XB, SM_SZB, SM_GA, SM_GB, SM_N };
constexpr size_t WS_IF = 478 * MiB, WS_HSS = 480 * MiB, WS_ROWSS = 483 * MiB, WS_MODP = 486 * MiB, WS_WIF = 488 * MiB, WS_BAR = 489 * MiB, WS_END = 490 * MiB, WS_MODG = 487 * MiB + 256 * 1024;
constexpr size_t O_YP = 0, O_YS = 33554432, O_CP = 33685504, O_NP = 37879808, O_MP = 37896192, O_HP = 37896256, O_CVP = 37912640,
                 O_CS = 37961792, O_NS = 40058944, O_MS = 40067136, O_HS = 40067168, O_CVS = 40075360, O_END = 40099936;
constexpr int LDS_BYTES = 151552, LDS_BARW = 151040, RS_OFF = 131072, PF_OFF = 139264;

struct Params { const float* in[28]; float* out; unsigned char* ws; int ph_lo, ph_hi, probe, pad; };

typedef float f32x2_t __attribute__((ext_vector_type(2)));
typedef __bf16 bf16x2_t __attribute__((ext_vector_type(2)));
__device__ __forceinline__ unsigned pk2(float lo, float hi) { f32x2_t v = {lo, hi}; bf16x2_t b = __builtin_convertvector(v, bf16x2_t); return __builtin_bit_cast(unsigned, b); }
__device__ __forceinline__ unsigned f2bf(float f) { return pk2(f, 0.f) & 0xffffu; }
__device__ __forceinline__ float bf2f(unsigned b) { return __uint_as_float(b << 16); }
__device__ __forceinline__ float bflo(unsigned w) { return __uint_as_float(w << 16); }
__device__ __forceinline__ float bfhi(unsigned w) { return __uint_as_float(w & 0xffff0000u); }
__device__ __forceinline__ float sigm(float x) { return __builtin_amdgcn_rcpf(1.0f + __expf(-x)); }
__device__ __forceinline__ float wave_sum_bperm(float v) {
#pragma unroll
    for (int o = 1; o < 64; o <<= 1) v += __shfl_xor(v, o);
    return v;
}

template <int CTRL, int ROWMASK> __device__ __forceinline__ float dpp_f(float oldv, float src) {
    return __builtin_bit_cast(float, __builtin_amdgcn_update_dpp(__builtin_bit_cast(int, oldv), __builtin_bit_cast(int, src), CTRL, ROWMASK, 0xf, false)); }
__device__ __forceinline__ float row16_sum(float v) {
    v += dpp_f<0xB1, 0xf>(0.f, v); v += dpp_f<0x4E, 0xf>(0.f, v); v += dpp_f<0x124, 0xf>(0.f, v); v += dpp_f<0x128, 0xf>(0.f, v); return v; }
__device__ __forceinline__ float wave_sum(float v) {
    v = row16_sum(v);
    const int iv = __builtin_bit_cast(int, v);
    const float r0 = __builtin_bit_cast(float, __builtin_amdgcn_readlane(iv, 0)), r1 = __builtin_bit_cast(float, __builtin_amdgcn_readlane(iv, 16));
    const float r2 = __builtin_bit_cast(float, __builtin_amdgcn_readlane(iv, 32)), r3 = __builtin_bit_cast(float, __builtin_amdgcn_readlane(iv, 48));
    return (r0 + r1) + (r2 + r3);
}
__device__ __forceinline__ float wave_scan_add(float v) {
    v += dpp_f<0x111, 0xf>(0.f, v); v += dpp_f<0x112, 0xf>(0.f, v); v += dpp_f<0x114, 0xf>(0.f, v); v += dpp_f<0x118, 0xf>(0.f, v);
    v += dpp_f<0x142, 0xa>(0.f, v); v += dpp_f<0x143, 0xc>(0.f, v); return v; }
__device__ __forceinline__ float wave_scan_max(float v) {
    const float ninf = -INFINITY;
    v = fmaxf(v, dpp_f<0x111, 0xf>(ninf, v)); v = fmaxf(v, dpp_f<0x112, 0xf>(ninf, v)); v = fmaxf(v, dpp_f<0x114, 0xf>(ninf, v)); v = fmaxf(v, dpp_f<0x118, 0xf>(ninf, v));
    v = fmaxf(v, dpp_f<0x142, 0xa>(ninf, v)); v = fmaxf(v, dpp_f<0x143, 0xc>(ninf, v)); return v; }
#define LDS_WAIT() asm volatile("s_waitcnt lgkmcnt(0)" ::: "memory")
#define BAR_LDS() do { asm volatile("s_waitcnt lgkmcnt(0)" ::: "memory"); __builtin_amdgcn_s_barrier(); asm volatile("" ::: "memory"); } while (0)

namespace pg8 {
constexpr int BM = 256, BK = 64, HALF = 128, HTB = HALF * BK * 2, STAGE_BYTES = 8 * HTB, NXCD = 8, WGM = 8;
__host__ __device__ __forceinline__ int lds_byte(int r, int c) { const int st = (r >> 4) * 2 + (c >> 5), rr = r & 15, cc = c & 31, ob = rr * 64 + cc * 2; return st * 1024 + (ob ^ (((ob >> 9) & 1) << 5)); }
__host__ __device__ __forceinline__ void stage_rc(int b, int& R, int& C) { const int st = b / 1024, sb = b % 1024, swz = sb ^ (((sb >> 9) & 1) << 5); R = (st >> 1) * 16 + swz / 64; C = (st & 1) * 32 + (swz % 64) / 2; }
__host__ __device__ __forceinline__ int perm32(int rho) { const int n = rho >> 4, i = rho & 15; return 8 * (i >> 2) + 4 * n + (i & 3); }

struct Unit { int pm, pn, sub, slot; };
struct StaticOrder {
    int nM, nN, nwg, G, c;
    __device__ void init(int nM_, int nN_, int G_, int c_) { nM = nM_; nN = nN_; nwg = nM * nN; G = G_; c = c_; }
    __device__ bool tile(int i, Unit& u) const {
        const long L = (long)i * G + c; if (L >= nwg) return false;
        int wgid = (int)L; { const int q = nwg / NXCD, r = nwg % NXCD, xcd = wgid % NXCD, off = wgid / NXCD; wgid = (xcd < r ? xcd * (q + 1) : r * (q + 1) + (xcd - r) * q) + off; }
        const int nig = WGM * nN, gid = wgid / nig, fm = gid * WGM, gsz = (nM - fm) < WGM ? (nM - fm) : WGM;
        u.pm = fm + ((wgid % nig) % gsz); u.pn = (wgid % nig) / gsz; u.sub = 0; u.slot = 0; return true;
    }
    __device__ bool next(int i, Unit& u) const { return tile(i, u); }
};
struct PairOrder : StaticOrder {
    __device__ bool next(int i, Unit& u) const { if (!tile(i >> 1, u)) return false; u.sub = i & 1; u.slot = (i >> 1) & 1; return true; }
};
__device__ __forceinline__ unsigned cvt_pk_bf16(float lo, float hi) { return pk2(lo, hi); }

template <class Epi, class Sched, class Prob>
__device__ __forceinline__ void gemm_phase(LAS unsigned char* lds, const int K, const Sched& S, const Epi& E, const Prob& P) {
    const int tid = threadIdx.x, wid = __builtin_amdgcn_readfirstlane(tid >> 6), lane = tid & 63, wr = wid >> 2, wc = wid & 3, fr = lane & 15, fq = lane >> 4;
    const int nt = K / BK;
    unsigned voffA[2], voffB[2];
#pragma unroll
    for (int i = 0; i < 2; ++i) { int R, C; stage_rc(tid * 16 + i * 8192, R, C); const int Rb = Epi::PERM ? ((R & ~31) + perm32(R & 31)) : R;
        voffA[i] = (unsigned)(R * K + C) * 2u; voffB[i] = (unsigned)(Rb * K + C) * 2u; }
    const size_t kstep = (size_t)(BK * 2);
    const size_t hstep = (size_t)HALF * K * 2;
    const unsigned ldsw = (unsigned)wid * 1024u;
    const int aoff = lds_byte(wr * 64 + fr, fq * 8), boff = lds_byte(wc * 32 + fr, fq * 8);
#define PG8_SA(b, h) (((b) * 2 + (h)) * HTB)
#define PG8_SB(b, h) ((4 + (b) * 2 + (h)) * HTB)
#define PG8_STAGE(bufoff, gbase, voff) do { _Pragma("unroll") for (int _i = 0; _i < 2; ++_i) \
        __builtin_amdgcn_global_load_lds((const unsigned*)((const char*)(gbase) + (voff)[_i]), (LAS unsigned*)(lds + (bufoff) + ldsw + _i * 8192), 16, 0, 0); } while (0)
#define PG8_LDA(dst, b, h) do { _Pragma("unroll") for (int m = 0; m < 4; ++m) _Pragma("unroll") for (int k = 0; k < 2; ++k) dst[m][k] = *(const LAS bf16x8*)(lds + PG8_SA(b, h) + aoff + m * 2048 + k * 1024); } while (0)
#define PG8_LDB(dst, b, h) do { _Pragma("unroll") for (int n = 0; n < 2; ++n) _Pragma("unroll") for (int k = 0; k < 2; ++k) dst[n][k] = *(const LAS bf16x8*)(lds + PG8_SB(b, h) + boff + n * 2048 + k * 1024); } while (0)
#define PG8_MMA(ai, bj, At, Bt) do { __builtin_amdgcn_sched_barrier(0); _Pragma("unroll") for (int m = 0; m < 4; ++m) _Pragma("unroll") for (int n = 0; n < 2; ++n) _Pragma("unroll") for (int k = 0; k < 2; ++k) \
        acc[ai][bj][m][n] = __builtin_amdgcn_mfma_f32_16x16x32_bf16(Bt[n][k], At[m][k], acc[ai][bj][m][n], 0, 0, 0); __builtin_amdgcn_sched_barrier(0); } while (0)
#define PG8_WAIT_V(n) asm volatile("s_waitcnt vmcnt(" #n ")" ::: "memory")
#define PG8_WAIT_L(n) asm volatile("s_waitcnt lgkmcnt(" #n ")" ::: "memory")
#define PG8_BAR __builtin_amdgcn_s_barrier()
#define PG8_SCHED __builtin_amdgcn_sched_barrier(0)
    Unit cur, nxt; int ui = 0;
    if (!S.next(0, cur)) return;
    f32x4 acc[2][2][4][2];
#pragma unroll
    for (int a = 0; a < 2; ++a)
#pragma unroll
        for (int b = 0; b < 2; ++b)
#pragma unroll
            for (int m = 0; m < 4; ++m)
#pragma unroll
                for (int n = 0; n < 2; ++n) acc[a][b][m][n] = (f32x4){0.f, 0.f, 0.f, 0.f};
    bf16x8 At[4][2], B0[2][2], B1[2][2];
    const char* cA = P.a(cur); const char* cB = P.b(cur);
    PG8_STAGE(PG8_SB(0, 0), cB, voffB); PG8_STAGE(PG8_SA(0, 0), cA, voffA); PG8_STAGE(PG8_SB(0, 1), cB + hstep, voffB); PG8_STAGE(PG8_SA(0, 1), cA + hstep, voffA);
    if (wr == 1) PG8_BAR;
    PG8_WAIT_V(4); PG8_BAR;
    PG8_STAGE(PG8_SB(1, 0), cB + kstep, voffB); PG8_STAGE(PG8_SA(1, 0), cA + kstep, voffA); PG8_STAGE(PG8_SB(1, 1), cB + hstep + kstep, voffB);
    PG8_WAIT_V(6); PG8_BAR;
    for (;;) {
        const bool has_next = S.next(ui + 1, nxt);
        const char* nA = has_next ? P.a(nxt) : cA; const char* nB = has_next ? P.b(nxt) : cB;
        for (int t = 0; t < nt; t += 2) {
            const bool last = (t == nt - 2);
#if GEMM_DRAIN
            PG8_WAIT_V(0);
#endif
            E.mid(acc, cur, t, wr, fr, lds);
            const char* a1 = cA + (size_t)(t + 1) * kstep;
            const char* a2 = last ? nA : cA + (size_t)(t + 2) * kstep; const char* b2 = last ? nB : cB + (size_t)(t + 2) * kstep;
            const char* a3 = a2 + kstep; const char* b3 = b2 + kstep;
            PG8_LDB(B0, 0, 0); PG8_SCHED; PG8_LDA(At, 0, 0); PG8_STAGE(PG8_SA(1, 1), a1 + hstep, voffA);
            PG8_WAIT_L(8); PG8_BAR; PG8_WAIT_L(0); PG8_MMA(0, 0, At, B0); PG8_BAR; PG8_SCHED;
            PG8_LDB(B1, 0, 1); PG8_STAGE(PG8_SB(0, 0), b2, voffB);
            PG8_BAR; PG8_WAIT_L(0); PG8_MMA(0, 1, At, B1); PG8_BAR;
            PG8_LDA(At, 0, 1); PG8_STAGE(PG8_SA(0, 0), a2, voffA);
            PG8_BAR; PG8_WAIT_L(0); PG8_MMA(1, 0, At, B0); PG8_BAR; PG8_SCHED;
            PG8_STAGE(PG8_SB(0, 1), b2 + hstep, voffB);
            PG8_WAIT_V(6); PG8_BAR; PG8_MMA(1, 1, At, B1); PG8_BAR;
            PG8_LDB(B0, 1, 0); PG8_SCHED; PG8_LDA(At, 1, 0); PG8_STAGE(PG8_SA(0, 1), a2 + hstep, voffA);
            PG8_WAIT_L(8); PG8_BAR; PG8_WAIT_L(0); PG8_MMA(0, 0, At, B0); PG8_BAR; PG8_SCHED;
            PG8_LDB(B1, 1, 1); PG8_STAGE(PG8_SB(1, 0), b3, voffB);
            PG8_BAR; PG8_WAIT_L(0); PG8_MMA(0, 1, At, B1); PG8_BAR;
            PG8_LDA(At, 1, 1); PG8_STAGE(PG8_SA(1, 0), a3, voffA);
            PG8_BAR; PG8_WAIT_L(0); PG8_MMA(1, 0, At, B0); PG8_BAR; PG8_SCHED;
            PG8_STAGE(PG8_SB(1, 1), b3 + hstep, voffB);
            PG8_WAIT_V(6); PG8_BAR; PG8_MMA(1, 1, At, B1); PG8_BAR;
        }
        E(acc, cur, wr, wc, fr, fq, lds);
        if (!has_next) break;
        cur = nxt; cA = nA; cB = nB; ++ui;
    }
    PG8_WAIT_V(0);
    if (wr == 0) PG8_BAR;
    PG8_BAR;
#undef PG8_SA
#undef PG8_SB
#undef PG8_STAGE
#undef PG8_LDA
#undef PG8_LDB
#undef PG8_MMA
#undef PG8_WAIT_V
#undef PG8_WAIT_L
#undef PG8_BAR
#undef PG8_SCHED
}
#define ACC_ZERO(acc) do { _Pragma("unroll") for (int a_ = 0; a_ < 2; ++a_) _Pragma("unroll") for (int b_ = 0; b_ < 2; ++b_) _Pragma("unroll") for (int m_ = 0; m_ < 4; ++m_) _Pragma("unroll") for (int n_ = 0; n_ < 2; ++n_) acc[a_][b_][m_][n_] = (f32x4){0.f, 0.f, 0.f, 0.f}; } while (0)
}


#define XB_TMO      128
#define XB_XCNT(j)  (256  + 64 * (j))
#define XB_XSUB(j)  (1280 + 64 * (j))
#define XB_XGEN(j)  (2304 + 64 * (j))
#define XB_TOP      3328
#define XB_TOPGEN   3392
#define XCD_BAR_WORDS 3456
#define XB_SPIN_CAP (1u << 18)

__device__ __forceinline__ unsigned xb_ld(unsigned* p)              { return __hip_atomic_load(p, __ATOMIC_RELAXED, __HIP_MEMORY_SCOPE_AGENT); }
__device__ __forceinline__ unsigned xb_add(unsigned* p, unsigned v) { return __hip_atomic_fetch_add(p, v, __ATOMIC_RELAXED, __HIP_MEMORY_SCOPE_AGENT); }
__device__ __forceinline__ unsigned xb_xcc_id() { return (unsigned)__builtin_amdgcn_s_getreg((3 << 11) | 20) & 0xFu; }
#define XB_SPIN(cond, bar) do { unsigned _sp = 0; while (cond) { __builtin_amdgcn_s_sleep(1); \
    if ((++_sp & 255u) == 0u) { if (xb_ld(&(bar)[XB_TMO])) break; if (_sp > XB_SPIN_CAP) { atomicAdd(&(bar)[XB_TMO], 1u); break; } } } } while (0)

struct XcdBarrier {
    unsigned* bar; unsigned x;
    volatile LAS unsigned* st;
};

__device__ __forceinline__ XcdBarrier xcd_barrier_post(unsigned* bar, volatile LAS unsigned* st) {
    XcdBarrier b; b.bar = bar; b.x = xb_xcc_id(); b.st = st;
    if (threadIdx.x == 0) (void)xb_add(&bar[XB_XCNT(b.x)], 1u);
    return b;
}
__device__ __forceinline__ void xcd_barrier_complete(unsigned* bar, unsigned x, unsigned& nloc, unsigned& nx) {
    const unsigned G = gridDim.x * gridDim.y * gridDim.z;
    unsigned sum, cnt, mine, sp = 0u;
    for (;;) {
        sum = 0u; cnt = 0u; mine = 0u;
#pragma unroll
        for (unsigned j = 0; j < 16; ++j) { const unsigned c = xb_ld(&bar[XB_XCNT(j)]); sum += c; cnt += (c > 0u) ? 1u : 0u; mine = (j == x) ? c : mine; }
        if (sum == G) break;
        __builtin_amdgcn_s_sleep(1);
        if ((++sp & 255u) == 0u) { if (xb_ld(&bar[XB_TMO])) break; if (sp > XB_SPIN_CAP) { atomicAdd(&bar[XB_TMO], 1u); break; } }
    }
    nloc = mine > 0u ? mine : 1u; nx = cnt > 0u ? cnt : 1u;
}

__device__ __forceinline__ void xcd_barrier(const XcdBarrier& b) {
    asm volatile("s_waitcnt vmcnt(0)" ::: "memory");
    __syncthreads();
    if (threadIdx.x == 0) {
        unsigned* bar = b.bar;
        __builtin_amdgcn_s_waitcnt(0);
        unsigned nloc = b.st[0], nx = b.st[1];
        if (nloc == 0u) { xcd_barrier_complete(bar, b.x, nloc, nx); b.st[0] = nloc; b.st[1] = nx; }
        const unsigned old = xb_add(&bar[XB_XSUB(b.x)], 1u);
        const unsigned gen = old / nloc;
        if (old + 1u == (gen + 1u) * nloc) {
            __builtin_amdgcn_fence(__ATOMIC_RELEASE, "agent");
            asm volatile("s_waitcnt vmcnt(0)" ::: "memory");
            const unsigned og = xb_add(&bar[XB_TOP], 1u);
            const unsigned tg = og / nx;
            if (og + 1u == (tg + 1u) * nx) xb_add(&bar[XB_TOPGEN], 1u);
            else XB_SPIN(xb_ld(&bar[XB_TOPGEN]) == tg, bar);
            __builtin_amdgcn_fence(__ATOMIC_ACQUIRE, "agent");
            xb_add(&bar[XB_XGEN(b.x)], 1u);
            asm volatile("s_waitcnt vmcnt(0)" ::: "memory");
        } else {
            XB_SPIN(xb_ld(&bar[XB_XGEN(b.x)]) == gen, bar);
            __builtin_amdgcn_fence(__ATOMIC_ACQUIRE, "agent");
            asm volatile("s_waitcnt vmcnt(0)" ::: "memory");
        }
    }
    __syncthreads();
}


struct TV { bf16_t* big; bf16_t* sm; };
__device__ __forceinline__ bf16_t* tv_tile(const TV& t, int pm) { return pm < 128 ? t.big + (size_t)pm * 256 * DM : t.sm; }
__device__ __forceinline__ bf16_t* tv_row(const TV& t, int row) { return row < NTP ? t.big + (size_t)row * DM : t.sm + (size_t)(row - NTP) * DM; }

struct Epi1 {
    static constexpr bool PERM = true;
    __device__ __forceinline__ void mid(f32x4 (&)[2][2][4][2], const pg8::Unit&, int, int, int, LAS unsigned char*) const {}
    TV Q, K, V, OG, XB, SZB, GA, GB; const float* b_gate;
    __device__ __forceinline__ void operator()(f32x4 (&acc)[2][2][4][2], const pg8::Unit& u, int wr, int wc, int fr, int fq, LAS unsigned char* lds) const {
        const int pn = u.pn; int type, colt; TV tv; const float* bias = nullptr;
        if (pn < 4) { type = 0; tv = Q; colt = pn * 256; }
        else if (pn < 8) { type = 1; tv = K; colt = (pn - 4) * 256; }
        else if (pn < 12) { type = 0; tv = V; colt = (pn - 8) * 256; }
        else if (pn < 20) { type = 2; tv = OG; colt = (pn - 12) * 128; }
        else if (pn < 24) { type = 0; tv = XB; colt = (pn - 20) * 256; }
        else if (pn < 28) { type = 3; tv = SZB; colt = (pn - 24) * 256; }
        else { type = 4; tv = GA; colt = (pn - 28) * 128; bias = b_gate + colt; }
        bf16_t* base = tv_tile(tv, u.pm);
        const int nai = (u.pm < 128) ? 2 : 1;
        const int cl = wc * 32 + 8 * fq;
        if (type == 2) {
#pragma unroll
            for (int ai = 0; ai < 2; ++ai) if (ai < nai)
#pragma unroll
                for (int m = 0; m < 4; ++m) {
                    bf16_t* rowp = base + (size_t)(ai * 128 + wr * 64 + m * 16 + fr) * DM + colt + cl;
                    float v[8];
#pragma unroll
                    for (int n = 0; n < 2; ++n)
#pragma unroll
                        for (int j = 0; j < 4; ++j) { const float o = acc[ai][0][m][n][j], z = acc[ai][1][m][n][j]; v[n * 4 + j] = sigm(o) * z * sigm(z); }
                    u32x4 w; w.x = pg8::cvt_pk_bf16(v[0], v[1]); w.y = pg8::cvt_pk_bf16(v[2], v[3]); w.z = pg8::cvt_pk_bf16(v[4], v[5]); w.w = pg8::cvt_pk_bf16(v[6], v[7]);
                    *(u32x4*)rowp = w;
                }
        } else if (type == 4) {
            f32x4 bv[2][2];
#pragma unroll
            for (int bj = 0; bj < 2; ++bj)
#pragma unroll
                for (int n = 0; n < 2; ++n) bv[bj][n] = *(const f32x4*)(bias + bj * 1024 + cl + 4 * n);
            bf16_t* baseb = tv_tile(GB, u.pm);
#pragma unroll
            for (int ai = 0; ai < 2; ++ai) if (ai < nai)
#pragma unroll
                for (int m = 0; m < 4; ++m) {
                    const size_t ro = (size_t)(ai * 128 + wr * 64 + m * 16 + fr) * DM + colt + cl;
                    float vr[8], vg[8];
#pragma unroll
                    for (int n = 0; n < 2; ++n)
#pragma unroll
                        for (int j = 0; j < 4; ++j) { const float ea = __expf(-(acc[ai][0][m][n][j] + bv[0][n][j])), eb = __expf(-fmaxf(acc[ai][1][m][n][j] + bv[1][n][j], -30.f));
                            vg[n * 4 + j] = __builtin_amdgcn_rcpf(1.0f + eb); vr[n * 4 + j] = (1.0f + eb) * __builtin_amdgcn_rcpf(1.0f + ea); }
                    u32x4 w; w.x = pg8::cvt_pk_bf16(vr[0], vr[1]); w.y = pg8::cvt_pk_bf16(vr[2], vr[3]); w.z = pg8::cvt_pk_bf16(vr[4], vr[5]); w.w = pg8::cvt_pk_bf16(vr[6], vr[7]);
                    *(u32x4*)(base + ro) = w;
                    w.x = pg8::cvt_pk_bf16(vg[0], vg[1]); w.y = pg8::cvt_pk_bf16(vg[2], vg[3]); w.z = pg8::cvt_pk_bf16(vg[4], vg[5]); w.w = pg8::cvt_pk_bf16(vg[6], vg[7]);
                    *(u32x4*)(baseb + ro) = w;
                }
        } else {
            const float sc = (type == 1) ? 0.0625f : 1.0f; const bool silu = (type == 3);
#pragma unroll
            for (int ai = 0; ai < 2; ++ai) if (ai < nai)
#pragma unroll
                for (int m = 0; m < 4; ++m) {
                    bf16_t* rowp = base + (size_t)(ai * 128 + wr * 64 + m * 16 + fr) * DM + colt + cl;
#pragma unroll
                    for (int bj = 0; bj < 2; ++bj) {
                        float v[8];
#pragma unroll
                        for (int n = 0; n < 2; ++n)
#pragma unroll
                            for (int j = 0; j < 4; ++j) { float x = acc[ai][bj][m][n][j] * sc; if (silu) x = x * sigm(x); v[n * 4 + j] = x; }
                        u32x4 w; w.x = pg8::cvt_pk_bf16(v[0], v[1]); w.y = pg8::cvt_pk_bf16(v[2], v[3]); w.z = pg8::cvt_pk_bf16(v[4], v[5]); w.w = pg8::cvt_pk_bf16(v[6], v[7]);
                        *(u32x4*)(rowp + bj * 128) = w;
                    }
                }
        }
        ACC_ZERO(acc);
    }
};
struct Prob1 { TV U; const bf16_t* W;
    __device__ __forceinline__ const char* a(const pg8::Unit& u) const { return (const char*)tv_tile(U, u.pm); }
    __device__ __forceinline__ const char* b(const pg8::Unit& u) const { return (const char*)(W + (size_t)u.pn * 256 * DM); } };

struct Epi2 {
    static constexpr bool PERM = true;
    __device__ __forceinline__ void mid(f32x4 (&acc)[2][2][4][2], const pg8::Unit& u, int t, int wr, int fr, LAS unsigned char* lds) const {
        if (u.sub != 0 || t == 0 || (t & 3) != 0) return;
        const int hd = t >> 2;
        const LAS float* RS = (const LAS float*)(lds + RS_OFF) + u.slot * 1024;
#pragma unroll
        for (int ai = 0; ai < 2; ++ai)
#pragma unroll
            for (int m = 0; m < 4; ++m) { const int rl = ai * 128 + wr * 64 + m * 16 + fr;
                const float ratio = RS[rl * 4 + hd - 1] * __builtin_amdgcn_rcpf(RS[rl * 4 + hd]);
#pragma unroll
                for (int bj = 0; bj < 2; ++bj)
#pragma unroll
                    for (int n = 0; n < 2; ++n) acc[ai][bj][m][n] = acc[ai][bj][m][n] * ratio; }
    }
    TV GA, GB, MG;
    __device__ __forceinline__ void operator()(f32x4 (&acc)[2][2][4][2], const pg8::Unit& u, int wr, int wc, int fr, int fq, LAS unsigned char* lds) const {
        const bf16_t* ga = tv_tile(GA, u.pm); const bf16_t* gb = tv_tile(GB, u.pm); bf16_t* mg = tv_tile(MG, u.pm);
        {
            int t_ = threadIdx.x; asm volatile("" : "+v"(t_));
            const unsigned off0 = (unsigned)(((t_ >> 6) * 32 + (t_ & 63) / 4) << 11) + (unsigned)((t_ & 3) << 7);
            const char* gbt = (const char*)(gb + u.pn * 256); const char* gat = (const char*)(ga + u.pn * 256);
#pragma unroll
            for (int q = 0; q < 2; ++q) __builtin_amdgcn_global_load_lds((const unsigned*)((u.sub == 0 ? gat : gbt) + off0 + q * 32768u), (LAS unsigned*)(lds + PF_OFF), 16, 0, 0);
        }
        const int nai = (u.pm < 128) ? 2 : 1;
        const int col0 = u.pn * 256 + wc * 32 + 8 * fq;
#pragma unroll
        for (int ai = 0; ai < 2; ++ai) if (ai < nai)
#pragma unroll
            for (int m = 0; m < 4; ++m) {
                const size_t ro = (size_t)(ai * 128 + wr * 64 + m * 16 + fr) * DM + col0;
                const float rs3 = ((const LAS float*)(lds + RS_OFF))[u.slot * 1024 + (ai * 128 + wr * 64 + m * 16 + fr) * 4 + 3];
#pragma unroll
                for (int bj = 0; bj < 2; ++bj) {
                    const u32x4 gbw = *(const u32x4*)((u.sub == 0 ? ga : gb) + ro + bj * 128);
                    float gbv[8] = {bflo(gbw.x), bfhi(gbw.x), bflo(gbw.y), bfhi(gbw.y), bflo(gbw.z), bfhi(gbw.z), bflo(gbw.w), bfhi(gbw.w)};
                    if (u.sub == 0) {
#pragma unroll
                        for (int n = 0; n < 2; ++n)
#pragma unroll
                            for (int j = 0; j < 4; ++j) acc[ai][bj][m][n][j] *= rs3 * gbv[n * 4 + j];
                    } else {
                        float v[8];
#pragma unroll
                        for (int n = 0; n < 2; ++n)
#pragma unroll
                            for (int j = 0; j < 4; ++j) v[n * 4 + j] = acc[ai][bj][m][n][j] * gbv[n * 4 + j];
                        u32x4 w; w.x = pg8::cvt_pk_bf16(v[0], v[1]); w.y = pg8::cvt_pk_bf16(v[2], v[3]); w.z = pg8::cvt_pk_bf16(v[4], v[5]); w.w = pg8::cvt_pk_bf16(v[6], v[7]);
                        *(u32x4*)(mg + ro + bj * 128) = w;
                    }
                }
            }
        if (u.sub == 1) ACC_ZERO(acc);
    }
};
struct Prob2 { TV YA, YB; const bf16_t* WA; const bf16_t* WB;
    __device__ __forceinline__ const char* a(const pg8::Unit& u) const { return (const char*)tv_tile(u.sub ? YB : YA, u.pm); }
    __device__ __forceinline__ const char* b(const pg8::Unit& u) const { return (const char*)((u.sub ? WB : WA) + (size_t)u.pn * 256 * DM); } };

struct Epi3 {
    static constexpr bool PERM = true;
    __device__ __forceinline__ void mid(f32x4 (&)[2][2][4][2], const pg8::Unit&, int, int, int, LAS unsigned char*) const {}
    const float* xp; bf16_t* yb; const float* modg; float* rowss;
    __device__ __forceinline__ void operator()(f32x4 (&acc)[2][2][4][2], const pg8::Unit& u, int wr, int wc, int fr, int fq, LAS unsigned char* lds) const {
        const int col0 = u.pn * 256 + wc * 32 + 8 * fq;
        const float* xb = xp + (size_t)u.pm * 256 * DM;
        int t_ = threadIdx.x; asm volatile("" : "+v"(t_));
        const int rl_ = (t_ >> 8) * 64 + (t_ & 15);
        {
            const char* xt = (const char*)(xb + u.pn * 256);
            const unsigned off0 = (unsigned)(((t_ >> 6) * 32 + (t_ & 63) / 8) << 12) + (unsigned)((t_ & 7) << 7);
#pragma unroll
            for (int q = 0; q < 4; ++q) __builtin_amdgcn_global_load_lds((const unsigned*)(xt + off0 + q * 32768u), (LAS unsigned*)(lds + PF_OFF), 16, 0, 0);
        }
        bf16_t* ob = yb + (size_t)u.pm * 256 * DM;
        const float* gp = modg + (u.pm >> 3) * DM + col0;
#pragma unroll
        for (int ai = 0; ai < 2; ++ai)
#pragma unroll
            for (int m = 0; m < 4; ++m) {
                const int rl = ai * 128 + wr * 64 + m * 16 + fr;
                const size_t ro = (size_t)rl * DM + col0;
                float ss = 0.f;
#pragma unroll
                for (int bj = 0; bj < 2; ++bj) {
                    const f32x4 y0 = *(const f32x4*)(xb + ro + bj * 128) + *(const f32x4*)(gp + bj * 128) * acc[ai][bj][m][0];
                    const f32x4 y1 = *(const f32x4*)(xb + ro + bj * 128 + 4) + *(const f32x4*)(gp + bj * 128 + 4) * acc[ai][bj][m][1];
                    ss += ((y0[0] * y0[0] + y0[1] * y0[1]) + (y0[2] * y0[2] + y0[3] * y0[3])) + ((y1[0] * y1[0] + y1[1] * y1[1]) + (y1[2] * y1[2] + y1[3] * y1[3]));
                    u32x4 w; w.x = pk2(y0[0], y0[1]); w.y = pk2(y0[2], y0[3]); w.z = pk2(y1[0], y1[1]); w.w = pk2(y1[2], y1[3]);
                    *(u32x4*)(ob + ro + bj * 128) = w;
                }
                ss += __shfl_xor(ss, 16); ss += __shfl_xor(ss, 32);
                if (fq == 0) rowss[((size_t)u.pm * 256 + ai * 128 + m * 16 + rl_) * 16 + u.pn * 4 + (t_ >> 6 & 3)] = ss;
            }
        ACC_ZERO(acc);
    }
};
struct Prob3 { TV MG; const bf16_t* WO;
    __device__ __forceinline__ const char* a(const pg8::Unit& u) const { return (const char*)tv_tile(MG, u.pm); }
    __device__ __forceinline__ const char* b(const pg8::Unit& u) const { return (const char*)(WO + (size_t)u.pn * 256 * DM); } };


__device__ __forceinline__ void mini_gemm2(const Params& p, LAS unsigned char* lds) {
    const int lane = threadIdx.x & 63, wave = threadIdx.x >> 6, g = lane >> 4, li = lane & 15, tsel = wave >> 2, ksl = wave & 3;
    unsigned char* ws = p.ws;
    const bf16_t* ya = (const bf16_t*)(ws + WS_SMALL + SM_V * SMALL_B); const bf16_t* yb = (const bf16_t*)(ws + WS_SMALL + SM_SZB * SMALL_B);
    const bf16_t* ga = (const bf16_t*)(ws + WS_SMALL + SM_GA * SMALL_B); const bf16_t* gb = (const bf16_t*)(ws + WS_SMALL + SM_GB * SMALL_B);
    bf16_t* mg = (bf16_t*)(ws + WS_SMALL + SM_U * SMALL_B);
    const bf16_t* wa = (const bf16_t*)(ws + WS_WAT); const bf16_t* wb = (const bf16_t*)(ws + WS_WBT);
    LAS float* red = (LAS float*)lds;
    for (int t0 = blockIdx.x * 2; t0 < 512; t0 += gridDim.x * 2) {
        const int wt = t0 + tsel, r0 = (wt >> 6) * 16, c0 = (wt & 63) * 16;
        const bf16_t* pa = ya + (size_t)(r0 + li) * DM + ksl * 256 + 8 * g; const bf16_t* pb = yb + (size_t)(r0 + li) * DM + ksl * 256 + 8 * g;
        const bf16_t* qa = wa + (size_t)(c0 + li) * DM + ksl * 256 + 8 * g; const bf16_t* qb = wb + (size_t)(c0 + li) * DM + ksl * 256 + 8 * g;
        f32x4 a1 = (f32x4){0.f, 0.f, 0.f, 0.f}, a2 = (f32x4){0.f, 0.f, 0.f, 0.f};
#pragma unroll
        for (int k0 = 0; k0 < 256; k0 += 32) {
            a1 = __builtin_amdgcn_mfma_f32_16x16x32_bf16(*(const bf16x8*)(pa + k0), *(const bf16x8*)(qa + k0), a1, 0, 0, 0);
            a2 = __builtin_amdgcn_mfma_f32_16x16x32_bf16(*(const bf16x8*)(pb + k0), *(const bf16x8*)(qb + k0), a2, 0, 0, 0);
        }
        { const float* hss = (const float*)(ws + WS_HSS);
#pragma unroll
          for (int r = 0; r < 4; ++r) { const f32x4 hs = *(const f32x4*)(hss + (size_t)(NTP + r0 + 4 * g + r) * 16 + ksl * 4);
              a1[r] *= rsqrtf(((hs[0] + hs[1]) + (hs[2] + hs[3])) * (1.0f / 256.0f) + EPS); } }
        *(LAS f32x4*)(red + (wave * 64 + lane) * 8) = a1; *(LAS f32x4*)(red + (wave * 64 + lane) * 8 + 4) = a2;
        __syncthreads();
        if (ksl == 0) {
#pragma unroll
            for (int q = 1; q < 4; ++q) { a1 += *(const LAS f32x4*)(red + ((wave + q) * 64 + lane) * 8); a2 += *(const LAS f32x4*)(red + ((wave + q) * 64 + lane) * 8 + 4); }
#pragma unroll
            for (int r = 0; r < 4; ++r) { const size_t o = (size_t)(r0 + 4 * g + r) * DM + c0 + li;
                mg[o] = (bf16_t)f2bf(bf2f(gb[o]) * (bf2f(ga[o]) * a1[r] + a2[r])); }
        }
        __syncthreads();
    }
}
__device__ __forceinline__ void mini_gemm3(const Params& p, LAS unsigned char* lds) {
    const int lane = threadIdx.x & 63, wave = threadIdx.x >> 6, g = lane >> 4, li = lane & 15, tsel = wave >> 2, ksl = wave & 3;
    unsigned char* ws = p.ws;
    const bf16_t* mg = (const bf16_t*)(ws + WS_SMALL + SM_U * SMALL_B); const bf16_t* wo = (const bf16_t*)(ws + WS_WOT);
    const float* modg = (const float*)(ws + WS_MODG);
    LAS float* red = (LAS float*)lds;
    for (int t0 = blockIdx.x * 2; t0 < 512; t0 += gridDim.x * 2) {
        const int wt = t0 + tsel, r0 = (wt >> 6) * 16, c0 = (wt & 63) * 16;
        const bf16_t* pa = mg + (size_t)(r0 + li) * DM + ksl * 256 + 8 * g; const bf16_t* qa = wo + (size_t)(c0 + li) * DM + ksl * 256 + 8 * g;
        f32x4 a1 = (f32x4){0.f, 0.f, 0.f, 0.f};
#pragma unroll
        for (int k0 = 0; k0 < 256; k0 += 32) a1 = __builtin_amdgcn_mfma_f32_16x16x32_bf16(*(const bf16x8*)(pa + k0), *(const bf16x8*)(qa + k0), a1, 0, 0, 0);
        *(LAS f32x4*)(red + (wave * 64 + lane) * 4) = a1;
        __syncthreads();
        if (ksl == 0) {
#pragma unroll
            for (int q = 1; q < 4; ++q) a1 += *(const LAS f32x4*)(red + ((wave + q) * 64 + lane) * 4);
#pragma unroll
            for (int r = 0; r < 4; ++r) { const int row = r0 + 4 * g + r, col = c0 + li;
                p.out[O_YS + (size_t)row * DM + col] = p.in[1][(size_t)row * DM + col] + modg[(16 + (row >> 4)) * DM + col] * a1[r]; }
        }
        __syncthreads();
    }
}

__device__ __forceinline__ void transpose_item(const float* W, int ldw, int col0, int k0, bf16_t* WT, int ldt, int row0, LAS float* scr, int lane, const float* kscale = nullptr) {
#pragma unroll
    for (int i = 0; i < 32; ++i) { const int kk = 2 * i + (lane >> 5); float v = W[(size_t)(k0 + kk) * ldw + col0 + (lane & 31)]; if (kscale) v *= kscale[k0 + kk]; scr[kk * 33 + (lane & 31)] = v; }
    LDS_WAIT(); asm volatile("" ::: "memory");
    const int c = lane & 7;
#pragma unroll
    for (int j = 0; j < 4; ++j) { const int n = (lane >> 3) + 8 * j; const LAS float* s = scr + (8 * c) * 33 + n;
        u32x4 o; o.x = pk2(s[0 * 33], s[1 * 33]); o.y = pk2(s[2 * 33], s[3 * 33]); o.z = pk2(s[4 * 33], s[5 * 33]); o.w = pk2(s[6 * 33], s[7 * 33]);
        *(u32x4*)(WT + (size_t)(row0 + n) * ldt + k0 + 8 * c) = o; }
    LDS_WAIT(); asm volatile("" ::: "memory");
}

__device__ __forceinline__ void phase0(const Params& p, LAS unsigned char* lds) {
    const int tid = threadIdx.x, lane = tid & 63, wave = tid >> 6, G = gridDim.x;
    unsigned char* ws = p.ws;
    for (int it = blockIdx.x; it < 192; it += G) {
        const int cgp = it % 48, ks = it / 48;
        LAS float* cs = (LAS float*)lds;
        LAS float* red = (LAS float*)(lds + 24576);
        for (int i = tid; i < 24 * 256; i += 512) { const int b = i >> 8, k = i & 255; cs[k * 24 + b] = (b < 16) ? p.in[2][b * DM + ks * 256 + k] : p.in[3][(b - 16) * DM + ks * 256 + k]; }
        __syncthreads();
        const int col = tid & 63, kq = tid >> 6;
        float a[24];
#pragma unroll
        for (int b = 0; b < 24; ++b) a[b] = 0.f;
        const float* wm = p.in[9] + (size_t)(ks * 256 + kq * 32) * 3072 + cgp * 64 + col;
        for (int kb = 0; kb < 32; kb += 8) {
            float wv[8];
#pragma unroll
            for (int i = 0; i < 8; ++i) wv[i] = wm[(size_t)(kb + i) * 3072];
#pragma unroll
            for (int i = 0; i < 8; ++i) {
#pragma unroll
                for (int b = 0; b < 24; ++b) a[b] += cs[(kq * 32 + kb + i) * 24 + b] * wv[i];
                asm volatile("" ::: "memory"); }
        }
#pragma unroll
        for (int b = 0; b < 24; ++b) red[(kq * 24 + b) * 64 + col] = a[b];
        __syncthreads();
        float* modp = (float*)(ws + WS_MODP);
        for (int i = tid; i < 24 * 64; i += 512) { const int b = i >> 6, c = i & 63; float s = 0.f;
#pragma unroll
            for (int q = 0; q < 8; ++q) s += red[(q * 24 + b) * 64 + c];
            modp[((size_t)ks * 24 + b) * 3072 + cgp * 64 + c] = s; }
        __syncthreads();
    }
    { float* wif = (float*)(ws + WS_WIF);
      for (int i = blockIdx.x * 512 + tid; i < 8 * DM; i += G * 512) { const int g = i >> 10, k = i & 1023; wif[i] = p.in[12][(size_t)k * DIN + 5120 + g]; } }
    LAS float* scr = (LAS float*)(lds + wave * 16384);
    const int gw = blockIdx.x * 8 + wave, NGW = G * 8;
    constexpr int I_W1 = 288 * 16, I_SQ = 32 * 16, I_R = 64, NIT = I_W1 + 3 * I_SQ + 2 * I_R;
    for (int it = gw; it < NIT; it += NGW) {
        int r = it;
        if (r < I_W1) {
            const int rg = r >> 4, kb = r & 15, pn = rg >> 3, c0 = (rg & 7) * 32; const float* W; int ldw, col;
            if (pn < 12) { W = p.in[12]; ldw = DIN; col = rg * 32; }
            else if (pn < 20) { W = p.in[12]; ldw = DIN; const int j = pn - 12; col = (c0 < 128) ? 3072 + 128 * j + c0 : 4096 + 128 * j + (c0 - 128); }
            else if (pn < 24) { W = p.in[12]; ldw = DIN; col = 5128 + (rg * 32 - 5120); }
            else if (pn < 28) { W = p.in[12]; ldw = DIN; col = 6152 + (rg * 32 - 6144); }
            else { W = p.in[22]; ldw = 2048; const int j = pn - 28; col = (c0 < 128) ? 128 * j + c0 : 1024 + 128 * j + (c0 - 128); }
            transpose_item(W, ldw, col, kb * 64, (bf16_t*)(ws + WS_W1T), DM, rg * 32, scr, lane); continue; }
        r -= I_W1;
        if (r < 3 * I_SQ) { const int w = r / I_SQ, q = r % I_SQ, rg = q >> 4, kb = q & 15;
            transpose_item(p.in[24 + w], DM, rg * 32, kb * 64, (bf16_t*)(ws + (w == 0 ? WS_WAT : (w == 1 ? WS_WBT : WS_WOT))), DM, rg * 32, scr, lane, w == 0 ? p.in[14] : nullptr); continue; }
        r -= 3 * I_SQ;
        { const int w = r / I_R, q = r % I_R, n = q >> 3, rg = (q >> 1) & 3, kb = q & 1;
          transpose_item(p.in[w ? 19 : 17] + (size_t)n * 16384, 128, rg * 32, kb * 64, (bf16_t*)(ws + (w ? WS_WRXT : WS_WRAT)) + (size_t)n * 16384, 128, rg * 32, scr, lane); }
    }
}

__device__ __forceinline__ void phase1(const Params& p, LAS unsigned char* lds) {
    const int tid = threadIdx.x, lane = tid & 63, wave = tid >> 6, G = gridDim.x;
    unsigned char* ws = p.ws;
    LAS float* wif = (LAS float*)lds;
    { const float* src = (const float*)(ws + WS_WIF); for (int i = tid; i < 8 * DM; i += 512) wif[i] = src[i]; }
    __syncthreads();
    const float* modp = (const float*)(ws + WS_MODP); const float* b_mod = p.in[10]; const float* g_norm = p.in[11]; const float* b_if = p.in[13];
    float* IF = (float*)(ws + WS_IF);
    TV U{(bf16_t*)(ws + WS_U), (bf16_t*)(ws + WS_SMALL + SM_U * SMALL_B)};
    { float* modg = (float*)(ws + WS_MODG);
      for (int i = blockIdx.x * 512 + tid; i < 24 * DM; i += G * 512) { const int b = i >> 10, c = i & 1023; float s = b_mod[2048 + c];
#pragma unroll
          for (int ks = 0; ks < 4; ++ks) s += modp[((size_t)ks * 24 + b) * 3072 + 2048 + c];
          modg[i] = s; } }
    const bool h32 = (lane & 32) != 0, h16 = (lane & 16) != 0, h8 = (lane & 8) != 0;
    const int gi = (h32 ? 4 : 0) + (h16 ? 2 : 0) + (h8 ? 1 : 0);
    const float bif = b_if[gi];
    for (int wi = blockIdx.x * 8 + wave; wi < NTP / 16 + NTS; wi += G * 8) {
        const int row0 = wi < NTP / 16 ? wi * 16 : NTP + (wi - NTP / 16), nrow = wi < NTP / 16 ? 16 : 1;
        const int bidx = row0 < NTP ? (row0 >> 11) : 16 + ((row0 - NTP) >> 4);
        f32x4 sc[4], sh[4];
#pragma unroll
        for (int j = 0; j < 4; ++j) { const int idx = 4 * lane + 256 * j;
            f32x4 s = *(const f32x4*)(b_mod + idx), c = *(const f32x4*)(b_mod + 1024 + idx);
#pragma unroll
            for (int ks = 0; ks < 4; ++ks) { const float* mp = modp + ((size_t)ks * 24 + bidx) * 3072; s += *(const f32x4*)(mp + idx); c += *(const f32x4*)(mp + 1024 + idx); }
            sh[j] = s; sc[j] = *(const f32x4*)(g_norm + idx) * (c + 1.0f); }
        const float* xbase = row0 < NTP ? p.in[0] + (size_t)row0 * DM : p.in[1] + (size_t)(row0 - NTP) * DM;
        f32x4 nv[4];
#pragma unroll
        for (int j = 0; j < 4; ++j) nv[j] = *(const f32x4*)(xbase + 4 * lane + 256 * j);
        for (int r = 0; r < nrow; ++r) {
            const int row = row0 + r;
            f32x4 v[4]; float ss = 0.f;
#pragma unroll
            for (int j = 0; j < 4; ++j) { v[j] = nv[j]; ss += (v[j][0] * v[j][0] + v[j][1] * v[j][1]) + (v[j][2] * v[j][2] + v[j][3] * v[j][3]); }
            if (r + 1 < nrow) {
#pragma unroll
                for (int j = 0; j < 4; ++j) nv[j] = *(const f32x4*)(xbase + (size_t)(r + 1) * DM + 4 * lane + 256 * j); }
            const float rs = rsqrtf(wave_sum(ss) * (1.0f / DM) + EPS);
            bf16_t* ur = tv_row(U, row);
            float d[8];
#pragma unroll
            for (int g = 0; g < 8; ++g) d[g] = 0.f;
#pragma unroll
            for (int j = 0; j < 4; ++j) { v[j] = v[j] * rs * sc[j] + sh[j];
                u32x2 w; w.x = pk2(v[j][0], v[j][1]); w.y = pk2(v[j][2], v[j][3]); *(u32x2*)(ur + 4 * lane + 256 * j) = w;
#pragma unroll
                for (int g = 0; g < 8; ++g) { const f32x4 wv = *(const LAS f32x4*)(wif + g * DM + 4 * lane + 256 * j); d[g] += (v[j][0] * wv[0] + v[j][1] * wv[1]) + (v[j][2] * wv[2] + v[j][3] * wv[3]); } }
            float e[4], f[2], gs;
#pragma unroll
            for (int i = 0; i < 4; ++i) { const float send = h32 ? d[i] : d[i + 4], keep = h32 ? d[i + 4] : d[i]; e[i] = keep + __shfl_xor(send, 32); }
#pragma unroll
            for (int i = 0; i < 2; ++i) { const float send = h16 ? e[i] : e[i + 2], keep = h16 ? e[i + 2] : e[i]; f[i] = keep + __shfl_xor(send, 16); }
            { const float send = h8 ? f[0] : f[1], keep = h8 ? f[1] : f[0]; gs = keep + __shfl_xor(send, 8); }
            gs += __shfl_xor(gs, 4); gs += __shfl_xor(gs, 2); gs += __shfl_xor(gs, 1);
            if ((lane & 7) == 0) { float x = gs + bif;
                if (gi >= 4) x = fminf(x, 0.f) - __logf(1.0f + __expf(-fabsf(x)));
                IF[(size_t)row * 8 + gi] = x; }
        }
    }
}

constexpr int ML_QS = 0, ML_KS = 33792, ML_CB = 67584, ML_VS = 109824, ML_VW = 119040, ML_HS = 128256, ML_F = 137472;
__device__ __forceinline__ void mlstm_item(const Params& p, LAS unsigned char* lds, int b, int h, int vs, bool smp, bool dry) {
    int tid_ = threadIdx.x; asm volatile("" : "+v"(tid_));
    const int tid = tid_, lane = tid & 63, w = __builtin_amdgcn_readfirstlane(tid >> 6), g = lane >> 4, li = lane & 15, q4 = li >> 2, p4 = li & 3;
    unsigned char* ws = p.ws;
    const int L = smp ? DSEQ : 64, nch = smp ? 1 : SEQ / 64;
    const int row0 = smp ? NTP + b * DSEQ : b * SEQ;
    const bf16_t* qb = (smp ? (const bf16_t*)(ws + WS_SMALL + SM_Q * SMALL_B) + (size_t)(b * DSEQ) * DM : (const bf16_t*)(p.out) + (size_t)row0 * DM) + h * 256;
    const bf16_t* kb = (smp ? (const bf16_t*)(ws + WS_SMALL + SM_K * SMALL_B) + (size_t)(b * DSEQ) * DM : (const bf16_t*)((unsigned char*)p.out + 64 * MiB) + (size_t)row0 * DM) + h * 256;
    bf16_t* vb = (smp ? (bf16_t*)(ws + WS_SMALL + SM_V * SMALL_B) + (size_t)(b * DSEQ) * DM : (bf16_t*)(ws + WS_V) + (size_t)row0 * DM) + h * 256 + vs * 64;
    const float* IFb = (const float*)(ws + WS_IF) + (size_t)row0 * 8;
    float* HSSb = (float*)(ws + WS_HSS) + (size_t)row0 * 16 + h * 4 + vs;
    const bf16_t* ogb = (smp ? (const bf16_t*)(ws + WS_SMALL + SM_OG * SMALL_B) + (size_t)(b * DSEQ) * DM : (const bf16_t*)(ws + WS_OG) + (size_t)row0 * DM) + h * 256 + vs * 64;
    LAS float* F = (LAS float*)(lds + ML_F);
    LAS float *IG = F, *LF = F + 64, *HSQ = F + 128;
    LAS float *GGw = F + 264 + 320 * w, *MMw = GGw + 64, *SIw = GGw + 128, *EMw = GGw + 192, *WSw = GGw + 256;
    const int bh = b * 4 + h;
    const int vt = w & 3, ktb = (w >> 2) * 8, i0 = 2 * (w & 3);
    f32x4 cst[8], nst[2];
    float m_state;
    if (smp) {
        const float* C0 = p.in[4] + (size_t)bh * 65536 + (size_t)(vs * 64 + vt * 16 + li) * 256;
#pragma unroll
        for (int i = 0; i < 8; ++i) cst[i] = *(const f32x4*)(C0 + (ktb + i) * 16 + 4 * g);
#pragma unroll
        for (int q = 0; q < 2; ++q) nst[q] = (li == 0) ? *(const f32x4*)(p.in[5] + bh * 256 + (ktb + i0 + q) * 16 + 4 * g) : (f32x4){0.f, 0.f, 0.f, 0.f};
        m_state = p.in[6][bh];
    } else {
#pragma unroll
        for (int i = 0; i < 8; ++i) cst[i] = (f32x4){0.f, 0.f, 0.f, 0.f};
        nst[0] = (f32x4){0.f, 0.f, 0.f, 0.f}; nst[1] = nst[0];
        m_state = 0.f;
    }
#pragma unroll
    for (int i = 0; i < 8; ++i) { u32x2 wv; wv.x = pk2(cst[i][0], cst[i][1]); wv.y = pk2(cst[i][2], cst[i][3]);
        *(LAS u32x2*)(lds + ML_CB + (vt * 16 + li) * 528 + ((ktb + i) * 16 + 4 * g) * 2) = wv; }
    if (li == 0) {
#pragma unroll
        for (int q = 0; q < 2; ++q) { u32x2 wv; wv.x = pk2(nst[q][0], nst[q][1]); wv.y = pk2(nst[q][2], nst[q][3]);
            *(LAS u32x2*)(lds + ML_CB + 64 * 528 + ((ktb + i0 + q) * 16 + 4 * g) * 2) = wv; } }
    u32x4 rq[4], rk[4], rv; float rig = 0.f, rlf = 0.f;
    const u32x4 z4 = (u32x4){0u, 0u, 0u, 0u};
#define ML_PREFETCH(c) do { const int t0_ = (c) * 64; \
        _Pragma("unroll") for (int i_ = 0; i_ < 4; ++i_) { const int id_ = tid + 512 * i_, r_ = id_ >> 5, ch_ = id_ & 31; \
            if (!smp || r_ < L) { rq[i_] = *(const u32x4*)(qb + (size_t)(t0_ + r_) * DM + ch_ * 8); rk[i_] = *(const u32x4*)(kb + (size_t)(t0_ + r_) * DM + ch_ * 8); } else { rq[i_] = z4; rk[i_] = z4; } } \
        { const int r_ = tid >> 3, ch_ = tid & 7; rv = (!smp || r_ < L) ? *(const u32x4*)(vb + (size_t)(t0_ + r_) * DM + ch_ * 8) : z4; } \
        if (tid < 64) { if (!smp || tid < L) { rig = IFb[(size_t)(t0_ + tid) * 8 + h]; rlf = IFb[(size_t)(t0_ + tid) * 8 + 4 + h]; } else { rig = -INFINITY; rlf = 0.f; } } } while (0)
    ML_PREFETCH(0);
    bf16x8 ones; { const short o1 = (short)0x3F80;
#pragma unroll
        for (int j = 0; j < 8; ++j) ones[j] = o1; }
    const int tt = (w < 4) ? (w >> 1) : 3 - ((w - 4) >> 1), hb = (w & 1) * 2;
    for (int c = 0; c < nch; ++c) {
        const int t0 = c * 64;
#pragma unroll
        for (int i = 0; i < 4; ++i) { const int id = tid + 512 * i, r = id >> 5, ch = id & 31;
            *(LAS u32x4*)(lds + ML_QS + r * 528 + ch * 16) = rq[i]; *(LAS u32x4*)(lds + ML_KS + r * 528 + ch * 16) = rk[i]; }
        const u32x4 vcur = rv;
        { const int r = tid >> 3, ch = tid & 7; *(LAS u32x4*)(lds + ML_VS + r * 144 + ch * 16) = vcur; }
        if (tid < 64) { IG[tid] = rig; LF[tid] = rlf; }
        BAR_LDS();
        if (tt >= 2) __builtin_amdgcn_s_setprio(1);
        if (c + 1 < nch) ML_PREFETCH(c + 1);
        float decay, m_next;
        {
            const float bc = wave_scan_add(LF[lane]);
            const float gs = IG[lane] - bc;
            const float cm = wave_scan_max(gs);
            const float Mt = fmaxf(m_state, cm);
            const float ML_ = __builtin_bit_cast(float, __builtin_amdgcn_readlane(__builtin_bit_cast(int, Mt), 63));
            const float bL = __builtin_bit_cast(float, __builtin_amdgcn_readlane(__builtin_bit_cast(int, bc), 63));
            GGw[lane] = gs; MMw[lane] = Mt; SIw[lane] = __expf(m_state - Mt); EMw[lane] = __expf(-(bc + Mt)); WSw[lane] = __expf(gs - ML_);
            decay = __expf(m_state - ML_); m_next = bL + ML_;
        }
        { const int r = tid >> 3, ch = tid & 7; const float wsr = WSw[r];
          u32x4 o; o.x = pk2(bflo(vcur.x) * wsr, bfhi(vcur.x) * wsr); o.y = pk2(bflo(vcur.y) * wsr, bfhi(vcur.y) * wsr); o.z = pk2(bflo(vcur.z) * wsr, bfhi(vcur.z) * wsr); o.w = pk2(bflo(vcur.w) * wsr, bfhi(vcur.w) * wsr);
          *(LAS u32x4*)(lds + ML_VW + r * 144 + ch * 16) = o; }
        {
            bf16x8 qf[8];
#pragma unroll
            for (int kk = 0; kk < 8; ++kk) qf[kk] = *(const LAS bf16x8*)(lds + ML_QS + (tt * 16 + li) * 528 + (kk * 32 + g * 8) * 2);
            const float mt = MMw[tt * 16 + li];
            const int tq = tt * 16 + li;
            bf16x8 ap[2];
#pragma unroll
            for (int ks = 0; ks < 2; ++ks) {
                float pv[8];
#pragma unroll
                for (int hh = 0; hh < 2; ++hh) { const int st = 2 * ks + hh;
                    if (st <= tt) { f32x4 sa = (f32x4){0.f, 0.f, 0.f, 0.f};
#pragma unroll
                        for (int kk = 0; kk < 8; ++kk) { const bf16x8 kf = *(const LAS bf16x8*)(lds + ML_KS + (st * 16 + li) * 528 + (kk * 32 + g * 8) * 2); sa = __builtin_amdgcn_mfma_f32_16x16x32_bf16(kf, qf[kk], sa, 0, 0, 0); }
                        const f32x4 gv = *(const LAS f32x4*)(GGw + st * 16 + 4 * g);
#pragma unroll
                        for (int r = 0; r < 4; ++r) { const int sidx = st * 16 + 4 * g + r; pv[hh * 4 + r] = (sidx <= tq) ? sa[r] * __expf(gv[r] - mt) : 0.f; }
                    } else {
#pragma unroll
                        for (int r = 0; r < 4; ++r) pv[hh * 4 + r] = 0.f; } }
                union { u32x4 u; bf16x8 v; } cvt; cvt.u.x = pk2(pv[0], pv[1]); cvt.u.y = pk2(pv[2], pv[3]); cvt.u.z = pk2(pv[4], pv[5]); cvt.u.w = pk2(pv[6], pv[7]);
                ap[ks] = cvt.v;
            }
            f32x4 na[2], nq = (f32x4){0.f, 0.f, 0.f, 0.f}, ra = (f32x4){0.f, 0.f, 0.f, 0.f};
            na[0] = (f32x4){0.f, 0.f, 0.f, 0.f}; na[1] = na[0];
#pragma unroll
            for (int kk = 0; kk < 8; ++kk) {
                const bf16x8 c0 = *(const LAS bf16x8*)(lds + ML_CB + ((hb + 0) * 16 + li) * 528 + (kk * 32 + g * 8) * 2);
                const bf16x8 c1 = *(const LAS bf16x8*)(lds + ML_CB + ((hb + 1) * 16 + li) * 528 + (kk * 32 + g * 8) * 2);
                const bf16x8 cn = *(const LAS bf16x8*)(lds + ML_CB + 64 * 528 + (kk * 32 + g * 8) * 2);
                na[0] = __builtin_amdgcn_mfma_f32_16x16x32_bf16(qf[kk], c0, na[0], 0, 0, 0);
                na[1] = __builtin_amdgcn_mfma_f32_16x16x32_bf16(qf[kk], c1, na[1], 0, 0, 0);
                nq = __builtin_amdgcn_mfma_f32_16x16x32_bf16(qf[kk], cn, nq, 0, 0, 0);
            }
            const f32x4 si = *(const LAS f32x4*)(SIw + tt * 16 + 4 * g), em = *(const LAS f32x4*)(EMw + tt * 16 + 4 * g);
            na[0] = na[0] * si; na[1] = na[1] * si;
#pragma unroll
            for (int ks = 0; ks < 2; ++ks) if (2 * ks <= tt) {
                ra = __builtin_amdgcn_mfma_f32_16x16x32_bf16(ap[ks], ones, ra, 0, 0, 0);
#pragma unroll
                for (int j = 0; j < 2; ++j) {
                    const s16x4 v0 = __builtin_amdgcn_ds_read_tr16_b64_v4i16((LAS s16x4*)(lds + ML_VS + (ks * 32 + g * 4 + q4) * 144 + ((hb + j) * 16 + 4 * p4) * 2));
                    const s16x4 v1 = __builtin_amdgcn_ds_read_tr16_b64_v4i16((LAS s16x4*)(lds + ML_VS + (ks * 32 + 16 + g * 4 + q4) * 144 + ((hb + j) * 16 + 4 * p4) * 2));
                    bf16x8 bv; bv[0] = v0[0]; bv[1] = v0[1]; bv[2] = v0[2]; bv[3] = v0[3]; bv[4] = v1[0]; bv[5] = v1[1]; bv[6] = v1[2]; bv[7] = v1[3];
                    na[j] = __builtin_amdgcn_mfma_f32_16x16x32_bf16(ap[ks], bv, na[j], 0, 0, 0);
                }
            }
#pragma unroll
            for (int r = 0; r < 4; ++r) { const int t = tt * 16 + 4 * g + r;
                const float den = si[r] * nq[r] + ra[r]; const float inv = __builtin_amdgcn_rcpf(fmaxf(fabsf(den), em[r]));
                const float h0 = na[0][r] * inv, h1 = na[1][r] * inv;
                *(LAS bf16_t*)(lds + ML_HS + t * 144 + ((hb + 0) * 16 + li) * 2) = (bf16_t)f2bf(h0);
                *(LAS bf16_t*)(lds + ML_HS + t * 144 + ((hb + 1) * 16 + li) * 2) = (bf16_t)f2bf(h1);
                float sq = h0 * h0 + h1 * h1;
                sq = row16_sum(sq);
                HSQ[t * 2 + (w & 1)] = sq; }
        }
        __builtin_amdgcn_s_setprio(0);
        BAR_LDS();
        u32x4 ogv = (u32x4){0u, 0u, 0u, 0u};
        { const int r = tid >> 3, ch = tid & 7; if (!smp || r < L) ogv = *(const u32x4*)(ogb + (size_t)(t0 + r) * DM + ch * 8); }
        if (tid < L && !dry) HSSb[(size_t)(t0 + tid) * 16] = HSQ[tid * 2] + HSQ[tid * 2 + 1];
        {
            bf16x8 bvw[2], bws[2];
#pragma unroll
            for (int ks = 0; ks < 2; ++ks) {
                const s16x4 v0 = __builtin_amdgcn_ds_read_tr16_b64_v4i16((LAS s16x4*)(lds + ML_VW + (ks * 32 + g * 8 + 0 + q4) * 144 + (vt * 16 + 4 * p4) * 2));
                const s16x4 v1 = __builtin_amdgcn_ds_read_tr16_b64_v4i16((LAS s16x4*)(lds + ML_VW + (ks * 32 + g * 8 + 4 + q4) * 144 + (vt * 16 + 4 * p4) * 2));
                bvw[ks][0] = v0[0]; bvw[ks][1] = v0[1]; bvw[ks][2] = v0[2]; bvw[ks][3] = v0[3]; bvw[ks][4] = v1[0]; bvw[ks][5] = v1[1]; bvw[ks][6] = v1[2]; bvw[ks][7] = v1[3];
                const f32x4 w0 = *(const LAS f32x4*)(WSw + ks * 32 + g * 8), w1 = *(const LAS f32x4*)(WSw + ks * 32 + g * 8 + 4);
                union { u32x4 u; bf16x8 v; } cvt; cvt.u.x = pk2(w0[0], w0[1]); cvt.u.y = pk2(w0[2], w0[3]); cvt.u.z = pk2(w1[0], w1[1]); cvt.u.w = pk2(w1[2], w1[3]);
                if (li != 0) cvt.u = (u32x4){0u, 0u, 0u, 0u};
                bws[ks] = cvt.v; }
            nst[0] = nst[0] * decay; nst[1] = nst[1] * decay;
#pragma unroll
            for (int i = 0; i < 8; ++i) { const int kt = ktb + i; cst[i] = cst[i] * decay;
                const bool mine = ((i >> 1) == (w & 3));
#pragma unroll
                for (int ks = 0; ks < 2; ++ks) {
                    const s16x4 k0 = __builtin_amdgcn_ds_read_tr16_b64_v4i16((LAS s16x4*)(lds + ML_KS + (ks * 32 + g * 8 + 0 + q4) * 528 + (kt * 16 + 4 * p4) * 2));
                    const s16x4 k1 = __builtin_amdgcn_ds_read_tr16_b64_v4i16((LAS s16x4*)(lds + ML_KS + (ks * 32 + g * 8 + 4 + q4) * 528 + (kt * 16 + 4 * p4) * 2));
                    bf16x8 ak; ak[0] = k0[0]; ak[1] = k0[1]; ak[2] = k0[2]; ak[3] = k0[3]; ak[4] = k1[0]; ak[5] = k1[1]; ak[6] = k1[2]; ak[7] = k1[3];
                    cst[i] = __builtin_amdgcn_mfma_f32_16x16x32_bf16(ak, bvw[ks], cst[i], 0, 0, 0);
                    if (mine) nst[i & 1] = __builtin_amdgcn_mfma_f32_16x16x32_bf16(ak, bws[ks], nst[i & 1], 0, 0, 0); }
                u32x2 wv; wv.x = pk2(cst[i][0], cst[i][1]); wv.y = pk2(cst[i][2], cst[i][3]);
                *(LAS u32x2*)(lds + ML_CB + (vt * 16 + li) * 528 + (kt * 16 + 4 * g) * 2) = wv; }
            if (li == 0) {
#pragma unroll
                for (int q = 0; q < 2; ++q) { u32x2 wv; wv.x = pk2(nst[q][0], nst[q][1]); wv.y = pk2(nst[q][2], nst[q][3]);
                    *(LAS u32x2*)(lds + ML_CB + 64 * 528 + ((ktb + i0 + q) * 16 + 4 * g) * 2) = wv; } }
        }
        { const int r = tid >> 3, ch = tid & 7; if ((!smp || r < L) && !dry) { const u32x4 hv = *(const LAS u32x4*)(lds + ML_HS + r * 144 + ch * 16); u32x4 o;
            o.x = pk2(bflo(hv.x) * bflo(ogv.x), bfhi(hv.x) * bfhi(ogv.x)); o.y = pk2(bflo(hv.y) * bflo(ogv.y), bfhi(hv.y) * bfhi(ogv.y));
            o.z = pk2(bflo(hv.z) * bflo(ogv.z), bfhi(hv.z) * bfhi(ogv.z)); o.w = pk2(bflo(hv.w) * bflo(ogv.w), bfhi(hv.w) * bfhi(ogv.w));
            *(u32x4*)(vb + (size_t)(t0 + r) * DM + ch * 8) = o; } }
        BAR_LDS();
        m_state = m_next;
    }
    if (!dry) {
        float* Co = p.out + (smp ? O_CS : O_CP) + (size_t)bh * 65536 + (size_t)(vs * 64 + vt * 16 + li) * 256;
#pragma unroll
        for (int i = 0; i < 8; ++i) *(f32x4*)(Co + (ktb + i) * 16 + 4 * g) = cst[i];
        if (vs == 0) {
            if (li == 0) {
#pragma unroll
                for (int q = 0; q < 2; ++q) *(f32x4*)(p.out + (smp ? O_NS : O_NP) + bh * 256 + (ktb + i0 + q) * 16 + 4 * g) = nst[q]; }
            if (tid == 0) p.out[(smp ? O_MS : O_MP) + bh] = m_state; }
    }
    __syncthreads();
#undef ML_PREFETCH
}

constexpr int RG_XR = 0, RG_XC = 18432, RG_W = 36864, RG_EX = 71680, RG_HC = 72704, RG_ZS = 73216;
__device__ __forceinline__ void rglru_item(const Params& p, LAS unsigned char* lds, int b, int n, int hf, bool smp, bool dry) {
    int tid_ = threadIdx.x; asm volatile("" : "+v"(tid_));
    const int tid = tid_, lane = tid & 63, w = __builtin_amdgcn_readfirstlane(tid >> 6), g = lane >> 4, li = lane & 15;
    unsigned char* ws = p.ws;
    const int L = smp ? DSEQ : SEQ, ntile = smp ? 1 : SEQ / 64;
    const int row0 = smp ? NTP + b * DSEQ : b * SEQ;
    const bf16_t* xbp = (smp ? (const bf16_t*)(ws + WS_SMALL + SM_XB * SMALL_B) + (size_t)(b * DSEQ) * DM : (const bf16_t*)(ws + WS_XB) + (size_t)row0 * DM) + n * 128;
    bf16_t* zbp = (smp ? (bf16_t*)(ws + WS_SMALL + SM_SZB * SMALL_B) + (size_t)(b * DSEQ) * DM : (bf16_t*)(ws + WS_SZB) + (size_t)row0 * DM) + n * 128 + hf * 64;
    const float* cvs = p.in[8] + (size_t)b * 3 * DM + n * 128;
    LAS float* EX = (LAS float*)(lds + RG_EX); LAS float* HC = (LAS float*)(lds + RG_HC);
    for (int id = tid; id < 2 * 64 * 16; id += 512) { const int gt = id >> 10, j = (id >> 4) & 63, ch = id & 15;
        *(LAS u32x4*)(lds + RG_W + (gt * 64 + j) * 272 + ch * 16) = *(const u32x4*)((const bf16_t*)(ws + (gt ? WS_WRXT : WS_WRAT)) + (size_t)n * 16384 + (size_t)(hf * 64 + j) * 128 + ch * 8); }
    const int jt = w & 3, th = w >> 2, jc = jt * 16 + li, chn = n * 128 + hf * 64 + jc;
    const float bra = p.in[18][chn], brx = p.in[20][chn];
    float spl; { const float lm = p.in[21][chn]; spl = fmaxf(-lm, 0.f) + log1pf(__expf(-fabsf(lm))); }
    float gw_[4]; const float gb_ = p.in[16][chn];
#pragma unroll
    for (int j = 0; j < 4; ++j) gw_[j] = p.in[15][j * DM + chn];
    const int c2 = tid & 63, tq = tid >> 6;
    float cw[4][2], cb[2];
#pragma unroll
    for (int j = 0; j < 4; ++j) { cw[j][0] = p.in[15][j * DM + n * 128 + 2 * c2]; cw[j][1] = p.in[15][j * DM + n * 128 + 2 * c2 + 1]; }
    cb[0] = p.in[16][n * 128 + 2 * c2]; cb[1] = p.in[16][n * 128 + 2 * c2 + 1];
    if (tid < 64) { HC[tid] = smp ? p.in[7][b * DM + n * 128 + hf * 64 + tid] : 0.f; }
    u32x4 rx[3], rzv;
    const u32x4 z4 = (u32x4){0u, 0u, 0u, 0u};
#define RG_PREFETCH(tl) do { const int t0_ = (tl) * 64; \
        _Pragma("unroll") for (int i_ = 0; i_ < 3; ++i_) { const int id_ = tid + 512 * i_, r_ = id_ >> 4, ch_ = id_ & 15, tok_ = t0_ - 3 + r_; rx[i_] = z4; \
            if (id_ < 67 * 16) { if (tok_ >= 0 && (!smp || tok_ < L)) rx[i_] = *(const u32x4*)(xbp + (size_t)tok_ * DM + ch_ * 8); \
                else if (tok_ < 0 && smp) { const float* s_ = cvs + (size_t)(tok_ + 3) * DM + ch_ * 8; const f32x4 a_ = *(const f32x4*)s_, b_ = *(const f32x4*)(s_ + 4); \
                    rx[i_].x = pk2(a_[0], a_[1]); rx[i_].y = pk2(a_[2], a_[3]); rx[i_].z = pk2(b_[0], b_[1]); rx[i_].w = pk2(b_[2], b_[3]); } } } \
        { const int r_ = tid >> 3, ch_ = tid & 7; rzv = (!smp || t0_ + r_ < L) ? *(const u32x4*)(zbp + (size_t)(t0_ + r_) * DM + ch_ * 8) : z4; } } while (0)
    RG_PREFETCH(0);
    for (int tl = 0; tl < ntile; ++tl) {
        const int t0 = tl * 64;
#pragma unroll
        for (int i = 0; i < 3; ++i) { const int id = tid + 512 * i, r = id >> 4, ch = id & 15; if (id < 67 * 16) *(LAS u32x4*)(lds + RG_XR + r * 272 + ch * 16) = rx[i]; }
        { const int r = tid >> 3, ch = tid & 7; *(LAS u32x4*)(lds + RG_ZS + (tl & 1) * 9216 + r * 144 + ch * 16) = rzv; }
        BAR_LDS();
        if (tl > 0 && !dry) { const int r = tid >> 3, ch = tid & 7;
            *(u32x4*)(zbp + (size_t)(t0 - 64 + r) * DM + ch * 8) = *(const LAS u32x4*)(lds + RG_ZS + ((tl - 1) & 1) * 9216 + r * 144 + ch * 16); }
        if (tl == ntile - 1 && tid < 192 && !dry) {
            const int j = tid >> 6, c = tid & 63, rr = (L - t0) + j;
            p.out[(smp ? O_CVS : O_CVP) + ((size_t)b * 3 + j) * DM + n * 128 + hf * 64 + c] = bf2f(*(const LAS bf16_t*)(lds + RG_XR + rr * 272 + (hf * 64 + c) * 2));
        }
        if (tl + 1 < ntile) RG_PREFETCH(tl + 1);
        { float x0[3], x1[3];
#pragma unroll
          for (int j = 0; j < 3; ++j) { const unsigned wv = *(const LAS unsigned*)(lds + RG_XR + (tq * 8 + j) * 272 + c2 * 4); x0[j] = bflo(wv); x1[j] = bfhi(wv); }
#pragma unroll
          for (int i = 0; i < 8; ++i) { const int t = tq * 8 + i; const unsigned wv = *(const LAS unsigned*)(lds + RG_XR + (t + 3) * 272 + c2 * 4); const float n0 = bflo(wv), n1 = bfhi(wv);
              const float y0 = cb[0] + cw[0][0] * x0[0] + cw[1][0] * x0[1] + cw[2][0] * x0[2] + cw[3][0] * n0;
              const float y1 = cb[1] + cw[0][1] * x1[0] + cw[1][1] * x1[1] + cw[2][1] * x1[2] + cw[3][1] * n1;
              x0[0] = x0[1]; x0[1] = x0[2]; x0[2] = n0; x1[0] = x1[1]; x1[1] = x1[2]; x1[2] = n1;
              *(LAS unsigned*)(lds + RG_XC + t * 272 + c2 * 4) = pk2(y0, y1); } }
        BAR_LDS();
        float av[2][4], bv[2][4], TA[2], TB[2], EA[2], EB[2];
        {
            bf16x8 wr_[4], wi_[4];
#pragma unroll
            for (int kk = 0; kk < 4; ++kk) { wr_[kk] = *(const LAS bf16x8*)(lds + RG_W + jc * 272 + (kk * 32 + g * 8) * 2); wi_[kk] = *(const LAS bf16x8*)(lds + RG_W + (64 + jc) * 272 + (kk * 32 + g * 8) * 2); }
#pragma unroll
            for (int q = 0; q < 2; ++q) { const int tt = 2 * th + q;
                f32x4 ar = (f32x4){0.f, 0.f, 0.f, 0.f}, ai = (f32x4){0.f, 0.f, 0.f, 0.f};
#pragma unroll
                for (int kk = 0; kk < 4; ++kk) { const bf16x8 ax = *(const LAS bf16x8*)(lds + RG_XC + (tt * 16 + li) * 272 + (kk * 32 + g * 8) * 2);
                    ar = __builtin_amdgcn_mfma_f32_16x16x32_bf16(ax, wr_[kk], ar, 0, 0, 0); ai = __builtin_amdgcn_mfma_f32_16x16x32_bf16(ax, wi_[kk], ai, 0, 0, 0); }
                float xw[7];
#pragma unroll
                for (int k = 0; k < 7; ++k) xw[k] = bf2f(*(const LAS bf16_t*)(lds + RG_XR + (tt * 16 + 4 * g + k) * 272 + (hf * 64 + jc) * 2));
                float A4 = 1.f, B4 = 0.f;
#pragma unroll
                for (int r = 0; r < 4; ++r) { const int t = tt * 16 + 4 * g + r;
                    const float xc = gb_ + gw_[0] * xw[r] + gw_[1] * xw[r + 1] + gw_[2] * xw[r + 2] + gw_[3] * xw[r + 3];
                    const float rg = sigm(ar[r] + bra), ig = sigm(ai[r] + brx);
                    const float la = -8.0f * rg * spl; const float a = __expf(la);
                    const float x2 = 2.0f * la;
                    const float pm = x2 * (1.0f + x2 * (0.5f + x2 * (0.16666667f + x2 * (0.041666668f + x2 * (0.0083333338f + x2 * (0.0013888889f + x2 * 0.0001984127f))))));
                    const float om = (x2 > -0.5f) ? -pm : 1.0f - __expf(x2);
                    float mult = __builtin_amdgcn_sqrtf(om); if (!smp && (t0 + t) == 0) mult = 1.0f;
                    const float bt = mult * ig * xc;
                    av[q][r] = a; bv[q][r] = bt; B4 = a * B4 + bt; A4 *= a; }
                { const float pA = __shfl_up(A4, 16), pB = __shfl_up(B4, 16); if (g >= 1) { B4 = A4 * pB + B4; A4 = A4 * pA; } }
                { const float pA = __shfl_up(A4, 32), pB = __shfl_up(B4, 32); if (g >= 2) { B4 = A4 * pB + B4; A4 = A4 * pA; } }
                { const float pA = __shfl_up(A4, 16), pB = __shfl_up(B4, 16); EA[q] = (g >= 1) ? pA : 1.f; EB[q] = (g >= 1) ? pB : 0.f; }
                TA[q] = __shfl(A4, 48 + li); TB[q] = __shfl(B4, 48 + li);
            }
            { EX[(th * 64 + jc) * 2] = TA[0] * TA[1]; EX[(th * 64 + jc) * 2 + 1] = TA[1] * TB[0] + TB[1]; }
        }
        BAR_LDS();
        {
            float hin = HC[(tl & 1) * 64 + jc];
            if (th == 1) hin = EX[jc * 2] * hin + EX[jc * 2 + 1];
            if (th == 1) HC[((tl + 1) & 1) * 64 + jc] = (TA[0] * TA[1]) * hin + (TA[1] * TB[0] + TB[1]);
#pragma unroll
            for (int q = 0; q < 2; ++q) { const int tt = 2 * th + q;
                float hcur = EA[q] * hin + EB[q];
#pragma unroll
                for (int r = 0; r < 4; ++r) { const int tok = t0 + tt * 16 + 4 * g + r;
                    hcur = av[q][r] * hcur + bv[q][r];
                    { LAS bf16_t* zp = (LAS bf16_t*)(lds + RG_ZS + (tl & 1) * 9216 + (tt * 16 + 4 * g + r) * 144 + jc * 2); *zp = (bf16_t)f2bf(bf2f(*zp) * hcur); }
                    if ((!smp || tok < L) && !dry && tok == L - 1) p.out[(smp ? O_HS : O_HP) + (size_t)b * DM + chn] = hcur; }
                hin = TA[q] * hin + TB[q];
            }
        }
    }
    BAR_LDS();
    if (!dry) { const int r = tid >> 3, ch = tid & 7, tlast = (ntile - 1) * 64;
        if (tlast + r < L) *(u32x4*)(zbp + (size_t)(tlast + r) * DM + ch * 8) = *(const LAS u32x4*)(lds + RG_ZS + ((ntile - 1) & 1) * 9216 + r * 144 + ch * 16); }
    __syncthreads();
#undef RG_PREFETCH
}

__device__ __forceinline__ void phase3(const Params& p, LAS unsigned char* lds) {
    const int G = gridDim.x;
    for (int it = blockIdx.x; it < 256; it += G) { const int bh = (it & 7) * 8 + (it >> 5), vs = (it >> 3) & 3; mlstm_item(p, lds, bh >> 2, bh & 3, vs, false, false); }
    for (int it = blockIdx.x; it < 256; it += G) { const int q = (it & 7) * 16 + (it >> 4), hf = (it >> 3) & 1; rglru_item(p, lds, q >> 3, q & 7, hf, false, false); }
    for (int it = blockIdx.x; it < 128; it += G) mlstm_item(p, lds, it >> 4, (it >> 2) & 3, it & 3, true, false);
    for (int it = blockIdx.x; it < 256; it += G) if (it >= 128) { const int q = it - 128; rglru_item(p, lds, q >> 4, (q >> 1) & 7, q & 1, true, false); }
}

__device__ __forceinline__ void phase4(const Params& p) {
    unsigned char* ws = p.ws;
    TV YA{(bf16_t*)(ws + WS_V), (bf16_t*)(ws + WS_SMALL + SM_V * SMALL_B)}, OG{(bf16_t*)(ws + WS_OG), (bf16_t*)(ws + WS_SMALL + SM_OG * SMALL_B)};
    const float* HSS = (const float*)(ws + WS_HSS); const float* gh = p.in[14];
    for (int id = blockIdx.x * 512 + threadIdx.x; id < NTT * 128; id += gridDim.x * 512) {
        const int row = id >> 7, ch = id & 127, hd = ch >> 5;
        const f32x4 hs = *(const f32x4*)(HSS + (size_t)row * 16 + hd * 4);
        const float rs = rsqrtf(((hs[0] + hs[1]) + (hs[2] + hs[3])) * (1.0f / 256.0f) + EPS);
        bf16_t* yp = tv_row(YA, row) + ch * 8; const bf16_t* op = tv_row(OG, row) + ch * 8;
        const u32x4 hv = *(const u32x4*)yp, ov = *(const u32x4*)op; const f32x4 g0 = *(const f32x4*)(gh + ch * 8), g1 = *(const f32x4*)(gh + ch * 8 + 4);
        u32x4 o;
        o.x = pk2(bflo(hv.x) * bflo(ov.x) * rs * g0[0], bfhi(hv.x) * bfhi(ov.x) * rs * g0[1]);
        o.y = pk2(bflo(hv.y) * bflo(ov.y) * rs * g0[2], bfhi(hv.y) * bfhi(ov.y) * rs * g0[3]);
        o.z = pk2(bflo(hv.z) * bflo(ov.z) * rs * g1[0], bfhi(hv.z) * bfhi(ov.z) * rs * g1[1]);
        o.w = pk2(bflo(hv.w) * bflo(ov.w) * rs * g1[2], bfhi(hv.w) * bfhi(ov.w) * rs * g1[3]);
        *(u32x4*)yp = o;
    }
}

__device__ __forceinline__ void phase7(const Params& p) {
    const int lane = threadIdx.x & 63, wave = threadIdx.x >> 6;
    const float* rowss = (const float*)(p.ws + WS_ROWSS); const float* gf = p.in[27];
    f32x4 gv[4];
#pragma unroll
    for (int j = 0; j < 4; ++j) gv[j] = *(const f32x4*)(gf + 4 * lane + 256 * j);
    const bf16_t* ybf = (const bf16_t*)(p.ws + WS_V);
    const int gw = blockIdx.x * 8 + wave, NGW = gridDim.x * 8;
    for (int r0 = gw; r0 < NTP; r0 += 4 * NGW) {
        u32x2 w[4][4]; float part[4];
#pragma unroll
        for (int q = 0; q < 4; ++q) { const int row = r0 + q * NGW; const bool ok = row < NTP; const int rr = ok ? row : r0;
#pragma unroll
            for (int j = 0; j < 4; ++j) w[q][j] = *(const u32x2*)(ybf + (size_t)rr * DM + 4 * lane + 256 * j);
            part[q] = lane < 16 ? rowss[(size_t)rr * 16 + lane] : 0.f; }
#pragma unroll
        for (int q = 0; q < 4; ++q) { const int row = r0 + q * NGW; if (row < NTP) {
            const float rs = rsqrtf(wave_sum(part[q]) * (1.0f / DM) + EPS);
            float* yr = p.out + O_YP + (size_t)row * DM;
#pragma unroll
            for (int j = 0; j < 4; ++j) { const f32x4 v = (f32x4){bflo(w[q][j].x), bfhi(w[q][j].x), bflo(w[q][j].y), bfhi(w[q][j].y)}; *(f32x4*)(yr + 4 * lane + 256 * j) = v * rs * gv[j]; } } }
    }
    for (int row = gw; row < NTS; row += NGW) {
        float* yr = p.out + O_YS + (size_t)row * DM;
        f32x4 v[4]; float part = 0.f;
#pragma unroll
        for (int j = 0; j < 4; ++j) { v[j] = *(const f32x4*)(yr + 4 * lane + 256 * j); part += (v[j][0] * v[j][0] + v[j][1] * v[j][1]) + (v[j][2] * v[j][2] + v[j][3] * v[j][3]); }
        const float rs = rsqrtf(wave_sum(part) * (1.0f / DM) + EPS);
#pragma unroll
        for (int j = 0; j < 4; ++j) *(f32x4*)(yr + 4 * lane + 256 * j) = v[j] * rs * gv[j];
    }
}

__global__ void __launch_bounds__(512) fwd_kernel(Params p) {
    extern __shared__ __attribute__((aligned(16))) unsigned char lds_raw[];
    LAS unsigned char* lds = (LAS unsigned char*)lds_raw;
    unsigned char* ws = p.ws;
    const int lo = p.ph_lo, hi = p.ph_hi;
#ifndef REP2
#define REP2 1
#define REP56 1
#define REP01 1
#ifndef PROBE_MODE
#define PROBE_MODE 0
#endif
#endif
#ifndef PH_MASK
#define PH_MASK 255
#endif
#define IN(k) (((PH_MASK >> (k)) & 1) && lo <= (k) && (k) < hi)
    { volatile LAS unsigned* stw = (volatile LAS unsigned*)(lds + LDS_BARW); if (threadIdx.x < 2) stw[threadIdx.x] = 0u; }
    __syncthreads();
    XcdBarrier xbar = xcd_barrier_post((unsigned*)(ws + WS_BAR), (volatile LAS unsigned*)(lds + LDS_BARW));
#define SEAM(k) do { if (IN(k) && IN((k) + 1)) { xcd_barrier(xbar); } } while (0)
    if (p.ph_hi > 1000) cg::this_grid().sync();
    auto small = [&](int i) { return (bf16_t*)(ws + WS_SMALL + (size_t)i * SMALL_B); };
    TV tU{(bf16_t*)(ws + WS_U), small(SM_U)}, tQ{(bf16_t*)p.out, small(SM_Q)}, tK{(bf16_t*)((unsigned char*)p.out + 64 * MiB), small(SM_K)},
       tV{(bf16_t*)(ws + WS_V), small(SM_V)}, tOG{(bf16_t*)(ws + WS_OG), small(SM_OG)}, tXB{(bf16_t*)(ws + WS_XB), small(SM_XB)},
       tSZB{(bf16_t*)(ws + WS_SZB), small(SM_SZB)}, tGA{(bf16_t*)(ws + WS_GA), small(SM_GA)}, tGB{(bf16_t*)(ws + WS_GB), small(SM_GB)};
    if (IN(0)) { phase0(p, lds); } SEAM(0);
    if (IN(1)) { phase1(p, lds); } SEAM(1);
#if REP01 > 1
    phase0(p, lds); cg::this_grid().sync(); phase1(p, lds); cg::this_grid().sync();
#endif
    if (IN(2)) {
        pg8::StaticOrder S; S.init(129, 36, gridDim.x, blockIdx.x);
        Epi1 E{tQ, tK, tV, tOG, tXB, tSZB, tGA, tGB, p.in[23]};
        Prob1 P{tU, (const bf16_t*)(ws + WS_W1T)};
        pg8::gemm_phase(lds, DM, S, E, P);
    } SEAM(2);
    if (IN(3)) { phase3(p, lds); } SEAM(3);
    if (IN(5)) {
        {
            pg8::PairOrder S0; S0.init(128, 4, gridDim.x, blockIdx.x);
            const int ord = threadIdx.x >> 8, rl = threadIdx.x & 255; pg8::Unit u0;
            if (S0.next(2 * ord, u0)) { const float* hss = (const float*)(ws + WS_HSS) + (size_t)(u0.pm * 256 + rl) * 16; f32x4 o;
#pragma unroll
                for (int hd = 0; hd < 4; ++hd) { const f32x4 hs = *(const f32x4*)(hss + hd * 4); o[hd] = rsqrtf(((hs[0] + hs[1]) + (hs[2] + hs[3])) * (1.0f / 256.0f) + EPS); }
                *(LAS f32x4*)(lds + RS_OFF + (ord * 256 + rl) * 16) = o; }
            __syncthreads();
        }
        pg8::PairOrder S; S.init(128, 4, gridDim.x, blockIdx.x);
        Epi2 E{tGA, tGB, tU};
        Prob2 P{tV, tSZB, (const bf16_t*)(ws + WS_WAT), (const bf16_t*)(ws + WS_WBT)};
        pg8::gemm_phase(lds, DM, S, E, P);
        mini_gemm2(p, lds);
#if REP56 > 1
        cg::this_grid().sync();
        pg8::gemm_phase(lds, DM, S, E, P);
#endif
    } SEAM(5);
    if (IN(6)) {
        pg8::StaticOrder S; S.init(128, 4, gridDim.x, blockIdx.x);
        Epi3 E{p.in[0], (bf16_t*)(ws + WS_V), (const float*)(ws + WS_MODG), (float*)(ws + WS_ROWSS)};
        Prob3 P{tU, (const bf16_t*)(ws + WS_WOT)};
        pg8::gemm_phase(lds, DM, S, E, P);
        mini_gemm3(p, lds);
#if REP56 > 1
        cg::this_grid().sync();
        pg8::gemm_phase(lds, DM, S, E, P);
#endif
    } SEAM(6);
    if (IN(7)) { phase7(p); }
#if SYNC_PROBE
    for (int i_ = 0; i_ < 8; ++i_) cg::this_grid().sync();
#endif
#undef IN
#undef SEAM
}

extern "C" void kernel_launch(void* const* d_in, const int* in_sizes, int n_in, void* d_out, int out_size, void* d_ws, size_t ws_size, hipStream_t stream) {
    static int grid = 0;
    if (grid == 0) {
        if (n_in != 28 || out_size != (int)O_END || ws_size < WS_END) { fprintf(stderr, "kernel_launch: unexpected shapes (n_in %d out %d ws %zu)\n", n_in, out_size, ws_size); grid = -1; return; }
        int dev = 0, cus = 0, per_cu = 0;
        hipGetDevice(&dev); hipDeviceGetAttribute(&cus, hipDeviceAttributeMultiprocessorCount, dev);
        hipFuncSetAttribute((const void*)fwd_kernel, hipFuncAttributeMaxDynamicSharedMemorySize, LDS_BYTES);
        hipOccupancyMaxActiveBlocksPerMultiprocessor(&per_cu, (const void*)fwd_kernel, 512, LDS_BYTES);
        if (per_cu < 1) { fprintf(stderr, "kernel_launch: occupancy query says %d blocks per CU\n", per_cu); grid = -1; return; }
        grid = cus;
        (void)hipGetLastError();
    }
    if (grid < 0) return;
    Params p{};
    for (int i = 0; i < 28; ++i) p.in[i] = (const float*)d_in[i];
    p.out = (float*)d_out; p.ws = (unsigned char*)d_ws; p.probe = PROBE_MODE;
#if MK_ONE_LAUNCH
    if (hipMemsetAsync((char*)d_ws + WS_BAR, 0, 16384, stream) != hipSuccess) { fprintf(stderr, "kernel_launch: memset of the barrier words failed\n"); return; }
    p.ph_lo = 0; p.ph_hi = 8;
    void* args[] = {&p};
    hipError_t e = hipLaunchCooperativeKernel((const void*)fwd_kernel, dim3(grid), dim3(512), args, LDS_BYTES, stream);
    if (e != hipSuccess) fprintf(stderr, "cooperative launch failed: %s (grid %d)\n", hipGetErrorString(e), grid);
#else
    for (int k = 0; k < 8; ++k) { p.ph_lo = k; p.ph_hi = k + 1; hipLaunchKernelGGL(fwd_kernel, dim3(grid), dim3(512), LDS_BYTES, stream, p); }
#endif
}
```

```cpp
#include <hip/hip_runtime.h>
#include <hip/hip_cooperative_groups.h>
#include <cstdio>
#include <cstdint>
namespace cg = cooperative_groups;

#ifndef GEMM_DRAIN
#define GEMM_DRAIN 0
#endif
#ifndef SYNC_PROBE
#define SYNC_PROBE 0
#endif
#ifndef MK_ONE_LAUNCH
#define MK_ONE_LAUNCH 1
#endif

#define LAS __attribute__((address_space(3)))
typedef unsigned short bf16_t;
typedef short bf16x8 __attribute__((ext_vector_type(8)));
typedef short s16x4 __attribute__((ext_vector_type(4)));
typedef float f32x4 __attribute__((ext_vector_type(4)));
typedef unsigned u32x4 __attribute__((ext_vector_type(4)));
typedef unsigned u32x2 __attribute__((ext_vector_type(2)));

constexpr int DM = 1024, NTP = 32768, NTS = 128, NTT = NTP + NTS, SEQ = 2048, DSEQ = 16;
constexpr int DIN = 7176;
constexpr float EPS = 1e-6f;
constexpr size_t MiB = 1u << 20;
constexpr size_t WS_U = 0 * MiB, WS_V = 64 * MiB, WS_OG = 128 * MiB, WS_XB = 192 * MiB, WS_SZB = 256 * MiB, WS_GA = 320 * MiB, WS_GB = 384 * MiB;
constexpr size_t WS_W1T = 448 * MiB, WS_WAT = 466 * MiB, WS_WBT = 468 * MiB, WS_WOT = 470 * MiB, WS_WRAT = 472 * MiB, WS_WRXT = 472 * MiB + 256 * 1024;
constexpr size_t WS_SMALL = 473 * MiB, SMALL_B = 512 * 1024;
enum { SM_U = 0, SM_Q, SM_K, SM_V, SM_OG, SM_XB, SM_SZB, SM_GA, SM_GB, SM_N };
constexpr size_t WS_IF = 478 * MiB, WS_HSS = 480 * MiB, WS_ROWSS = 483 * MiB, WS_MODP = 486 * MiB, WS_WIF = 488 * MiB, WS_BAR = 489 * MiB, WS_END = 490 * MiB, WS_MODG = 487 * MiB + 256 * 1024;
constexpr size_t O_YP = 0, O_YS = 33554432, O_CP = 33685504, O_NP = 37879808, O_MP = 37896192, O_HP = 37896256, O_CVP = 37912640,
                 O_CS = 37961792, O_NS = 40058944, O_MS = 40067136, O_HS = 40067168, O_CVS = 40075360, O_END = 40099936;
constexpr int LDS_BYTES = 151552, LDS_BARW = 151040, RS_OFF = 131072, PF_OFF = 139264;

struct Params { const float* in[28]; float* out; unsigned char* ws; int ph_lo, ph_hi, probe, pad; };

typedef float f32x2_t __attribute__((ext_vector_type(2)));
typedef __bf16 bf16x2_t __attribute__((ext_vector_type(2)));
__device__ __forceinline__ unsigned pk2(float lo, float hi) { f32x2_t v = {lo, hi}; bf16x2_t b = __builtin_convertvector(v, bf16x2_t); return __builtin_bit_cast(unsigned, b); }
__device__ __forceinline__ unsigned f2bf(float f) { return pk2(f, 0.f) & 0xffffu; }
__device__ __forceinline__ float bf2f(unsigned b) { return __uint_as_float(b << 16); }
__device__ __forceinline__ float bflo(unsigned w) { return __uint_as_float(w << 16); }
__device__ __forceinline__ float bfhi(unsigned w) { return __uint_as_float(w & 0xffff0000u); }
__device__ __forceinline__ float sigm(float x) { return __builtin_amdgcn_rcpf(1.0f + __expf(-x)); }
__device__ __forceinline__ float wave_sum_bperm(float v) {
#pragma unroll
    for (int o = 1; o < 64; o <<= 1) v += __shfl_xor(v, o);
    return v;
}

template <int CTRL, int ROWMASK> __device__ __forceinline__ float dpp_f(float oldv, float src) {
    return __builtin_bit_cast(float, __builtin_amdgcn_update_dpp(__builtin_bit_cast(int, oldv), __builtin_bit_cast(int, src), CTRL, ROWMASK, 0xf, false)); }
__device__ __forceinline__ float row16_sum(float v) {
    v += dpp_f<0xB1, 0xf>(0.f, v); v += dpp_f<0x4E, 0xf>(0.f, v); v += dpp_f<0x124, 0xf>(0.f, v); v += dpp_f<0x128, 0xf>(0.f, v); return v; }
__device__ __forceinline__ float wave_sum(float v) {
    v = row16_sum(v);
    const int iv = __builtin_bit_cast(int, v);
    const float r0 = __builtin_bit_cast(float, __builtin_amdgcn_readlane(iv, 0)), r1 = __builtin_bit_cast(float, __builtin_amdgcn_readlane(iv, 16));
    const float r2 = __builtin_bit_cast(float, __builtin_amdgcn_readlane(iv, 32)), r3 = __builtin_bit_cast(float, __builtin_amdgcn_readlane(iv, 48));
    return (r0 + r1) + (r2 + r3);
}
__device__ __forceinline__ float wave_scan_add(float v) {
    v += dpp_f<0x111, 0xf>(0.f, v); v += dpp_f<0x112, 0xf>(0.f, v); v += dpp_f<0x114, 0xf>(0.f, v); v += dpp_f<0x118, 0xf>(0.f, v);
    v += dpp_f<0x142, 0xa>(0.f, v); v += dpp_f<0x143, 0xc>(0.f, v); return v; }
__device__ __forceinline__ float wave_scan_max(float v) {
    const float ninf = -INFINITY;
    v = fmaxf(v, dpp_f<0x111, 0xf>(ninf, v)); v = fmaxf(v, dpp_f<0x112, 0xf>(ninf, v)); v = fmaxf(v, dpp_f<0x114, 0xf>(ninf, v)); v = fmaxf(v, dpp_f<0x118, 0xf>(ninf, v));
    v = fmaxf(v, dpp_f<0x142, 0xa>(ninf, v)); v = fmaxf(v, dpp_f<0x143, 0xc>(ninf, v)); return v; }
#define LDS_WAIT() asm volatile("s_waitcnt lgkmcnt(0)" ::: "memory")
#define BAR_LDS() do { asm volatile("s_waitcnt lgkmcnt(0)" ::: "memory"); __builtin_amdgcn_s_barrier(); asm volatile("" ::: "memory"); } while (0)

namespace pg8 {
constexpr int BM = 256, BK = 64, HALF = 128, HTB = HALF * BK * 2, STAGE_BYTES = 8 * HTB, NXCD = 8, WGM = 8;
__host__ __device__ __forceinline__ int lds_byte(int r, int c) { const int st = (r >> 4) * 2 + (c >> 5), rr = r & 15, cc = c & 31, ob = rr * 64 + cc * 2; return st * 1024 + (ob ^ (((ob >> 9) & 1) << 5)); }
__host__ __device__ __forceinline__ void stage_rc(int b, int& R, int& C) { const int st = b / 1024, sb = b % 1024, swz = sb ^ (((sb >> 9) & 1) << 5); R = (st >> 1) * 16 + swz / 64; C = (st & 1) * 32 + (swz % 64) / 2; }
__host__ __device__ __forceinline__ int perm32(int rho) { const int n = rho >> 4, i = rho & 15; return 8 * (i >> 2) + 4 * n + (i & 3); }

struct Unit { int pm, pn, sub, slot; };
struct StaticOrder {
    int nM, nN, nwg, G, c;
    __device__ void init(int nM_, int nN_, int G_, int c_) { nM = nM_; nN = nN_; nwg = nM * nN; G = G_; c = c_; }
    __device__ bool tile(int i, Unit& u) const {
        const long L = (long)i * G + c; if (L >= nwg) return false;
        int wgid = (int)L; { const int q = nwg / NXCD, r = nwg % NXCD, xcd = wgid % NXCD, off = wgid / NXCD; wgid = (xcd < r ? xcd * (q + 1) : r * (q + 1) + (xcd - r) * q) + off; }
        const int nig = WGM * nN, gid = wgid / nig, fm = gid * WGM, gsz = (nM - fm) < WGM ? (nM - fm) : WGM;
        u.pm = fm + ((wgid % nig) % gsz); u.pn = (wgid % nig) / gsz; u.sub = 0; u.slot = 0; return true;
    }
    __device__ bool next(int i, Unit& u) const { return tile(i, u); }
};
struct PairOrder : StaticOrder {
    __device__ bool next(int i, Unit& u) const { if (!tile(i >> 1, u)) return false; u.sub = i & 1; u.slot = (i >> 1) & 1; return true; }
};
__device__ __forceinline__ unsigned cvt_pk_bf16(float lo, float hi) { return pk2(lo, hi); }

template <class Epi, class Sched, class Prob>
__device__ __forceinline__ void gemm_phase(LAS unsigned char* lds, const int K, const Sched& S, const Epi& E, const Prob& P) {
    const int tid = threadIdx.x, wid = __builtin_amdgcn_readfirstlane(tid >> 6), lane = tid & 63, wr = wid >> 2, wc = wid & 3, fr = lane & 15, fq = lane >> 4;
    const int nt = K / BK;
    unsigned voffA[2], voffB[2];
#pragma unroll
    for (int i = 0; i < 2; ++i) { int R, C; stage_rc(tid * 16 + i * 8192, R, C); const int Rb = Epi::PERM ? ((R & ~31) + perm32(R & 31)) : R;
        voffA[i] = (unsigned)(R * K + C) * 2u; voffB[i] = (unsigned)(Rb * K + C) * 2u; }
    const size_t kstep = (size_t)(BK * 2);
    const size_t hstep = (size_t)HALF * K * 2;
    const unsigned ldsw = (unsigned)wid * 1024u;
    const int aoff = lds_byte(wr * 64 + fr, fq * 8), boff = lds_byte(wc * 32 + fr, fq * 8);
#define PG8_SA(b, h) (((b) * 2 + (h)) * HTB)
#define PG8_SB(b, h) ((4 + (b) * 2 + (h)) * HTB)
#define PG8_STAGE(bufoff, gbase, voff) do { _Pragma("unroll") for (int _i = 0; _i < 2; ++_i) \
        __builtin_amdgcn_global_load_lds((const unsigned*)((const char*)(gbase) + (voff)[_i]), (LAS unsigned*)(lds + (bufoff) + ldsw + _i * 8192), 16, 0, 0); } while (0)
#define PG8_LDA(dst, b, h) do { _Pragma("unroll") for (int m = 0; m < 4; ++m) _Pragma("unroll") for (int k = 0; k < 2; ++k) dst[m][k] = *(const LAS bf16x8*)(lds + PG8_SA(b, h) + aoff + m * 2048 + k * 1024); } while (0)
#define PG8_LDB(dst, b, h) do { _Pragma("unroll") for (int n = 0; n < 2; ++n) _Pragma("unroll") for (int k = 0; k < 2; ++k) dst[n][k] = *(const LAS bf16x8*)(lds + PG8_SB(b, h) + boff + n * 2048 + k * 1024); } while (0)
#define PG8_MMA(ai, bj, At, Bt) do { __builtin_amdgcn_sched_barrier(0); _Pragma("unroll") for (int m = 0; m < 4; ++m) _Pragma("unroll") for (int n = 0; n < 2; ++n) _Pragma("unroll") for (int k = 0; k < 2; ++k) \
        acc[ai][bj][m][n] = __builtin_amdgcn_mfma_f32_16x16x32_bf16(Bt[n][k], At[m][k], acc[ai][bj][m][n], 0, 0, 0); __builtin_amdgcn_sched_barrier(0); } while (0)
#define PG8_WAIT_V(n) asm volatile("s_waitcnt vmcnt(" #n ")" ::: "memory")
#define PG8_WAIT_L(n) asm volatile("s_waitcnt lgkmcnt(" #n ")" ::: "memory")
#define PG8_BAR __builtin_amdgcn_s_barrier()
#define PG8_SCHED __builtin_amdgcn_sched_barrier(0)
    Unit cur, nxt; int ui = 0;
    if (!S.next(0, cur)) return;
    f32x4 acc[2][2][4][2];
#pragma unroll
    for (int a = 0; a < 2; ++a)
#pragma unroll
        for (int b = 0; b < 2; ++b)
#pragma unroll
            for (int m = 0; m < 4; ++m)
#pragma unroll
                for (int n = 0; n < 2; ++n) acc[a][b][m][n] = (f32x4){0.f, 0.f, 0.f, 0.f};
    bf16x8 At[4][2], B0[2][2], B1[2][2];
    const char* cA = P.a(cur); const char* cB = P.b(cur);
    PG8_STAGE(PG8_SB(0, 0), cB, voffB); PG8_STAGE(PG8_SA(0, 0), cA, voffA); PG8_STAGE(PG8_SB(0, 1), cB + hstep, voffB); PG8_STAGE(PG8_SA(0, 1), cA + hstep, voffA);
    if (wr == 1) PG8_BAR;
    PG8_WAIT_V(4); PG8_BAR;
    PG8_STAGE(PG8_SB(1, 0), cB + kstep, voffB); PG8_STAGE(PG8_SA(1, 0), cA + kstep, voffA); PG8_STAGE(PG8_SB(1, 1), cB + hstep + kstep, voffB);
    PG8_WAIT_V(6); PG8_BAR;
    for (;;) {
        const bool has_next = S.next(ui + 1, nxt);
        const char* nA = has_next ? P.a(nxt) : cA; const char* nB = has_next ? P.b(nxt) : cB;
        for (int t = 0; t < nt; t += 2) {
            const bool last = (t == nt - 2);
#if GEMM_DRAIN
            PG8_WAIT_V(0);
#endif
            E.mid(acc, cur, t, wr, fr, lds);
            const char* a1 = cA + (size_t)(t + 1) * kstep;
            const char* a2 = last ? nA : cA + (size_t)(t + 2) * kstep; const char* b2 = last ? nB : cB + (size_t)(t + 2) * kstep;
            const char* a3 = a2 + kstep; const char* b3 = b2 + kstep;
            PG8_LDB(B0, 0, 0); PG8_SCHED; PG8_LDA(At, 0, 0); PG8_STAGE(PG8_SA(1, 1), a1 + hstep, voffA);
            PG8_WAIT_L(8); PG8_BAR; PG8_WAIT_L(0); PG8_MMA(0, 0, At, B0); PG8_BAR; PG8_SCHED;
            PG8_LDB(B1, 0, 1); PG8_STAGE(PG8_SB(0, 0), b2, voffB);
            PG8_BAR; PG8_WAIT_L(0); PG8_MMA(0, 1, At, B1); PG8_BAR;
            PG8_LDA(At, 0, 1); PG8_STAGE(PG8_SA(0, 0), a2, voffA);
            PG8_BAR; PG8_WAIT_L(0); PG8_MMA(1, 0, At, B0); PG8_BAR; PG8_SCHED;
            PG8_STAGE(PG8_SB(0, 1), b2 + hstep, voffB);
            PG8_WAIT_V(6); PG8_BAR; PG8_MMA(1, 1, At, B1); PG8_BAR;
            PG8_LDB(B0, 1, 0); PG8_SCHED; PG8_LDA(At, 1, 0); PG8_STAGE(PG8_SA(0, 1), a2 + hstep, voffA);
            PG8_WAIT_L(8); PG8_BAR; PG8_WAIT_L(0); PG8_MMA(0, 0, At, B0); PG8_BAR; PG8_SCHED;
            PG8_LDB(B1, 1, 1); PG8_STAGE(PG8_SB(1, 0), b3, voffB);
            PG8_BAR; PG8_WAIT_L(0); PG8_MMA(0, 1, At, B1); PG8_BAR;
            PG8_LDA(At, 1, 1); PG8_STAGE(PG8_SA(1, 0), a3, voffA);
            PG8_BAR; PG8_WAIT_L(0); PG8_MMA(1, 0, At, B0); PG8_BAR; PG8_SCHED;
            PG8_STAGE(PG8_SB(1, 1), b3 + hstep, voffB);
            PG8_WAIT_V(6); PG8_BAR; PG8_MMA(1, 1, At, B1); PG8_BAR;
        }
        E(acc, cur, wr, wc, fr, fq, lds);
        if (!has_next) break;
        cur = nxt; cA = nA; cB = nB; ++ui;
    }
    PG8_WAIT_V(0);
    if (wr == 0) PG8_BAR;
    PG8_BAR;
#undef PG8_SA
#undef PG8_SB
#undef PG8_STAGE
#undef PG8_LDA
#undef PG8_LDB
#undef PG8_MMA
#undef PG8_WAIT_V
#undef PG8_WAIT_L
#undef PG8_BAR
#undef PG8_SCHED
}
#define ACC_ZERO(acc) do { _Pragma("unroll") for (int a_ = 0; a_ < 2; ++a_) _Pragma("unroll") for (int b_ = 0; b_ < 2; ++b_) _Pragma("unroll") for (int m_ = 0; m_ < 4; ++m_) _Pragma("unroll") for (int n_ = 0; n_ < 2; ++n_) acc[a_][b_][m_][n_] = (f32x4){0.f, 0.f, 0.f, 0.f}; } while (0)
}


#define XB_TMO      128
#define XB_XCNT(j)  (256  + 64 * (j))
#define XB_XSUB(j)  (1280 + 64 * (j))
#define XB_XGEN(j)  (2304 + 64 * (j))
#define XB_TOP      3328
#define XB_TOPGEN   3392
#define XCD_BAR_WORDS 3456
#define XB_SPIN_CAP (1u << 18)

__device__ __forceinline__ unsigned xb_ld(unsigned* p)              { return __hip_atomic_load(p, __ATOMIC_RELAXED, __HIP_MEMORY_SCOPE_AGENT); }
__device__ __forceinline__ unsigned xb_add(unsigned* p, unsigned v) { return __hip_atomic_fetch_add(p, v, __ATOMIC_RELAXED, __HIP_MEMORY_SCOPE_AGENT); }
__device__ __forceinline__ unsigned xb_xcc_id() { return (unsigned)__builtin_amdgcn_s_getreg((3 << 11) | 20) & 0xFu; }
#define XB_SPIN(cond, bar) do { unsigned _sp = 0; while (cond) { __builtin_amdgcn_s_sleep(1); \
    if ((++_sp & 255u) == 0u) { if (xb_ld(&(bar)[XB_TMO])) break; if (_sp > XB_SPIN_CAP) { atomicAdd(&(bar)[XB_TMO], 1u); break; } } } } while (0)

struct XcdBarrier {
    unsigned* bar; unsigned x;
    volatile LAS unsigned* st;
};

__device__ __forceinline__ XcdBarrier xcd_barrier_post(unsigned* bar, volatile LAS unsigned* st) {
    XcdBarrier b; b.bar = bar; b.x = xb_xcc_id(); b.st = st;
    if (threadIdx.x == 0) (void)xb_add(&bar[XB_XCNT(b.x)], 1u);
    return b;
}
__device__ __forceinline__ void xcd_barrier_complete(unsigned* bar, unsigned x, unsigned& nloc, unsigned& nx) {
    const unsigned G = gridDim.x * gridDim.y * gridDim.z;
    unsigned sum, cnt, mine, sp = 0u;
    for (;;) {
        sum = 0u; cnt = 0u; mine = 0u;
#pragma unroll
        for (unsigned j = 0; j < 16; ++j) { const unsigned c = xb_ld(&bar[XB_XCNT(j)]); sum += c; cnt += (c > 0u) ? 1u : 0u; mine = (j == x) ? c : mine; }
        if (sum == G) break;
        __builtin_amdgcn_s_sleep(1);
        if ((++sp & 255u) == 0u) { if (xb_ld(&bar[XB_TMO])) break; if (sp > XB_SPIN_CAP) { atomicAdd(&bar[XB_TMO], 1u); break; } }
    }
    nloc = mine > 0u ? mine : 1u; nx = cnt > 0u ? cnt : 1u;
}

__device__ __forceinline__ void xcd_barrier(const XcdBarrier& b) {
    asm volatile("s_waitcnt vmcnt(0)" ::: "memory");
    __syncthreads();
    if (threadIdx.x == 0) {
        unsigned* bar = b.bar;
        __builtin_amdgcn_s_waitcnt(0);
        unsigned nloc = b.st[0], nx = b.st[1];
        if (nloc == 0u) { xcd_barrier_complete(bar, b.x, nloc, nx); b.st[0] = nloc; b.st[1] = nx; }
        const unsigned old = xb_add(&bar[XB_XSUB(b.x)], 1u);
        const unsigned gen = old / nloc;
        if (old + 1u == (gen + 1u) * nloc) {
            __builtin_amdgcn_fence(__ATOMIC_RELEASE, "agent");
            asm volatile("s_waitcnt vmcnt(0)" ::: "memory");
            const unsigned og = xb_add(&bar[XB_TOP], 1u);
            const unsigned tg = og / nx;
            if (og + 1u == (tg + 1u) * nx) xb_add(&bar[XB_TOPGEN], 1u);
            else XB_SPIN(xb_ld(&bar[XB_TOPGEN]) == tg, bar);
            __builtin_amdgcn_fence(__ATOMIC_ACQUIRE, "agent");
            xb_add(&bar[XB_XGEN(b.x)], 1u);
            asm volatile("s_waitcnt vmcnt(0)" ::: "memory");
        } else {
            XB_SPIN(xb_ld(&bar[XB_XGEN(b.x)]) == gen, bar);
            __builtin_amdgcn_fence(__ATOMIC_ACQUIRE, "agent");
            asm volatile("s_waitcnt vmcnt(0)" ::: "memory");
        }
    }
    __syncthreads();
}


struct TV { bf16_t* big; bf16_t* sm; };
__device__ __forceinline__ bf16_t* tv_tile(const TV& t, int pm) { return pm < 128 ? t.big + (size_t)pm * 256 * DM : t.sm; }
__device__ __forceinline__ bf16_t* tv_row(const TV& t, int row) { return row < NTP ? t.big + (size_t)row * DM : t.sm + (size_t)(row - NTP) * DM; }

struct Epi1 {
    static constexpr bool PERM = true;
    __device__ __forceinline__ void mid(f32x4 (&)[2][2][4][2], const pg8::Unit&, int, int, int, LAS unsigned char*) const {}
    TV Q, K, V, OG, XB, SZB, GA, GB; const float* b_gate;
    __device__ __forceinline__ void operator()(f32x4 (&acc)[2][2][4][2], const pg8::Unit& u, int wr, int wc, int fr, int fq, LAS unsigned char* lds) const {
        const int pn = u.pn; int type, colt; TV tv; const float* bias = nullptr;
        if (pn < 4) { type = 0; tv = Q; colt = pn * 256; }
        else if (pn < 8) { type = 1; tv = K; colt = (pn - 4) * 256; }
        else if (pn < 12) { type = 0; tv = V; colt = (pn - 8) * 256; }
        else if (pn < 20) { type = 2; tv = OG; colt = (pn - 12) * 128; }
        else if (pn < 24) { type = 0; tv = XB; colt = (pn - 20) * 256; }
        else if (pn < 28) { type = 3; tv = SZB; colt = (pn - 24) * 256; }
        else { type = 4; tv = GA; colt = (pn - 28) * 128; bias = b_gate + colt; }
        bf16_t* base = tv_tile(tv, u.pm);
        const int nai = (u.pm < 128) ? 2 : 1;
        const int cl = wc * 32 + 8 * fq;
        if (type == 2) {
#pragma unroll
            for (int ai = 0; ai < 2; ++ai) if (ai < nai)
#pragma unroll
                for (int m = 0; m < 4; ++m) {
                    bf16_t* rowp = base + (size_t)(ai * 128 + wr * 64 + m * 16 + fr) * DM + colt + cl;
                    float v[8];
#pragma unroll
                    for (int n = 0; n < 2; ++n)
#pragma unroll
                        for (int j = 0; j < 4; ++j) { const float o = acc[ai][0][m][n][j], z = acc[ai][1][m][n][j]; v[n * 4 + j] = sigm(o) * z * sigm(z); }
                    u32x4 w; w.x = pg8::cvt_pk_bf16(v[0], v[1]); w.y = pg8::cvt_pk_bf16(v[2], v[3]); w.z = pg8::cvt_pk_bf16(v[4], v[5]); w.w = pg8::cvt_pk_bf16(v[6], v[7]);
                    *(u32x4*)rowp = w;
                }
        } else if (type == 4) {
            f32x4 bv[2][2];
#pragma unroll
            for (int bj = 0; bj < 2; ++bj)
#pragma unroll
                for (int n = 0; n < 2; ++n) bv[bj][n] = *(const f32x4*)(bias + bj * 1024 + cl + 4 * n);
            bf16_t* baseb = tv_tile(GB, u.pm);
#pragma unroll
            for (int ai = 0; ai < 2; ++ai) if (ai < nai)
#pragma unroll
                for (int m = 0; m < 4; ++m) {
                    const size_t ro = (size_t)(ai * 128 + wr * 64 + m * 16 + fr) * DM + colt + cl;
                    float vr[8], vg[8];
#pragma unroll
                    for (int n = 0; n < 2; ++n)
#pragma unroll
                        for (int j = 0; j < 4; ++j) { const float ea = __expf(-(acc[ai][0][m][n][j] + bv[0][n][j])), eb = __expf(-fmaxf(acc[ai][1][m][n][j] + bv[1][n][j], -30.f));
                            vg[n * 4 + j] = __builtin_amdgcn_rcpf(1.0f + eb); vr[n * 4 + j] = (1.0f + eb) * __builtin_amdgcn_rcpf(1.0f + ea); }
                    u32x4 w; w.x = pg8::cvt_pk_bf16(vr[0], vr[1]); w.y = pg8::cvt_pk_bf16(vr[2], vr[3]); w.z = pg8::cvt_pk_bf16(vr[4], vr[5]); w.w = pg8::cvt_pk_bf16(vr[6], vr[7]);
                    *(u32x4*)(base + ro) = w;
                    w.x = pg8::cvt_pk_bf16(vg[0], vg[1]); w.y = pg8::cvt_pk_bf16(vg[2], vg[3]); w.z = pg8::cvt_pk_bf16(vg[4], vg[5]); w.w = pg8::cvt_pk_bf16(vg[6], vg[7]);
                    *(u32x4*)(baseb + ro) = w;
                }
        } else {
            const float sc = (type == 1) ? 0.0625f : 1.0f; const bool silu = (type == 3);
#pragma unroll
            for (int ai = 0; ai < 2; ++ai) if (ai < nai)
#pragma unroll
                for (int m = 0; m < 4; ++m) {
                    bf16_t* rowp = base + (size_t)(ai * 128 + wr * 64 + m * 16 + fr) * DM + colt + cl;
#pragma unroll
                    for (int bj = 0; bj < 2; ++bj) {
                        float v[8];
#pragma unroll
                        for (int n = 0; n < 2; ++n)
#pragma unroll
                            for (int j = 0; j < 4; ++j) { float x = acc[ai][bj][m][n][j] * sc; if (silu) x = x * sigm(x); v[n * 4 + j] = x; }
                        u32x4 w; w.x = pg8::cvt_pk_bf16(v[0], v[1]); w.y = pg8::cvt_pk_bf16(v[2], v[3]); w.z = pg8::cvt_pk_bf16(v[4], v[5]); w.w = pg8::cvt_pk_bf16(v[6], v[7]);
                        *(u32x4*)(rowp + bj * 128) = w;
                    }
                }
        }
        ACC_ZERO(acc);
    }
};
struct Prob1 { TV U; const bf16_t* W;
    __device__ __forceinline__ const char* a(const pg8::Unit& u) const { return (const char*)tv_tile(U, u.pm); }
    __device__ __forceinline__ const char* b(const pg8::Unit& u) const { return (const char*)(W + (size_t)u.pn * 256 * DM); } };

struct Epi2 {
    static constexpr bool PERM = true;
    __device__ __forceinline__ void mid(f32x4 (&acc)[2][2][4][2], const pg8::Unit& u, int t, int wr, int fr, LAS unsigned char* lds) const {
        if (u.sub != 0 || t == 0 || (t & 3) != 0) return;
        const int hd = t >> 2;
        const LAS float* RS = (const LAS float*)(lds + RS_OFF) + u.slot * 1024;
#pragma unroll
        for (int ai = 0; ai < 2; ++ai)
#pragma unroll
            for (int m = 0; m < 4; ++m) { const int rl = ai * 128 + wr * 64 + m * 16 + fr;
                const float ratio = RS[rl * 4 + hd - 1] * __builtin_amdgcn_rcpf(RS[rl * 4 + hd]);
#pragma unroll
                for (int bj = 0; bj < 2; ++bj)
#pragma unroll
                    for (int n = 0; n < 2; ++n) acc[ai][bj][m][n] = acc[ai][bj][m][n] * ratio; }
    }
    TV GA, GB, MG;
    __device__ __forceinline__ void operator()(f32x4 (&acc)[2][2][4][2], const pg8::Unit& u, int wr, int wc, int fr, int fq, LAS unsigned char* lds) const {
        const bf16_t* ga = tv_tile(GA, u.pm); const bf16_t* gb = tv_tile(GB, u.pm); bf16_t* mg = tv_tile(MG, u.pm);
        {
            int t_ = threadIdx.x; asm volatile("" : "+v"(t_));
            const unsigned off0 = (unsigned)(((t_ >> 6) * 32 + (t_ & 63) / 4) << 11) + (unsigned)((t_ & 3) << 7);
            const char* gbt = (const char*)(gb + u.pn * 256); const char* gat = (const char*)(ga + u.pn * 256);
#pragma unroll
            for (int q = 0; q < 2; ++q) __builtin_amdgcn_global_load_lds((const unsigned*)((u.sub == 0 ? gat : gbt) + off0 + q * 32768u), (LAS unsigned*)(lds + PF_OFF), 16, 0, 0);
        }
        const int nai = (u.pm < 128) ? 2 : 1;
        const int col0 = u.pn * 256 + wc * 32 + 8 * fq;
#pragma unroll
        for (int ai = 0; ai < 2; ++ai) if (ai < nai)
#pragma unroll
            for (int m = 0; m < 4; ++m) {
                const size_t ro = (size_t)(ai * 128 + wr * 64 + m * 16 + fr) * DM + col0;
                const float rs3 = ((const LAS float*)(lds + RS_OFF))[u.slot * 1024 + (ai * 128 + wr * 64 + m * 16 + fr) * 4 + 3];
#pragma unroll
                for (int bj = 0; bj < 2; ++bj) {
                    const u32x4 gbw = *(const u32x4*)((u.sub == 0 ? ga : gb) + ro + bj * 128);
                    float gbv[8] = {bflo(gbw.x), bfhi(gbw.x), bflo(gbw.y), bfhi(gbw.y), bflo(gbw.z), bfhi(gbw.z), bflo(gbw.w), bfhi(gbw.w)};
                    if (u.sub == 0) {
#pragma unroll
                        for (int n = 0; n < 2; ++n)
#pragma unroll
                            for (int j = 0; j < 4; ++j) acc[ai][bj][m][n][j] *= rs3 * gbv[n * 4 + j];
                    } else {
                        float v[8];
#pragma unroll
                        for (int n = 0; n < 2; ++n)
#pragma unroll
                            for (int j = 0; j < 4; ++j) v[n * 4 + j] = acc[ai][bj][m][n][j] * gbv[n * 4 + j];
                        u32x4 w; w.x = pg8::cvt_pk_bf16(v[0], v[1]); w.y = pg8::cvt_pk_bf16(v[2], v[3]); w.z = pg8::cvt_pk_bf16(v[4], v[5]); w.w = pg8::cvt_pk_bf16(v[6], v[7]);
                        *(u32x4*)(mg + ro + bj * 128) = w;
                    }
                }
            }
        if (u.sub == 1) ACC_ZERO(acc);
    }
};
struct Prob2 { TV YA, YB; const bf16_t* WA; const bf16_t* WB;
    __device__ __forceinline__ const char* a(const pg8::Unit& u) const { return (const char*)tv_tile(u.sub ? YB : YA, u.pm); }
    __device__ __forceinline__ const char* b(const pg8::Unit& u) const { return (const char*)((u.sub ? WB : WA) + (size_t)u.pn * 256 * DM); } };

struct Epi3 {
    static constexpr bool PERM = true;
    __device__ __forceinline__ void mid(f32x4 (&)[2][2][4][2], const pg8::Unit&, int, int, int, LAS unsigned char*) const {}
    const float* xp; bf16_t* yb; const float* modg; float* rowss;
    __device__ __forceinline__ void operator()(f32x4 (&acc)[2][2][4][2], const pg8::Unit& u, int wr, int wc, int fr, int fq, LAS unsigned char* lds) const {
        const int col0 = u.pn * 256 + wc * 32 + 8 * fq;
        const float* xb = xp + (size_t)u.pm * 256 * DM;
        int t_ = threadIdx.x; asm volatile("" : "+v"(t_));
        const int rl_ = (t_ >> 8) * 64 + (t_ & 15);
        {
            const char* xt = (const char*)(xb + u.pn * 256);
            const unsigned off0 = (unsigned)(((t_ >> 6) * 32 + (t_ & 63) / 8) << 12) + (unsigned)((t_ & 7) << 7);
#pragma unroll
            for (int q = 0; q < 4; ++q) __builtin_amdgcn_global_load_lds((const unsigned*)(xt + off0 + q * 32768u), (LAS unsigned*)(lds + PF_OFF), 16, 0, 0);
        }
        bf16_t* ob = yb + (size_t)u.pm * 256 * DM;
        const float* gp = modg + (u.pm >> 3) * DM + col0;
#pragma unroll
        for (int ai = 0; ai < 2; ++ai)
#pragma unroll
            for (int m = 0; m < 4; ++m) {
                const int rl = ai * 128 + wr * 64 + m * 16 + fr;
                const size_t ro = (size_t)rl * DM + col0;
                float ss = 0.f;
#pragma unroll
                for (int bj = 0; bj < 2; ++bj) {
                    const f32x4 y0 = *(const f32x4*)(xb + ro + bj * 128) + *(const f32x4*)(gp + bj * 128) * acc[ai][bj][m][0];
                    const f32x4 y1 = *(const f32x4*)(xb + ro + bj * 128 + 4) + *(const f32x4*)(gp + bj * 128 + 4) * acc[ai][bj][m][1];
                    ss += ((y0[0] * y0[0] + y0[1] * y0[1]) + (y0[2] * y0[2] + y0[3] * y0[3])) + ((y1[0] * y1[0] + y1[1] * y1[1]) + (y1[2] * y1[2] + y1[3] * y1[3]));
                    u32x4 w; w.x = pk2(y0[0], y0[1]); w.y = pk2(y0[2], y0[3]); w.z = pk2(y1[0], y1[1]); w.w = pk2(y1[2], y1[3]);
                    *(u32x4*)(ob + ro + bj * 128) = w;
                }
                ss += __shfl_xor(ss, 16); ss += __shfl_xor(ss, 32);
                if (fq == 0) rowss[((size_t)u.pm * 256 + ai * 128 + m * 16 + rl_) * 16 + u.pn * 4 + (t_ >> 6 & 3)] = ss;
            }
        ACC_ZERO(acc);
    }
};
struct Prob3 { TV MG; const bf16_t* WO;
    __device__ __forceinline__ const char* a(const pg8::Unit& u) const { return (const char*)tv_tile(MG, u.pm); }
    __device__ __forceinline__ const char* b(const pg8::Unit& u) const { return (const char*)(WO + (size_t)u.pn * 256 * DM); } };


__device__ __forceinline__ void mini_gemm2(const Params& p, LAS unsigned char* lds) {
    const int lane = threadIdx.x & 63, wave = threadIdx.x >> 6, g = lane >> 4, li = lane & 15, tsel = wave >> 2, ksl = wave & 3;
    unsigned char* ws = p.ws;
    const bf16_t* ya = (const bf16_t*)(ws + WS_SMALL + SM_V * SMALL_B); const bf16_t* yb = (const bf16_t*)(ws + WS_SMALL + SM_SZB * SMALL_B);
    const bf16_t* ga = (const bf16_t*)(ws + WS_SMALL + SM_GA * SMALL_B); const bf16_t* gb = (const bf16_t*)(ws + WS_SMALL + SM_GB * SMALL_B);
    bf16_t* mg = (bf16_t*)(ws + WS_SMALL + SM_U * SMALL_B);
    const bf16_t* wa = (const bf16_t*)(ws + WS_WAT); const bf16_t* wb = (const bf16_t*)(ws + WS_WBT);
    LAS float* red = (LAS float*)lds;
    for (int t0 = blockIdx.x * 2; t0 < 512; t0 += gridDim.x * 2) {
        const int wt = t0 + tsel, r0 = (wt >> 6) * 16, c0 = (wt & 63) * 16;
        const bf16_t* pa = ya + (size_t)(r0 + li) * DM + ksl * 256 + 8 * g; const bf16_t* pb = yb + (size_t)(r0 + li) * DM + ksl * 256 + 8 * g;
        const bf16_t* qa = wa + (size_t)(c0 + li) * DM + ksl * 256 + 8 * g; const bf16_t* qb = wb + (size_t)(c0 + li) * DM + ksl * 256 + 8 * g;
        f32x4 a1 = (f32x4){0.f, 0.f, 0.f, 0.f}, a2 = (f32x4){0.f, 0.f, 0.f, 0.f};
#pragma unroll
        for (int k0 = 0; k0 < 256; k0 += 32) {
            a1 = __builtin_amdgcn_mfma_f32_16x16x32_bf16(*(const bf16x8*)(pa + k0), *(const bf16x8*)(qa + k0), a1, 0, 0, 0);
            a2 = __builtin_amdgcn_mfma_f32_16x16x32_bf16(*(const bf16x8*)(pb + k0), *(const bf16x8*)(qb + k0), a2, 0, 0, 0);
        }
        { const float* hss = (const float*)(ws + WS_HSS);
#pragma unroll
          for (int r = 0; r < 4; ++r) { const f32x4 hs = *(const f32x4*)(hss + (size_t)(NTP + r0 + 4 * g + r) * 16 + ksl * 4);
              a1[r] *= rsqrtf(((hs[0] + hs[1]) + (hs[2] + hs[3])) * (1.0f / 256.0f) + EPS); } }
        *(LAS f32x4*)(red + (wave * 64 + lane) * 8) = a1; *(LAS f32x4*)(red + (wave * 64 + lane) * 8 + 4) = a2;
        __syncthreads();
        if (ksl == 0) {
#pragma unroll
            for (int q = 1; q < 4; ++q) { a1 += *(const LAS f32x4*)(red + ((wave + q) * 64 + lane) * 8); a2 += *(const LAS f32x4*)(red + ((wave + q) * 64 + lane) * 8 + 4); }
#pragma unroll
            for (int r = 0; r < 4; ++r) { const size_t o = (size_t)(r0 + 4 * g + r) * DM + c0 + li;
                mg[o] = (bf16_t)f2bf(bf2f(gb[o]) * (bf2f(ga[o]) * a1[r] + a2[r])); }
        }
        __syncthreads();
    }
}
__device__ __forceinline__ void mini_gemm3(const Params& p, LAS unsigned char* lds) {
    const int lane = threadIdx.x & 63, wave = threadIdx.x >> 6, g = lane >> 4, li = lane & 15, tsel = wave >> 2, ksl = wave & 3;
    unsigned char* ws = p.ws;
    const bf16_t* mg = (const bf16_t*)(ws + WS_SMALL + SM_U * SMALL_B); const bf16_t* wo = (const bf16_t*)(ws + WS_WOT);
    const float* modg = (const float*)(ws + WS_MODG);
    LAS float* red = (LAS float*)lds;
    for (int t0 = blockIdx.x * 2; t0 < 512; t0 += gridDim.x * 2) {
        const int wt = t0 + tsel, r0 = (wt >> 6) * 16, c0 = (wt & 63) * 16;
        const bf16_t* pa = mg + (size_t)(r0 + li) * DM + ksl * 256 + 8 * g; const bf16_t* qa = wo + (size_t)(c0 + li) * DM + ksl * 256 + 8 * g;
        f32x4 a1 = (f32x4){0.f, 0.f, 0.f, 0.f};
#pragma unroll
        for (int k0 = 0; k0 < 256; k0 += 32) a1 = __builtin_amdgcn_mfma_f32_16x16x32_bf16(*(const bf16x8*)(pa + k0), *(const bf16x8*)(qa + k0), a1, 0, 0, 0);
        *(LAS f32x4*)(red + (wave * 64 + lane) * 4) = a1;
        __syncthreads();
        if (ksl == 0) {
#pragma unroll
            for (int q = 1; q < 4; ++q) a1 += *(const LAS f32x4*)(red + ((wave + q) * 64 + lane) * 4);
#pragma unroll
            for (int r = 0; r < 4; ++r) { const int row = r0 + 4 * g + r, col = c0 + li;
                p.out[O_YS + (size_t)row * DM + col] = p.in[1][(size_t)row * DM + col] + modg[(16 + (row >> 4)) * DM + col] * a1[r]; }
        }
        __syncthreads();
    }
}

__device__ __forceinline__ void transpose_item(const float* W, int ldw, int col0, int k0, bf16_t* WT, int ldt, int row0, LAS float* scr, int lane, const float* kscale = nullptr) {
#pragma unroll
    for (int i = 0; i < 32; ++i) { const int kk = 2 * i + (lane >> 5); float v = W[(size_t)(k0 + kk) * ldw + col0 + (lane & 31)]; if (kscale) v *= kscale[k0 + kk]; scr[kk * 33 + (lane & 31)] = v; }
    LDS_WAIT(); asm volatile("" ::: "memory");
    const int c = lane & 7;
#pragma unroll
    for (int j = 0; j < 4; ++j) { const int n = (lane >> 3) + 8 * j; const LAS float* s = scr + (8 * c) * 33 + n;
        u32x4 o; o.x = pk2(s[0 * 33], s[1 * 33]); o.y = pk2(s[2 * 33], s[3 * 33]); o.z = pk2(s[4 * 33], s[5 * 33]); o.w = pk2(s[6 * 33], s[7 * 33]);
        *(u32x4*)(WT + (size_t)(row0 + n) * ldt + k0 + 8 * c) = o; }
    LDS_WAIT(); asm volatile("" ::: "memory");
}

__device__ __forceinline__ void phase0(const Params& p, LAS unsigned char* lds) {
    const int tid = threadIdx.x, lane = tid & 63, wave = tid >> 6, G = gridDim.x;
    unsigned char* ws = p.ws;
    for (int it = blockIdx.x; it < 192; it += G) {
        const int cgp = it % 48, ks = it / 48;
        LAS float* cs = (LAS float*)lds;
        LAS float* red = (LAS float*)(lds + 24576);
        for (int i = tid; i < 24 * 256; i += 512) { const int b = i >> 8, k = i & 255; cs[k * 24 + b] = (b < 16) ? p.in[2][b * DM + ks * 256 + k] : p.in[3][(b - 16) * DM + ks * 256 + k]; }
        __syncthreads();
        const int col = tid & 63, kq = tid >> 6;
        float a[24];
#pragma unroll
        for (int b = 0; b < 24; ++b) a[b] = 0.f;
        const float* wm = p.in[9] + (size_t)(ks * 256 + kq * 32) * 3072 + cgp * 64 + col;
        for (int kb = 0; kb < 32; kb += 8) {
            float wv[8];
#pragma unroll
            for (int i = 0; i < 8; ++i) wv[i] = wm[(size_t)(kb + i) * 3072];
#pragma unroll
            for (int i = 0; i < 8; ++i) {
#pragma unroll
                for (int b = 0; b < 24; ++b) a[b] += cs[(kq * 32 + kb + i) * 24 + b] * wv[i];
                asm volatile("" ::: "memory"); }
        }
#pragma unroll
        for (int b = 0; b < 24; ++b) red[(kq * 24 + b) * 64 + col] = a[b];
        __syncthreads();
        float* modp = (float*)(ws + WS_MODP);
        for (int i = tid; i < 24 * 64; i += 512) { const int b = i >> 6, c = i & 63; float s = 0.f;
#pragma unroll
            for (int q = 0; q < 8; ++q) s += red[(q * 24 + b) * 64 + c];
            modp[((size_t)ks * 24 + b) * 3072 + cgp * 64 + c] = s; }
        __syncthreads();
    }
    { float* wif = (float*)(ws + WS_WIF);
      for (int i = blockIdx.x * 512 + tid; i < 8 * DM; i += G * 512) { const int g = i >> 10, k = i & 1023; wif[i] = p.in[12][(size_t)k * DIN + 5120 + g]; } }
    LAS float* scr = (LAS float*)(lds + wave * 16384);
    const int gw = blockIdx.x * 8 + wave, NGW = G * 8;
    constexpr int I_W1 = 288 * 16, I_SQ = 32 * 16, I_R = 64, NIT = I_W1 + 3 * I_SQ + 2 * I_R;
    for (int it = gw; it < NIT; it += NGW) {
        int r = it;
        if (r < I_W1) {
            const int rg = r >> 4, kb = r & 15, pn = rg >> 3, c0 = (rg & 7) * 32; const float* W; int ldw, col;
            if (pn < 12) { W = p.in[12]; ldw = DIN; col = rg * 32; }
            else if (pn < 20) { W = p.in[12]; ldw = DIN; const int j = pn - 12; col = (c0 < 128) ? 3072 + 128 * j + c0 : 4096 + 128 * j + (c0 - 128); }
            else if (pn < 24) { W = p.in[12]; ldw = DIN; col = 5128 + (rg * 32 - 5120); }
            else if (pn < 28) { W = p.in[12]; ldw = DIN; col = 6152 + (rg * 32 - 6144); }
            else { W = p.in[22]; ldw = 2048; const int j = pn - 28; col = (c0 < 128) ? 128 * j + c0 : 1024 + 128 * j + (c0 - 128); }
            transpose_item(W, ldw, col, kb * 64, (bf16_t*)(ws + WS_W1T), DM, rg * 32, scr, lane); continue; }
        r -= I_W1;
        if (r < 3 * I_SQ) { const int w = r / I_SQ, q = r % I_SQ, rg = q >> 4, kb = q & 15;
            transpose_item(p.in[24 + w], DM, rg * 32, kb * 64, (bf16_t*)(ws + (w == 0 ? WS_WAT : (w == 1 ? WS_WBT : WS_WOT))), DM, rg * 32, scr, lane, w == 0 ? p.in[14] : nullptr); continue; }
        r -= 3 * I_SQ;
        { const int w = r / I_R, q = r % I_R, n = q >> 3, rg = (q >> 1) & 3, kb = q & 1;
          transpose_item(p.in[w ? 19 : 17] + (size_t)n * 16384, 128, rg * 32, kb * 64, (bf16_t*)(ws + (w ? WS_WRXT : WS_WRAT)) + (size_t)n * 16384, 128, rg * 32, scr, lane); }
    }
}

__device__ __forceinline__ void phase1(const Params& p, LAS unsigned char* lds) {
    const int tid = threadIdx.x, lane = tid & 63, wave = tid >> 6, G = gridDim.x;
    unsigned char* ws = p.ws;
    LAS float* wif = (LAS float*)lds;
    { const float* src = (const float*)(ws + WS_WIF); for (int i = tid; i < 8 * DM; i += 512) wif[i] = src[i]; }
    __syncthreads();
    const float* modp = (const float*)(ws + WS_MODP); const float* b_mod = p.in[10]; const float* g_norm = p.in[11]; const float* b_if = p.in[13];
    float* IF = (float*)(ws + WS_IF);
    TV U{(bf16_t*)(ws + WS_U), (bf16_t*)(ws + WS_SMALL + SM_U * SMALL_B)};
    { float* modg = (float*)(ws + WS_MODG);
      for (int i = blockIdx.x * 512 + tid; i < 24 * DM; i += G * 512) { const int b = i >> 10, c = i & 1023; float s = b_mod[2048 + c];
#pragma unroll
          for (int ks = 0; ks < 4; ++ks) s += modp[((size_t)ks * 24 + b) * 3072 + 2048 + c];
          modg[i] = s; } }
    const bool h32 = (lane & 32) != 0, h16 = (lane & 16) != 0, h8 = (lane & 8) != 0;
    const int gi = (h32 ? 4 : 0) + (h16 ? 2 : 0) + (h8 ? 1 : 0);
    const float bif = b_if[gi];
    for (int wi = blockIdx.x * 8 + wave; wi < NTP / 16 + NTS; wi += G * 8) {
        const int row0 = wi < NTP / 16 ? wi * 16 : NTP + (wi - NTP / 16), nrow = wi < NTP / 16 ? 16 : 1;
        const int bidx = row0 < NTP ? (row0 >> 11) : 16 + ((row0 - NTP) >> 4);
        f32x4 sc[4], sh[4];
#pragma unroll
        for (int j = 0; j < 4; ++j) { const int idx = 4 * lane + 256 * j;
            f32x4 s = *(const f32x4*)(b_mod + idx), c = *(const f32x4*)(b_mod + 1024 + idx);
#pragma unroll
            for (int ks = 0; ks < 4; ++ks) { const float* mp = modp + ((size_t)ks * 24 + bidx) * 3072; s += *(const f32x4*)(mp + idx); c += *(const f32x4*)(mp + 1024 + idx); }
            sh[j] = s; sc[j] = *(const f32x4*)(g_norm + idx) * (c + 1.0f); }
        const float* xbase = row0 < NTP ? p.in[0] + (size_t)row0 * DM : p.in[1] + (size_t)(row0 - NTP) * DM;
        f32x4 nv[4];
#pragma unroll
        for (int j = 0; j < 4; ++j) nv[j] = *(const f32x4*)(xbase + 4 * lane + 256 * j);
        for (int r = 0; r < nrow; ++r) {
            const int row = row0 + r;
            f32x4 v[4]; float ss = 0.f;
#pragma unroll
            for (int j = 0; j < 4; ++j) { v[j] = nv[j]; ss += (v[j][0] * v[j][0] + v[j][1] * v[j][1]) + (v[j][2] * v[j][2] + v[j][3] * v[j][3]); }
            if (r + 1 < nrow) {
#pragma unroll
                for (int j = 0; j < 4; ++j) nv[j] = *(const f32x4*)(xbase + (size_t)(r + 1) * DM + 4 * lane + 256 * j); }
            const float rs = rsqrtf(wave_sum(ss) * (1.0f / DM) + EPS);
            bf16_t* ur = tv_row(U, row);
            float d[8];
#pragma unroll
            for (int g = 0; g < 8; ++g) d[g] = 0.f;
#pragma unroll
            for (int j = 0; j < 4; ++j) { v[j] = v[j] * rs * sc[j] + sh[j];
                u32x2 w; w.x = pk2(v[j][0], v[j][1]); w.y = pk2(v[j][2], v[j][3]); *(u32x2*)(ur + 4 * lane + 256 * j) = w;
#pragma unroll
                for (int g = 0; g < 8; ++g) { const f32x4 wv = *(const LAS f32x4*)(wif + g * DM + 4 * lane + 256 * j); d[g] += (v[j][0] * wv[0] + v[j][1] * wv[1]) + (v[j][2] * wv[2] + v[j][3] * wv[3]); } }
            float e[4], f[2], gs;
#pragma unroll
            for (int i = 0; i < 4; ++i) { const float send = h32 ? d[i] : d[i + 4], keep = h32 ? d[i + 4] : d[i]; e[i] = keep + __shfl_xor(send, 32); }
#pragma unroll
            for (int i = 0; i < 2; ++i) { const float send = h16 ? e[i] : e[i + 2], keep = h16 ? e[i + 2] : e[i]; f[i] = keep + __shfl_xor(send, 16); }
            { const float send = h8 ? f[0] : f[1], keep = h8 ? f[1] : f[0]; gs = keep + __shfl_xor(send, 8); }
            gs += __shfl_xor(gs, 4); gs += __shfl_xor(gs, 2); gs += __shfl_xor(gs, 1);
            if ((lane & 7) == 0) { float x = gs + bif;
                if (gi >= 4) x = fminf(x, 0.f) - __logf(1.0f + __expf(-fabsf(x)));
                IF[(size_t)row * 8 + gi] = x; }
        }
    }
}

constexpr int ML_QS = 0, ML_KS = 33792, ML_CB = 67584, ML_VS = 109824, ML_VW = 119040, ML_HS = 128256, ML_F = 137472, ML_DUMP = 149000;
__device__ __forceinline__ void mlstm_item(const Params& p, LAS unsigned char* lds, int b, int h, int vs, bool smp, bool dry) {
    int tid_ = threadIdx.x; asm volatile("" : "+v"(tid_));
    const int tid = tid_, lane = tid & 63, w = __builtin_amdgcn_readfirstlane(tid >> 6), g = lane >> 4, li = lane & 15, q4 = li >> 2, p4 = li & 3;
    unsigned char* ws = p.ws;
    const int L = smp ? DSEQ : 64, nch = smp ? 1 : SEQ / 64;
    const int row0 = smp ? NTP + b * DSEQ : b * SEQ;
    const bf16_t* qb = (smp ? (const bf16_t*)(ws + WS_SMALL + SM_Q * SMALL_B) + (size_t)(b * DSEQ) * DM : (const bf16_t*)(p.out) + (size_t)row0 * DM) + h * 256;
    const bf16_t* kb = (smp ? (const bf16_t*)(ws + WS_SMALL + SM_K * SMALL_B) + (size_t)(b * DSEQ) * DM : (const bf16_t*)((unsigned char*)p.out + 64 * MiB) + (size_t)row0 * DM) + h * 256;
    bf16_t* vb = (smp ? (bf16_t*)(ws + WS_SMALL + SM_V * SMALL_B) + (size_t)(b * DSEQ) * DM : (bf16_t*)(ws + WS_V) + (size_t)row0 * DM) + h * 256 + vs * 64;
    const float* IFb = (const float*)(ws + WS_IF) + (size_t)row0 * 8;
    float* HSSb = (float*)(ws + WS_HSS) + (size_t)row0 * 16 + h * 4 + vs;
    const bf16_t* ogb = (smp ? (const bf16_t*)(ws + WS_SMALL + SM_OG * SMALL_B) + (size_t)(b * DSEQ) * DM : (const bf16_t*)(ws + WS_OG) + (size_t)row0 * DM) + h * 256 + vs * 64;
    LAS float* F = (LAS float*)(lds + ML_F);
    LAS float *IG = F, *LF = F + 64, *HSQ = F + 128;
    LAS float *GGw = F + 264 + 320 * w, *MMw = GGw + 64, *SIw = GGw + 128, *EMw = GGw + 192, *WSw = GGw + 256;
    const int bh = b * 4 + h;
    const int vt = w & 3, ktb = (w >> 2) * 8, i0 = 2 * (w & 3);
    f32x4 cst[8], nst[2];
    float m_state;
    if (smp) {
        const float* C0 = p.in[4] + (size_t)bh * 65536 + (size_t)(vs * 64 + vt * 16 + li) * 256;
#pragma unroll
        for (int i = 0; i < 8; ++i) cst[i] = *(const f32x4*)(C0 + (ktb + i) * 16 + 4 * g);
#pragma unroll
        for (int q = 0; q < 2; ++q) nst[q] = (li == 0) ? *(const f32x4*)(p.in[5] + bh * 256 + (ktb + i0 + q) * 16 + 4 * g) : (f32x4){0.f, 0.f, 0.f, 0.f};
        m_state = p.in[6][bh];
    } else {
#pragma unroll
        for (int i = 0; i < 8; ++i) cst[i] = (f32x4){0.f, 0.f, 0.f, 0.f};
        nst[0] = (f32x4){0.f, 0.f, 0.f, 0.f}; nst[1] = nst[0];
        m_state = 0.f;
    }
#pragma unroll
    for (int i = 0; i < 8; ++i) { u32x2 wv; wv.x = pk2(cst[i][0], cst[i][1]); wv.y = pk2(cst[i][2], cst[i][3]);
        *(LAS u32x2*)(lds + ML_CB + (vt * 16 + li) * 528 + ((ktb + i) * 16 + 4 * g) * 2) = wv; }
    if (li == 0) {
#pragma unroll
        for (int q = 0; q < 2; ++q) { u32x2 wv; wv.x = pk2(nst[q][0], nst[q][1]); wv.y = pk2(nst[q][2], nst[q][3]);
            *(LAS u32x2*)(lds + ML_CB + 64 * 528 + ((ktb + i0 + q) * 16 + 4 * g) * 2) = wv; } }
    u32x4 rq[4], rk[4], rv; float rig = 0.f, rlf = 0.f;
    const u32x4 z4 = (u32x4){0u, 0u, 0u, 0u};
#define ML_PREFETCH(c) do { const int t0_ = (c) * 64; \
        _Pragma("unroll") for (int i_ = 0; i_ < 4; ++i_) { const int id_ = tid + 512 * i_, r_ = id_ >> 5, ch_ = id_ & 31; \
            if (!smp || r_ < L) { rq[i_] = *(const u32x4*)(qb + (size_t)(t0_ + r_) * DM + ch_ * 8); rk[i_] = *(const u32x4*)(kb + (size_t)(t0_ + r_) * DM + ch_ * 8); } else { rq[i_] = z4; rk[i_] = z4; } } \
        { const int r_ = tid >> 3, ch_ = tid & 7; rv = (!smp || r_ < L) ? *(const u32x4*)(vb + (size_t)(t0_ + r_) * DM + ch_ * 8) : z4; } \
        if (tid < 64) { if (!smp || tid < L) { rig = IFb[(size_t)(t0_ + tid) * 8 + h]; rlf = IFb[(size_t)(t0_ + tid) * 8 + 4 + h]; } else { rig = -INFINITY; rlf = 0.f; } } } while (0)
    ML_PREFETCH(0);
    bf16x8 ones; { const short o1 = (short)0x3F80;
#pragma unroll
        for (int j = 0; j < 8; ++j) ones[j] = o1; }
    const int tt = (w < 4) ? (w >> 1) : 3 - ((w - 4) >> 1), hb = (w & 1) * 2;
    for (int c = 0; c < nch; ++c) {
        const int t0 = c * 64;
#pragma unroll
        for (int i = 0; i < 4; ++i) { const int id = tid + 512 * i, r = id >> 5, ch = id & 31;
            *(LAS u32x4*)(lds + ML_QS + r * 528 + ch * 16) = rq[i]; *(LAS u32x4*)(lds + ML_KS + r * 528 + ch * 16) = rk[i]; }
        const u32x4 vcur = rv;
        { const int r = tid >> 3, ch = tid & 7; *(LAS u32x4*)(lds + ML_VS + r * 144 + ch * 16) = vcur; }
        if (tid < 64) { IG[tid] = rig; LF[tid] = rlf; }
        BAR_LDS();
        if (tt >= 2) __builtin_amdgcn_s_setprio(1);
        if (c + 1 < nch) ML_PREFETCH(c + 1);
        float decay, m_next;
        {
            const float bc = wave_scan_add(LF[lane]);
            const float gs = IG[lane] - bc;
            const float cm = wave_scan_max(gs);
            const float Mt = fmaxf(m_state, cm);
            const float ML_ = __builtin_bit_cast(float, __builtin_amdgcn_readlane(__builtin_bit_cast(int, Mt), 63));
            const float bL = __builtin_bit_cast(float, __builtin_amdgcn_readlane(__builtin_bit_cast(int, bc), 63));
            GGw[lane] = gs; MMw[lane] = Mt; SIw[lane] = __expf(m_state - Mt); EMw[lane] = __expf(-(bc + Mt)); WSw[lane] = __expf(gs - ML_);
            decay = __expf(m_state - ML_); m_next = bL + ML_;
        }
        { const int r = tid >> 3, ch = tid & 7; const float wsr = WSw[r];
          u32x4 o; o.x = pk2(bflo(vcur.x) * wsr, bfhi(vcur.x) * wsr); o.y = pk2(bflo(vcur.y) * wsr, bfhi(vcur.y) * wsr); o.z = pk2(bflo(vcur.z) * wsr, bfhi(vcur.z) * wsr); o.w = pk2(bflo(vcur.w) * wsr, bfhi(vcur.w) * wsr);
          *(LAS u32x4*)(lds + ML_VW + r * 144 + ch * 16) = o; }
        {
            bf16x8 qf[8];
#pragma unroll
            for (int kk = 0; kk < 8; ++kk) qf[kk] = *(const LAS bf16x8*)(lds + ML_QS + (tt * 16 + li) * 528 + (kk * 32 + g * 8) * 2);
            const float mt = MMw[tt * 16 + li];
            const int tq = tt * 16 + li;
            bf16x8 ap[2];
#pragma unroll
            for (int ks = 0; ks < 2; ++ks) {
                float pv[8];
#pragma unroll
                for (int hh = 0; hh < 2; ++hh) { const int st = 2 * ks + hh;
                    if (st <= tt) { f32x4 sa = (f32x4){0.f, 0.f, 0.f, 0.f};
#pragma unroll
                        for (int kk = 0; kk < 8; ++kk) { const bf16x8 kf = *(const LAS bf16x8*)(lds + ML_KS + (st * 16 + li) * 528 + (kk * 32 + g * 8) * 2); sa = __builtin_amdgcn_mfma_f32_16x16x32_bf16(kf, qf[kk], sa, 0, 0, 0); }
                        const f32x4 gv = *(const LAS f32x4*)(GGw + st * 16 + 4 * g);
#pragma unroll
                        for (int r = 0; r < 4; ++r) { const int sidx = st * 16 + 4 * g + r; pv[hh * 4 + r] = (sidx <= tq) ? sa[r] * __expf(gv[r] - mt) : 0.f; }
                    } else {
#pragma unroll
                        for (int r = 0; r < 4; ++r) pv[hh * 4 + r] = 0.f; } }
                union { u32x4 u; bf16x8 v; } cvt; cvt.u.x = pk2(pv[0], pv[1]); cvt.u.y = pk2(pv[2], pv[3]); cvt.u.z = pk2(pv[4], pv[5]); cvt.u.w = pk2(pv[6], pv[7]);
                ap[ks] = cvt.v;
            }
            f32x4 na[2], nq = (f32x4){0.f, 0.f, 0.f, 0.f}, ra = (f32x4){0.f, 0.f, 0.f, 0.f};
            na[0] = (f32x4){0.f, 0.f, 0.f, 0.f}; na[1] = na[0];
#pragma unroll
            for (int kk = 0; kk < 8; ++kk) {
                const bf16x8 c0 = *(const LAS bf16x8*)(lds + ML_CB + ((hb + 0) * 16 + li) * 528 + (kk * 32 + g * 8) * 2);
                const bf16x8 c1 = *(const LAS bf16x8*)(lds + ML_CB + ((hb + 1) * 16 + li) * 528 + (kk * 32 + g * 8) * 2);
                const bf16x8 cn = *(const LAS bf16x8*)(lds + ML_CB + 64 * 528 + (kk * 32 + g * 8) * 2);
                na[0] = __builtin_amdgcn_mfma_f32_16x16x32_bf16(qf[kk], c0, na[0], 0, 0, 0);
                na[1] = __builtin_amdgcn_mfma_f32_16x16x32_bf16(qf[kk], c1, na[1], 0, 0, 0);
                nq = __builtin_amdgcn_mfma_f32_16x16x32_bf16(qf[kk], cn, nq, 0, 0, 0);
            }
            const f32x4 si = *(const LAS f32x4*)(SIw + tt * 16 + 4 * g), em = *(const LAS f32x4*)(EMw + tt * 16 + 4 * g);
            na[0] = na[0] * si; na[1] = na[1] * si;
#pragma unroll
            for (int ks = 0; ks < 2; ++ks) if (2 * ks <= tt) {
                ra = __builtin_amdgcn_mfma_f32_16x16x32_bf16(ap[ks], ones, ra, 0, 0, 0);
#pragma unroll
                for (int j = 0; j < 2; ++j) {
                    const s16x4 v0 = __builtin_amdgcn_ds_read_tr16_b64_v4i16((LAS s16x4*)(lds + ML_VS + (ks * 32 + g * 4 + q4) * 144 + ((hb + j) * 16 + 4 * p4) * 2));
                    const s16x4 v1 = __builtin_amdgcn_ds_read_tr16_b64_v4i16((LAS s16x4*)(lds + ML_VS + (ks * 32 + 16 + g * 4 + q4) * 144 + ((hb + j) * 16 + 4 * p4) * 2));
                    bf16x8 bv; bv[0] = v0[0]; bv[1] = v0[1]; bv[2] = v0[2]; bv[3] = v0[3]; bv[4] = v1[0]; bv[5] = v1[1]; bv[6] = v1[2]; bv[7] = v1[3];
                    na[j] = __builtin_amdgcn_mfma_f32_16x16x32_bf16(ap[ks], bv, na[j], 0, 0, 0);
                }
            }
#pragma unroll
            for (int r = 0; r < 4; ++r) { const int t = tt * 16 + 4 * g + r;
                const float den = si[r] * nq[r] + ra[r]; const float inv = __builtin_amdgcn_rcpf(fmaxf(fabsf(den), em[r]));
                const float h0 = na[0][r] * inv, h1 = na[1][r] * inv;
                *(LAS bf16_t*)(lds + ML_HS + t * 144 + ((hb + 0) * 16 + li) * 2) = (bf16_t)f2bf(h0);
                *(LAS bf16_t*)(lds + ML_HS + t * 144 + ((hb + 1) * 16 + li) * 2) = (bf16_t)f2bf(h1);
                float sq = h0 * h0 + h1 * h1;
                sq = row16_sum(sq);
                HSQ[t * 2 + (w & 1)] = sq; }
        }
        __builtin_amdgcn_s_setprio(0);
        BAR_LDS();
        u32x4 ogv = (u32x4){0u, 0u, 0u, 0u};
        { const int r = tid >> 3, ch = tid & 7; if (!smp || r < L) ogv = *(const u32x4*)(ogb + (size_t)(t0 + r) * DM + ch * 8); }
        if (tid < L && !dry) HSSb[(size_t)(t0 + tid) * 16] = HSQ[tid * 2] + HSQ[tid * 2 + 1];
        {
            bf16x8 bvw[2], bws[2];
#pragma unroll
            for (int ks = 0; ks < 2; ++ks) {
                const s16x4 v0 = __builtin_amdgcn_ds_read_tr16_b64_v4i16((LAS s16x4*)(lds + ML_VW + (ks * 32 + g * 8 + 0 + q4) * 144 + (vt * 16 + 4 * p4) * 2));
                const s16x4 v1 = __builtin_amdgcn_ds_read_tr16_b64_v4i16((LAS s16x4*)(lds + ML_VW + (ks * 32 + g * 8 + 4 + q4) * 144 + (vt * 16 + 4 * p4) * 2));
                bvw[ks][0] = v0[0]; bvw[ks][1] = v0[1]; bvw[ks][2] = v0[2]; bvw[ks][3] = v0[3]; bvw[ks][4] = v1[0]; bvw[ks][5] = v1[1]; bvw[ks][6] = v1[2]; bvw[ks][7] = v1[3];
                const f32x4 w0 = *(const LAS f32x4*)(WSw + ks * 32 + g * 8), w1 = *(const LAS f32x4*)(WSw + ks * 32 + g * 8 + 4);
                union { u32x4 u; bf16x8 v; } cvt; cvt.u.x = pk2(w0[0], w0[1]); cvt.u.y = pk2(w0[2], w0[3]); cvt.u.z = pk2(w1[0], w1[1]); cvt.u.w = pk2(w1[2], w1[3]);
                if (li != 0) cvt.u = (u32x4){0u, 0u, 0u, 0u};
                bws[ks] = cvt.v; }
            nst[0] = nst[0] * decay; nst[1] = nst[1] * decay;
#pragma unroll
            for (int i = 0; i < 8; ++i) { const int kt = ktb + i; cst[i] = cst[i] * decay;
                const bool mine = ((i >> 1) == (w & 3));
#pragma unroll
                for (int ks = 0; ks < 2; ++ks) {
                    const s16x4 k0 = __builtin_amdgcn_ds_read_tr16_b64_v4i16((LAS s16x4*)(lds + ML_KS + (ks * 32 + g * 8 + 0 + q4) * 528 + (kt * 16 + 4 * p4) * 2));
                    const s16x4 k1 = __builtin_amdgcn_ds_read_tr16_b64_v4i16((LAS s16x4*)(lds + ML_KS + (ks * 32 + g * 8 + 4 + q4) * 528 + (kt * 16 + 4 * p4) * 2));
                    bf16x8 ak; ak[0] = k0[0]; ak[1] = k0[1]; ak[2] = k0[2]; ak[3] = k0[3]; ak[4] = k1[0]; ak[5] = k1[1]; ak[6] = k1[2]; ak[7] = k1[3];
                    cst[i] = __builtin_amdgcn_mfma_f32_16x16x32_bf16(ak, bvw[ks], cst[i], 0, 0, 0);
                    if (mine) nst[i & 1] = __builtin_amdgcn_mfma_f32_16x16x32_bf16(ak, bws[ks], nst[i & 1], 0, 0, 0); }
                u32x2 wv; wv.x = pk2(cst[i][0], cst[i][1]); wv.y = pk2(cst[i][2], cst[i][3]);
                *(LAS u32x2*)(lds + ML_CB + (vt * 16 + li) * 528 + (kt * 16 + 4 * g) * 2) = wv; }
            {
#pragma unroll
                for (int q = 0; q < 2; ++q) { u32x2 wv; wv.x = pk2(nst[q][0], nst[q][1]); wv.y = pk2(nst[q][2], nst[q][3]);
                    const int na_ = (li == 0) ? ML_CB + 64 * 528 + ((ktb + i0 + q) * 16 + 4 * g) * 2 : ML_DUMP;
                    *(LAS u32x2*)(lds + na_) = wv; } }
        }
        { const int r = tid >> 3, ch = tid & 7; if ((!smp || r < L) && !dry) { const u32x4 hv = *(const LAS u32x4*)(lds + ML_HS + r * 144 + ch * 16); u32x4 o;
            o.x = pk2(bflo(hv.x) * bflo(ogv.x), bfhi(hv.x) * bfhi(ogv.x)); o.y = pk2(bflo(hv.y) * bflo(ogv.y), bfhi(hv.y) * bfhi(ogv.y));
            o.z = pk2(bflo(hv.z) * bflo(ogv.z), bfhi(hv.z) * bfhi(ogv.z)); o.w = pk2(bflo(hv.w) * bflo(ogv.w), bfhi(hv.w) * bfhi(ogv.w));
            *(u32x4*)(vb + (size_t)(t0 + r) * DM + ch * 8) = o; } }
        BAR_LDS();
        m_state = m_next;
    }
    if (!dry) {
        float* Co = p.out + (smp ? O_CS : O_CP) + (size_t)bh * 65536 + (size_t)(vs * 64 + vt * 16 + li) * 256;
#pragma unroll
        for (int i = 0; i < 8; ++i) *(f32x4*)(Co + (ktb + i) * 16 + 4 * g) = cst[i];
        if (vs == 0) {
            if (li == 0) {
#pragma unroll
                for (int q = 0; q < 2; ++q) *(f32x4*)(p.out + (smp ? O_NS : O_NP) + bh * 256 + (ktb + i0 + q) * 16 + 4 * g) = nst[q]; }
            if (tid == 0) p.out[(smp ? O_MS : O_MP) + bh] = m_state; }
    }
    __syncthreads();
#undef ML_PREFETCH
}

constexpr int RG_XR = 0, RG_XC = 18432, RG_W = 36864, RG_EX = 71680, RG_HC = 72704, RG_ZS = 73216;
__device__ __forceinline__ void rglru_item(const Params& p, LAS unsigned char* lds, int b, int n, int hf, bool smp, bool dry) {
    int tid_ = threadIdx.x; asm volatile("" : "+v"(tid_));
    const int tid = tid_, lane = tid & 63, w = __builtin_amdgcn_readfirstlane(tid >> 6), g = lane >> 4, li = lane & 15;
    unsigned char* ws = p.ws;
    const int L = smp ? DSEQ : SEQ, ntile = smp ? 1 : SEQ / 64;
    const int row0 = smp ? NTP + b * DSEQ : b * SEQ;
    const bf16_t* xbp = (smp ? (const bf16_t*)(ws + WS_SMALL + SM_XB * SMALL_B) + (size_t)(b * DSEQ) * DM : (const bf16_t*)(ws + WS_XB) + (size_t)row0 * DM) + n * 128;
    bf16_t* zbp = (smp ? (bf16_t*)(ws + WS_SMALL + SM_SZB * SMALL_B) + (size_t)(b * DSEQ) * DM : (bf16_t*)(ws + WS_SZB) + (size_t)row0 * DM) + n * 128 + hf * 64;
    const float* cvs = p.in[8] + (size_t)b * 3 * DM + n * 128;
    LAS float* EX = (LAS float*)(lds + RG_EX); LAS float* HC = (LAS float*)(lds + RG_HC);
    for (int id = tid; id < 2 * 64 * 16; id += 512) { const int gt = id >> 10, j = (id >> 4) & 63, ch = id & 15;
        *(LAS u32x4*)(lds + RG_W + (gt * 64 + j) * 272 + ch * 16) = *(const u32x4*)((const bf16_t*)(ws + (gt ? WS_WRXT : WS_WRAT)) + (size_t)n * 16384 + (size_t)(hf * 64 + j) * 128 + ch * 8); }
    const int jt = w & 3, th = w >> 2, jc = jt * 16 + li, chn = n * 128 + hf * 64 + jc;
    const float bra = p.in[18][chn], brx = p.in[20][chn];
    float spl; { const float lm = p.in[21][chn]; spl = fmaxf(-lm, 0.f) + log1pf(__expf(-fabsf(lm))); }
    float gw_[4]; const float gb_ = p.in[16][chn];
#pragma unroll
    for (int j = 0; j < 4; ++j) gw_[j] = p.in[15][j * DM + chn];
    const int c2 = tid & 63, tq = tid >> 6;
    float cw[4][2], cb[2];
#pragma unroll
    for (int j = 0; j < 4; ++j) { cw[j][0] = p.in[15][j * DM + n * 128 + 2 * c2]; cw[j][1] = p.in[15][j * DM + n * 128 + 2 * c2 + 1]; }
    cb[0] = p.in[16][n * 128 + 2 * c2]; cb[1] = p.in[16][n * 128 + 2 * c2 + 1];
    if (tid < 64) { HC[tid] = smp ? p.in[7][b * DM + n * 128 + hf * 64 + tid] : 0.f; }
    u32x4 rx[3], rzv;
    const u32x4 z4 = (u32x4){0u, 0u, 0u, 0u};
#define RG_PREFETCH(tl) do { const int t0_ = (tl) * 64; \
        _Pragma("unroll") for (int i_ = 0; i_ < 3; ++i_) { const int id_ = tid + 512 * i_, r_ = id_ >> 4, ch_ = id_ & 15, tok_ = t0_ - 3 + r_; rx[i_] = z4; \
            if (id_ < 67 * 16) { if (tok_ >= 0 && (!smp || tok_ < L)) rx[i_] = *(const u32x4*)(xbp + (size_t)tok_ * DM + ch_ * 8); \
                else if (tok_ < 0 && smp) { const float* s_ = cvs + (size_t)(tok_ + 3) * DM + ch_ * 8; const f32x4 a_ = *(const f32x4*)s_, b_ = *(const f32x4*)(s_ + 4); \
                    rx[i_].x = pk2(a_[0], a_[1]); rx[i_].y = pk2(a_[2], a_[3]); rx[i_].z = pk2(b_[0], b_[1]); rx[i_].w = pk2(b_[2], b_[3]); } } } \
        { const int r_ = tid >> 3, ch_ = tid & 7; rzv = (!smp || t0_ + r_ < L) ? *(const u32x4*)(zbp + (size_t)(t0_ + r_) * DM + ch_ * 8) : z4; } } while (0)
    RG_PREFETCH(0);
    for (int tl = 0; tl < ntile; ++tl) {
        const int t0 = tl * 64;
#pragma unroll
        for (int i = 0; i < 3; ++i) { const int id = tid + 512 * i, r = id >> 4, ch = id & 15; if (id < 67 * 16) *(LAS u32x4*)(lds + RG_XR + r * 272 + ch * 16) = rx[i]; }
        { const int r = tid >> 3, ch = tid & 7; *(LAS u32x4*)(lds + RG_ZS + (tl & 1) * 9216 + r * 144 + ch * 16) = rzv; }
        BAR_LDS();
        if (tl > 0 && !dry) { const int r = tid >> 3, ch = tid & 7;
            *(u32x4*)(zbp + (size_t)(t0 - 64 + r) * DM + ch * 8) = *(const LAS u32x4*)(lds + RG_ZS + ((tl - 1) & 1) * 9216 + r * 144 + ch * 16); }
        if (tl == ntile - 1 && tid < 192 && !dry) {
            const int j = tid >> 6, c = tid & 63, rr = (L - t0) + j;
            p.out[(smp ? O_CVS : O_CVP) + ((size_t)b * 3 + j) * DM + n * 128 + hf * 64 + c] = bf2f(*(const LAS bf16_t*)(lds + RG_XR + rr * 272 + (hf * 64 + c) * 2));
        }
        if (tl + 1 < ntile) RG_PREFETCH(tl + 1);
        { float x0[3], x1[3];
#pragma unroll
          for (int j = 0; j < 3; ++j) { const unsigned wv = *(const LAS unsigned*)(lds + RG_XR + (tq * 8 + j) * 272 + c2 * 4); x0[j] = bflo(wv); x1[j] = bfhi(wv); }
#pragma unroll
          for (int i = 0; i < 8; ++i) { const int t = tq * 8 + i; const unsigned wv = *(const LAS unsigned*)(lds + RG_XR + (t + 3) * 272 + c2 * 4); const float n0 = bflo(wv), n1 = bfhi(wv);
              const float y0 = cb[0] + cw[0][0] * x0[0] + cw[1][0] * x0[1] + cw[2][0] * x0[2] + cw[3][0] * n0;
              const float y1 = cb[1] + cw[0][1] * x1[0] + cw[1][1] * x1[1] + cw[2][1] * x1[2] + cw[3][1] * n1;
              x0[0] = x0[1]; x0[1] = x0[2]; x0[2] = n0; x1[0] = x1[1]; x1[1] = x1[2]; x1[2] = n1;
              *(LAS unsigned*)(lds + RG_XC + t * 272 + c2 * 4) = pk2(y0, y1); } }
        BAR_LDS();
        float av[2][4], bv[2][4], TA[2], TB[2], EA[2], EB[2];
        {
            bf16x8 wr_[4], wi_[4];
#pragma unroll
            for (int kk = 0; kk < 4; ++kk) { wr_[kk] = *(const LAS bf16x8*)(lds + RG_W + jc * 272 + (kk * 32 + g * 8) * 2); wi_[kk] = *(const LAS bf16x8*)(lds + RG_W + (64 + jc) * 272 + (kk * 32 + g * 8) * 2); }
#pragma unroll
            for (int q = 0; q < 2; ++q) { const int tt = 2 * th + q;
                f32x4 ar = (f32x4){0.f, 0.f, 0.f, 0.f}, ai = (f32x4){0.f, 0.f, 0.f, 0.f};
#pragma unroll
                for (int kk = 0; kk < 4; ++kk) { const bf16x8 ax = *(const LAS bf16x8*)(lds + RG_XC + (tt * 16 + li) * 272 + (kk * 32 + g * 8) * 2);
                    ar = __builtin_amdgcn_mfma_f32_16x16x32_bf16(ax, wr_[kk], ar, 0, 0, 0); ai = __builtin_amdgcn_mfma_f32_16x16x32_bf16(ax, wi_[kk], ai, 0, 0, 0); }
                float xw[7];
#pragma unroll
                for (int k = 0; k < 7; ++k) xw[k] = bf2f(*(const LAS bf16_t*)(lds + RG_XR + (tt * 16 + 4 * g + k) * 272 + (hf * 64 + jc) * 2));
                float A4 = 1.f, B4 = 0.f;
#pragma unroll
                for (int r = 0; r < 4; ++r) { const int t = tt * 16 + 4 * g + r;
                    const float xc = gb_ + gw_[0] * xw[r] + gw_[1] * xw[r + 1] + gw_[2] * xw[r + 2] + gw_[3] * xw[r + 3];
                    const float rg = sigm(ar[r] + bra), ig = sigm(ai[r] + brx);
                    const float la = -8.0f * rg * spl; const float a = __expf(la);
                    const float x2 = 2.0f * la;
                    const float pm = x2 * (1.0f + x2 * (0.5f + x2 * (0.16666667f + x2 * (0.041666668f + x2 * (0.0083333338f + x2 * (0.0013888889f + x2 * 0.0001984127f))))));
                    const float om = (x2 > -0.5f) ? -pm : 1.0f - __expf(x2);
                    float mult = __builtin_amdgcn_sqrtf(om); if (!smp && (t0 + t) == 0) mult = 1.0f;
                    const float bt = mult * ig * xc;
                    av[q][r] = a; bv[q][r] = bt; B4 = a * B4 + bt; A4 *= a; }
                { const float pA = __shfl_up(A4, 16), pB = __shfl_up(B4, 16); if (g >= 1) { B4 = A4 * pB + B4; A4 = A4 * pA; } }
                { const float pA = __shfl_up(A4, 32), pB = __shfl_up(B4, 32); if (g >= 2) { B4 = A4 * pB + B4; A4 = A4 * pA; } }
                { const float pA = __shfl_up(A4, 16), pB = __shfl_up(B4, 16); EA[q] = (g >= 1) ? pA : 1.f; EB[q] = (g >= 1) ? pB : 0.f; }
                TA[q] = __shfl(A4, 48 + li); TB[q] = __shfl(B4, 48 + li);
            }
            { EX[(th * 64 + jc) * 2] = TA[0] * TA[1]; EX[(th * 64 + jc) * 2 + 1] = TA[1] * TB[0] + TB[1]; }
        }
        BAR_LDS();
        {
            float hin = HC[(tl & 1) * 64 + jc];
            if (th == 1) hin = EX[jc * 2] * hin + EX[jc * 2 + 1];
            if (th == 1) HC[((tl + 1) & 1) * 64 + jc] = (TA[0] * TA[1]) * hin + (TA[1] * TB[0] + TB[1]);
#pragma unroll
            for (int q = 0; q < 2; ++q) { const int tt = 2 * th + q;
                float hcur = EA[q] * hin + EB[q];
#pragma unroll
                for (int r = 0; r < 4; ++r) { const int tok = t0 + tt * 16 + 4 * g + r;
                    hcur = av[q][r] * hcur + bv[q][r];
                    { LAS bf16_t* zp = (LAS bf16_t*)(lds + RG_ZS + (tl & 1) * 9216 + (tt * 16 + 4 * g + r) * 144 + jc * 2); *zp = (bf16_t)f2bf(bf2f(*zp) * hcur); }
                    if (tl == ntile - 1) { if (tok == L - 1 && !dry) p.out[(smp ? O_HS : O_HP) + (size_t)b * DM + chn] = hcur; } }
                hin = TA[q] * hin + TB[q];
            }
        }
    }
    BAR_LDS();
    if (!dry) { const int r = tid >> 3, ch = tid & 7, tlast = (ntile - 1) * 64;
        if (tlast + r < L) *(u32x4*)(zbp + (size_t)(tlast + r) * DM + ch * 8) = *(const LAS u32x4*)(lds + RG_ZS + ((ntile - 1) & 1) * 9216 + r * 144 + ch * 16); }
    __syncthreads();
#undef RG_PREFETCH
}

__device__ __forceinline__ void phase3(const Params& p, LAS unsigned char* lds) {
    const int G = gridDim.x;
    for (int it = blockIdx.x; it < 256; it += G) { const int bh = (it & 7) * 8 + (it >> 5), vs = (it >> 3) & 3; mlstm_item(p, lds, bh >> 2, bh & 3, vs, false, false); }
    for (int it = blockIdx.x; it < 256; it += G) { const int q = (it & 7) * 16 + (it >> 4), hf = (it >> 3) & 1; rglru_item(p, lds, q >> 3, q & 7, hf, false, false); }
    for (int it = blockIdx.x; it < 128; it += G) mlstm_item(p, lds, it >> 4, (it >> 2) & 3, it & 3, true, false);
    for (int it = blockIdx.x; it < 256; it += G) if (it >= 128) { const int q = it - 128; rglru_item(p, lds, q >> 4, (q >> 1) & 7, q & 1, true, false); }
}

__device__ __forceinline__ void phase4(const Params& p) {
    unsigned char* ws = p.ws;
    TV YA{(bf16_t*)(ws + WS_V), (bf16_t*)(ws + WS_SMALL + SM_V * SMALL_B)}, OG{(bf16_t*)(ws + WS_OG), (bf16_t*)(ws + WS_SMALL + SM_OG * SMALL_B)};
    const float* HSS = (const float*)(ws + WS_HSS); const float* gh = p.in[14];
    for (int id = blockIdx.x * 512 + threadIdx.x; id < NTT * 128; id += gridDim.x * 512) {
        const int row = id >> 7, ch = id & 127, hd = ch >> 5;
        const f32x4 hs = *(const f32x4*)(HSS + (size_t)row * 16 + hd * 4);
        const float rs = rsqrtf(((hs[0] + hs[1]) + (hs[2] + hs[3])) * (1.0f / 256.0f) + EPS);
        bf16_t* yp = tv_row(YA, row) + ch * 8; const bf16_t* op = tv_row(OG, row) + ch * 8;
        const u32x4 hv = *(const u32x4*)yp, ov = *(const u32x4*)op; const f32x4 g0 = *(const f32x4*)(gh + ch * 8), g1 = *(const f32x4*)(gh + ch * 8 + 4);
        u32x4 o;
        o.x = pk2(bflo(hv.x) * bflo(ov.x) * rs * g0[0], bfhi(hv.x) * bfhi(ov.x) * rs * g0[1]);
        o.y = pk2(bflo(hv.y) * bflo(ov.y) * rs * g0[2], bfhi(hv.y) * bfhi(ov.y) * rs * g0[3]);
        o.z = pk2(bflo(hv.z) * bflo(ov.z) * rs * g1[0], bfhi(hv.z) * bfhi(ov.z) * rs * g1[1]);
        o.w = pk2(bflo(hv.w) * bflo(ov.w) * rs * g1[2], bfhi(hv.w) * bfhi(ov.w) * rs * g1[3]);
        *(u32x4*)yp = o;
    }
}

__device__ __forceinline__ void phase7(const Params& p) {
    const int lane = threadIdx.x & 63, wave = threadIdx.x >> 6;
    const float* rowss = (const float*)(p.ws + WS_ROWSS); const float* gf = p.in[27];
    f32x4 gv[4];
#pragma unroll
    for (int j = 0; j < 4; ++j) gv[j] = *(const f32x4*)(gf + 4 * lane + 256 * j);
    const bf16_t* ybf = (const bf16_t*)(p.ws + WS_V);
    const int gw = blockIdx.x * 8 + wave, NGW = gridDim.x * 8;
    for (int r0 = gw; r0 < NTP; r0 += 4 * NGW) {
        u32x2 w[4][4]; float part[4];
#pragma unroll
        for (int q = 0; q < 4; ++q) { const int row = r0 + q * NGW; const bool ok = row < NTP; const int rr = ok ? row : r0;
#pragma unroll
            for (int j = 0; j < 4; ++j) w[q][j] = *(const u32x2*)(ybf + (size_t)rr * DM + 4 * lane + 256 * j);
            part[q] = lane < 16 ? rowss[(size_t)rr * 16 + lane] : 0.f; }
#pragma unroll
        for (int q = 0; q < 4; ++q) { const int row = r0 + q * NGW; if (row < NTP) {
            const float rs = rsqrtf(wave_sum(part[q]) * (1.0f / DM) + EPS);
            float* yr = p.out + O_YP + (size_t)row * DM;
#pragma unroll
            for (int j = 0; j < 4; ++j) { const f32x4 v = (f32x4){bflo(w[q][j].x), bfhi(w[q][j].x), bflo(w[q][j].y), bfhi(w[q][j].y)}; *(f32x4*)(yr + 4 * lane + 256 * j) = v * rs * gv[j]; } } }
    }
    for (int row = gw; row < NTS; row += NGW) {
        float* yr = p.out + O_YS + (size_t)row * DM;
        f32x4 v[4]; float part = 0.f;
#pragma unroll
        for (int j = 0; j < 4; ++j) { v[j] = *(const f32x4*)(yr + 4 * lane + 256 * j); part += (v[j][0] * v[j][0] + v[j][1] * v[j][1]) + (v[j][2] * v[j][2] + v[j][3] * v[j][3]); }
        const float rs = rsqrtf(wave_sum(part) * (1.0f / DM) + EPS);
#pragma unroll
        for (int j = 0; j < 4; ++j) *(f32x4*)(yr + 4 * lane + 256 * j) = v[j] * rs * gv[j];
    }
}

__global__ void __launch_bounds__(512) fwd_kernel(Params p) {
    extern __shared__ __attribute__((aligned(16))) unsigned char lds_raw[];
    LAS unsigned char* lds = (LAS unsigned char*)lds_raw;
    unsigned char* ws = p.ws;
    const int lo = p.ph_lo, hi = p.ph_hi;
#ifndef REP2
#define REP2 1
#define REP56 1
#define REP01 1
#ifndef PROBE_MODE
#define PROBE_MODE 0
#endif
#endif
#ifndef PH_MASK
#define PH_MASK 255
#endif
#define IN(k) (((PH_MASK >> (k)) & 1) && lo <= (k) && (k) < hi)
    { volatile LAS unsigned* stw = (volatile LAS unsigned*)(lds + LDS_BARW); if (threadIdx.x < 2) stw[threadIdx.x] = 0u; }
    __syncthreads();
    XcdBarrier xbar = xcd_barrier_post((unsigned*)(ws + WS_BAR), (volatile LAS unsigned*)(lds + LDS_BARW));
#define SEAM(k) do { if (IN(k) && IN((k) + 1)) { xcd_barrier(xbar); } } while (0)
    if (p.ph_hi > 1000) cg::this_grid().sync();
    auto small = [&](int i) { return (bf16_t*)(ws + WS_SMALL + (size_t)i * SMALL_B); };
    TV tU{(bf16_t*)(ws + WS_U), small(SM_U)}, tQ{(bf16_t*)p.out, small(SM_Q)}, tK{(bf16_t*)((unsigned char*)p.out + 64 * MiB), small(SM_K)},
       tV{(bf16_t*)(ws + WS_V), small(SM_V)}, tOG{(bf16_t*)(ws + WS_OG), small(SM_OG)}, tXB{(bf16_t*)(ws + WS_XB), small(SM_XB)},
       tSZB{(bf16_t*)(ws + WS_SZB), small(SM_SZB)}, tGA{(bf16_t*)(ws + WS_GA), small(SM_GA)}, tGB{(bf16_t*)(ws + WS_GB), small(SM_GB)};
    if (IN(0)) { phase0(p, lds); } SEAM(0);
    if (IN(1)) { phase1(p, lds); } SEAM(1);
#if REP01 > 1
    phase0(p, lds); cg::this_grid().sync(); phase1(p, lds); cg::this_grid().sync();
#endif
    if (IN(2)) {
        pg8::StaticOrder S; S.init(129, 36, gridDim.x, blockIdx.x);
        Epi1 E{tQ, tK, tV, tOG, tXB, tSZB, tGA, tGB, p.in[23]};
        Prob1 P{tU, (const bf16_t*)(ws + WS_W1T)};
        pg8::gemm_phase(lds, DM, S, E, P);
    } SEAM(2);
    if (IN(3)) { phase3(p, lds); } SEAM(3);
    if (IN(5)) {
        {
            pg8::PairOrder S0; S0.init(128, 4, gridDim.x, blockIdx.x);
            const int ord = threadIdx.x >> 8, rl = threadIdx.x & 255; pg8::Unit u0;
            if (S0.next(2 * ord, u0)) { const float* hss = (const float*)(ws + WS_HSS) + (size_t)(u0.pm * 256 + rl) * 16; f32x4 o;
#pragma unroll
                for (int hd = 0; hd < 4; ++hd) { const f32x4 hs = *(const f32x4*)(hss + hd * 4); o[hd] = rsqrtf(((hs[0] + hs[1]) + (hs[2] + hs[3])) * (1.0f / 256.0f) + EPS); }
                *(LAS f32x4*)(lds + RS_OFF + (ord * 256 + rl) * 16) = o; }
            __syncthreads();
        }
        pg8::PairOrder S; S.init(128, 4, gridDim.x, blockIdx.x);
        Epi2 E{tGA, tGB, tU};
        Prob2 P{tV, tSZB, (const bf16_t*)(ws + WS_WAT), (const bf16_t*)(ws + WS_WBT)};
        pg8::gemm_phase(lds, DM, S, E, P);
        mini_gemm2(p, lds);
#if REP56 > 1
        cg::this_grid().sync();
        pg8::gemm_phase(lds, DM, S, E, P);
#endif
    } SEAM(5);
    if (IN(6)) {
        pg8::StaticOrder S; S.init(128, 4, gridDim.x, blockIdx.x);
        Epi3 E{p.in[0], (bf16_t*)(ws + WS_V), (const float*)(ws + WS_MODG), (float*)(ws + WS_ROWSS)};
        Prob3 P{tU, (const bf16_t*)(ws + WS_WOT)};
        pg8::gemm_phase(lds, DM, S, E, P);
        mini_gemm3(p, lds);
#if REP56 > 1
        cg::this_grid().sync();
        pg8::gemm_phase(lds, DM, S, E, P);
#endif
    } SEAM(6);
    if (IN(7)) { phase7(p); }
#if SYNC_PROBE
    for (int i_ = 0; i_ < 8; ++i_) cg::this_grid().sync();
#endif
#undef IN
#undef SEAM
}

extern "C" void kernel_launch(void* const* d_in, const int* in_sizes, int n_in, void* d_out, int out_size, void* d_ws, size_t ws_size, hipStream_t stream) {
    static int grid = 0;
    if (grid == 0) {
        if (n_in != 28 || out_size != (int)O_END || ws_size < WS_END) { fprintf(stderr, "kernel_launch: unexpected shapes (n_in %d out %d ws %zu)\n", n_in, out_size, ws_size); grid = -1; return; }
        int dev = 0, cus = 0, per_cu = 0;
        hipGetDevice(&dev); hipDeviceGetAttribute(&cus, hipDeviceAttributeMultiprocessorCount, dev);
        hipFuncSetAttribute((const void*)fwd_kernel, hipFuncAttributeMaxDynamicSharedMemorySize, LDS_BYTES);
        hipOccupancyMaxActiveBlocksPerMultiprocessor(&per_cu, (const void*)fwd_kernel, 512, LDS_BYTES);
        if (per_cu < 1) { fprintf(stderr, "kernel_launch: occupancy query says %d blocks per CU\n", per_cu); grid = -1; return; }
        grid = cus;
        (void)hipGetLastError();
    }
    if (grid < 0) return;
    Params p{};
    for (int i = 0; i < 28; ++i) p.in[i] = (const float*)d_in[i];
    p.out = (float*)d_out; p.ws = (unsigned char*)d_ws; p.probe = PROBE_MODE;
#if MK_ONE_LAUNCH
    if (hipMemsetAsync((char*)d_ws + WS_BAR, 0, 16384, stream) != hipSuccess) { fprintf(stderr, "kernel_launch: memset of the barrier words failed\n"); return; }
    p.ph_lo = 0; p.ph_hi = 8;
    void* args[] = {&p};
    hipError_t e = hipLaunchCooperativeKernel((const void*)fwd_kernel, dim3(grid), dim3(512), args, LDS_BYTES, stream);
    if (e != hipSuccess) fprintf(stderr, "cooperative launch failed: %s (grid %d)\n", hipGetErrorString(e), grid);
#else
    for (int k = 0; k < 8; ++k) { p.ph_lo = k; p.ph_hi = k + 1; hipLaunchKernelGGL(fwd_kernel, dim3(grid), dim3(512), LDS_BYTES, stream, p); }
#endif
}
```
